# Optimizing an MI355X kernel written in HIP

```python
import math
import jax, jax.numpy as jnp
from jax import lax
import numpy as np

D_MODEL = 4096
BATCH = 8
SEQ = 2048
DEPTH = 1
DEC_BATCH = 1
DEC_SEQ = 16384
PAST_LEN = 128

MIX_WIDTH = D_MODEL
ATTN_WIDTH = MIX_WIDTH // 2
HGRN_WIDTH = MIX_WIDTH - ATTN_WIDTH
DIFF_HEAD_DIM = 128
N_DIFF_HEADS = ATTN_WIDTH // (2 * DIFF_HEAD_DIM)
HGRN_HEAD_DIM = 128
N_HGRN_HEADS = HGRN_WIDTH // HGRN_HEAD_DIM
D_FF = 4 * D_MODEL
ROPE_THETA = 10000.0
NORM_EPS = 1e-6
Q_BLOCK = 128
CHUNK = 64
IN_PROJ_WIDTH = 3 * ATTN_WIDTH + 5 * HGRN_WIDTH

kernel_name = 'hymba_diffattn_hgrn2_encoder'


def rms_norm(x, w):
    xf = x.astype(jnp.float32)
    y = xf * lax.rsqrt(jnp.mean(xf * xf, axis=-1, keepdims=True) + NORM_EPS)
    return (y * w.astype(jnp.float32)).astype(x.dtype)


def rope_tables(length):
    inv = 1.0 / (ROPE_THETA ** (jnp.arange(0, DIFF_HEAD_DIM, 2, dtype=jnp.float32) / DIFF_HEAD_DIM))
    ang = jnp.arange(length, dtype=jnp.float32)[:, None] * inv[None, :]
    ang = jnp.concatenate([ang, ang], axis=-1)
    return jnp.cos(ang), jnp.sin(ang)


def apply_rope(x, cos, sin):
    half = DIFF_HEAD_DIM // 2
    x1, x2 = x[..., :half], x[..., half:]
    rot = jnp.concatenate([-x2, x1], axis=-1)
    c = cos[None, :, None, None, :]
    s = sin[None, :, None, None, :]
    return (x.astype(jnp.float32) * c + rot.astype(jnp.float32) * s).astype(x.dtype)


def diff_attention(q_a, k_a, v_a, lam, cos, sin):
    B, L, _ = q_a.shape
    q = apply_rope(q_a.reshape(B, L, N_DIFF_HEADS, 2, DIFF_HEAD_DIM), cos, sin)
    k = apply_rope(k_a.reshape(B, L, N_DIFF_HEADS, 2, DIFF_HEAD_DIM), cos, sin)
    v = v_a.reshape(B, L, N_DIFF_HEADS, 2 * DIFF_HEAD_DIM)
    n_blocks = L // Q_BLOCK
    q_blocks = q.reshape(B, n_blocks, Q_BLOCK, N_DIFF_HEADS, 2, DIFF_HEAD_DIM).transpose(1, 0, 2, 3, 4, 5)
    scale = DIFF_HEAD_DIM ** -0.5

    def attend(qb):
        s = jnp.einsum('bqhcd,bkhcd->bhcqk', qb, k).astype(jnp.float32) * scale
        p = jax.nn.softmax(s, axis=-1)
        p_diff = p[:, :, 0] - lam * p[:, :, 1]
        return jnp.einsum('bhqk,bkhe->bqhe', p_diff.astype(v.dtype), v)

    o = lax.map(attend, q_blocks)
    return o.transpose(1, 0, 2, 3, 4).reshape(B, L, N_DIFF_HEADS, 2 * DIFF_HEAD_DIM)


def gla_chunkwise(q, k, v, log_f):
    B, L, H, DK = q.shape
    DV = v.shape[-1]
    n_chunks = L // CHUNK

    def to_chunks(t):
        return t.reshape(B, n_chunks, CHUNK, H, t.shape[-1]).transpose(1, 0, 3, 2, 4)

    mask = jnp.tril(jnp.ones((CHUNK, CHUNK), dtype=bool))[None, None, :, :, None]

    def step(S, inp):
        qb, kb, vb, gb = inp
        b = jnp.cumsum(gb, axis=2)
        rel = jnp.where(mask, b[:, :, :, None, :] - b[:, :, None, :, :], -jnp.inf)
        A = jnp.einsum('bhtk,bhsk,bhtsk->bhts', qb, kb, jnp.exp(rel))
        o = jnp.einsum('bhts,bhsv->bhtv', A, vb) + jnp.einsum('bhtk,bhkv->bhtv', qb * jnp.exp(b), S)
        b_last = b[:, :, -1:, :]
        S_new = jnp.exp(b_last[:, :, 0, :])[..., None] * S + jnp.einsum(
            'bhsk,bhsv->bhkv', kb * jnp.exp(b_last - b), vb)
        return S_new, o

    S0 = jnp.zeros((B, H, DK, DV), dtype=jnp.float32)
    _, o = lax.scan(step, S0, (to_chunks(q), to_chunks(k), to_chunks(v), to_chunks(log_f)))
    return o.transpose(1, 0, 3, 2, 4).reshape(B, L, H, DV)


def hgrn2_bidirectional(q_h, f_fw, f_bw, i_h, g_h, lb_fw, lb_bw, norm_w):
    B, L, _ = q_h.shape
    shp = (B, L, N_HGRN_HEADS, HGRN_HEAD_DIM)
    q = jax.nn.silu(q_h.astype(jnp.float32)).reshape(shp)
    v = i_h.astype(jnp.float32).reshape(shp)

    def gates(f_raw, lb):
        f = lb + (1.0 - lb) * jax.nn.sigmoid(f_raw.astype(jnp.float32))
        return (1.0 - f).reshape(shp), jnp.log(f).reshape(shp)

    k_fw, lf_fw = gates(f_fw, lb_fw)
    k_bw, lf_bw = gates(f_bw, lb_bw)
    o_fw = gla_chunkwise(q, k_fw, v, lf_fw)
    flip = lambda t: jnp.flip(t, axis=1)
    o_bw = flip(gla_chunkwise(flip(q), flip(k_bw), flip(v), flip(lf_bw)))
    o = rms_norm(o_fw + o_bw, norm_w) * jax.nn.silu(g_h.astype(jnp.float32)).reshape(shp)
    return o.reshape(B, L, HGRN_WIDTH).astype(q_h.dtype)


def encoder_trunk(x, attn_norm_w, w_in, diff_lambda, subln_w, hgrn_lb, hgrn_norm_w,
                  w_out, mlp_norm_w, w_up, w_down, final_norm_w):
    B, L, _ = x.shape
    cos, sin = rope_tables(L)
    lb_all = jnp.cumsum(jax.nn.softmax(hgrn_lb.astype(jnp.float32), axis=1), axis=1)
    bounds = [ATTN_WIDTH, 2 * ATTN_WIDTH, 3 * ATTN_WIDTH] + [3 * ATTN_WIDTH + j * HGRN_WIDTH for j in range(1, 5)]
    for layer in range(DEPTH):
        h = rms_norm(x, attn_norm_w[layer])
        proj = h @ w_in[layer]
        q_a, k_a, v_a, q_h, f_fw, f_bw, i_h, g_h = jnp.split(proj, bounds, axis=-1)
        lam_init = 0.8 - 0.6 * math.exp(-0.3 * layer)
        lq1, lk1, lq2, lk2 = diff_lambda[layer].astype(jnp.float32)
        lam = jnp.exp(jnp.sum(lq1 * lk1)) - jnp.exp(jnp.sum(lq2 * lk2)) + lam_init
        o_a = diff_attention(q_a, k_a, v_a, lam, cos, sin)
        o_a = (rms_norm(o_a, subln_w[layer]) * (1.0 - lam_init)).reshape(B, L, ATTN_WIDTH)
        o_h = hgrn2_bidirectional(q_h, f_fw, f_bw, i_h, g_h, lb_all[0, layer], lb_all[1, layer], hgrn_norm_w[layer])
        x = x + jnp.concatenate([o_a, o_h], axis=-1) @ w_out[layer]
        h = rms_norm(x, mlp_norm_w[layer])
        x = x + jnp.square(jax.nn.relu(h @ w_up[layer])) @ w_down[layer]
    return rms_norm(x, final_norm_w)


def setup_inputs(seed: int = 0) -> dict:
    key = jax.random.key(seed)
    ks = jax.random.split(key, 13)
    f32 = jnp.float32

    def normal(k, shape, scale):
        return jax.random.normal(k, shape, f32) * scale

    return {
        'x_prompt': normal(ks[0], (BATCH, SEQ, D_MODEL), 1.0),
        'x_sample': normal(ks[1], (DEC_BATCH, DEC_SEQ, D_MODEL), 1.0),
        'attn_norm_w': 1.0 + normal(ks[2], (DEPTH, D_MODEL), 0.01),
        'w_in': normal(ks[3], (DEPTH, D_MODEL, IN_PROJ_WIDTH), D_MODEL ** -0.5),
        'diff_lambda': normal(ks[4], (DEPTH, 4, DIFF_HEAD_DIM), 0.1),
        'subln_w': 1.0 + normal(ks[5], (DEPTH, 2 * DIFF_HEAD_DIM), 0.01),
        'hgrn_lb': normal(ks[6], (2, DEPTH + 1, HGRN_WIDTH), 0.1),
        'hgrn_norm_w': 1.0 + normal(ks[7], (DEPTH, HGRN_HEAD_DIM), 0.01),
        'w_out': normal(ks[8], (DEPTH, MIX_WIDTH, D_MODEL), MIX_WIDTH ** -0.5),
        'mlp_norm_w': 1.0 + normal(ks[9], (DEPTH, D_MODEL), 0.01),
        'w_up': normal(ks[10], (DEPTH, D_MODEL, D_FF), D_MODEL ** -0.5),
        'w_down': normal(ks[11], (DEPTH, D_FF, D_MODEL), D_FF ** -0.5),
        'final_norm_w': 1.0 + normal(ks[12], (D_MODEL,), 0.01),
    }


def reference(x_prompt, x_sample, attn_norm_w, w_in, diff_lambda, subln_w, hgrn_lb, hgrn_norm_w,
              w_out, mlp_norm_w, w_up, w_down, final_norm_w):
    y_prompt = encoder_trunk(x_prompt, attn_norm_w, w_in, diff_lambda, subln_w, hgrn_lb, hgrn_norm_w,
                             w_out, mlp_norm_w, w_up, w_down, final_norm_w)
    y_sample = encoder_trunk(x_sample, attn_norm_w, w_in, diff_lambda, subln_w, hgrn_lb, hgrn_norm_w,
                             w_out, mlp_norm_w, w_up, w_down, final_norm_w)
    return (y_prompt, y_sample)
```

```cpp
#include <hip/hip_runtime.h>
#include <cstdio>
#include <cstdint>
__device__ __forceinline__ int ltid() { int t = threadIdx.x; asm volatile("" : "+v"(t)); return t; }
__device__ __forceinline__ int lsg(int v) { asm volatile("" : "+s"(v)); return v; }
namespace pg8 {
#define PG8_LAS __attribute__((address_space(3)))
typedef unsigned short bf16_t;
typedef short bf16x8 __attribute__((ext_vector_type(8)));
typedef float f32x4 __attribute__((ext_vector_type(4)));
typedef unsigned u32x4 __attribute__((ext_vector_type(4)));
constexpr int BM = 256, BK = 64, HALF = 128, HTB = HALF * BK * 2  , STAGE_BYTES = 8 * HTB, NXCD = 8, WGM = 8;

__host__ __device__ __forceinline__ int lds_byte(int r, int c) { const int st = (r >> 4) * 2 + (c >> 5), rr = r & 15, cc = c & 31, ob = rr * 64 + cc * 2; return st * 1024 + (ob ^ (((ob >> 9) & 1) << 5)); }
__host__ __device__ __forceinline__ void stage_rc(int b, int& R, int& C) { const int st = b / 1024, sb = b % 1024, swz = sb ^ (((sb >> 9) & 1) << 5); R = (st >> 1) * 16 + swz / 64; C = (st & 1) * 32 + (swz % 64) / 2; }
__host__ __device__ __forceinline__ int perm32(int rho) { const int n = rho >> 4, i = rho & 15; return 8 * (i >> 2) + 4 * n + (i & 3); }

struct Unit { int pm, pn; };
struct Gemm { const bf16_t* A; const bf16_t* Bt; int M, N, K; };

struct StaticOrder {
    int nM, nN, nwg, G, c;
    __host__ __device__ void init(int M, int N, int G_, int c_) { nM = M / BM; nN = N / BM; nwg = nM * nN; G = G_; c = c_; }
    __host__ __device__ bool next(int i, Unit& u) const {
        const long L = (long)i * G + c; if (L >= nwg) return false;
        int wgid = (int)L; { const int q = nwg / NXCD, r = nwg % NXCD, xcd = wgid % NXCD, off = wgid / NXCD; wgid = (xcd < r ? xcd * (q + 1) : r * (q + 1) + (xcd - r) * q) + off; }
        const int nig = WGM * nN, gid = wgid / nig, fm = gid * WGM, gsz = (nM - fm) < WGM ? (nM - fm) : WGM;
        u.pm = fm + ((wgid % nig) % gsz); u.pn = (wgid % nig) / gsz; return true;
    }
    __device__ __forceinline__ void a_ready(const Unit&) const {}
    __device__ __forceinline__ void done(const Unit&) const {}
};
struct CountedOrder : StaticOrder {
    const unsigned* ready; unsigned need; unsigned* tmo;
    __device__ __forceinline__ void a_ready(const Unit& u) const {
        if (threadIdx.x < 64) {
            const unsigned long long t0 = __builtin_amdgcn_s_memrealtime(); unsigned polls = 0;
            while ((unsigned)__builtin_amdgcn_readfirstlane(__hip_atomic_load(ready + 64 * u.pm, __ATOMIC_RELAXED, __HIP_MEMORY_SCOPE_AGENT)) < need) {
                if ((++polls & 255u) == 0u && __builtin_amdgcn_readfirstlane(__hip_atomic_load(tmo, __ATOMIC_RELAXED, __HIP_MEMORY_SCOPE_AGENT)) != 0u) break;
                if (__builtin_amdgcn_s_memrealtime() - t0 > 2000000ull) {
                    if (threadIdx.x == 0) { unsigned expect = 0u; __hip_atomic_compare_exchange_strong(tmo + 1, &expect, 0x600u | (unsigned)(u.pm & 0xff), __ATOMIC_RELAXED, __ATOMIC_RELAXED, __HIP_MEMORY_SCOPE_AGENT); __hip_atomic_store(tmo, 1u, __ATOMIC_RELAXED, __HIP_MEMORY_SCOPE_AGENT); }
                    break; }
                __builtin_amdgcn_s_sleep(2); }
            __builtin_amdgcn_fence(__ATOMIC_ACQUIRE, "agent");
            asm volatile("s_waitcnt vmcnt(0)" ::: "memory");
        }
#if !defined(BROKEN_HOOK_NO_BARRIER)
        asm volatile("" ::: "memory"); __builtin_amdgcn_s_barrier(); asm volatile("" ::: "memory");
#endif
    }
};

__device__ __forceinline__ unsigned cvt_pk_bf16(float lo, float hi) { unsigned r; asm volatile("v_cvt_pk_bf16_f32 %0, %1, %2" : "=v"(r) : "v"(lo), "v"(hi)); return r; }
typedef float f32x2 __attribute__((ext_vector_type(2)));
__device__ __forceinline__ f32x2 gelu_pk(f32x2 v) {
    const f32x2 av = __builtin_elementwise_abs(v), d = av * 0.2316418882f + 1.0f;
    f32x2 t; t.x = __builtin_amdgcn_rcpf(d.x); t.y = __builtin_amdgcn_rcpf(d.y);
    f32x2 q = t * 0.5307027145f + (-0.7265760135f); q = q * t + 0.7107068705f; q = q * t + (-0.142248368f); q = q * t + 0.127414796f; q = q * t;
    const f32x2 s = (v * v) * (-0.72134752044f);
    f32x2 e; e.x = __builtin_amdgcn_exp2f(s.x); e.y = __builtin_amdgcn_exp2f(s.y);
    const f32x2 m = v * (q * e), r = v - m;
    f32x2 o; o.x = v.x < 0.f ? m.x : r.x; o.y = v.y < 0.f ? m.y : r.y; return o;
}

struct EpiF32 {
    static constexpr bool PERM = false, AFTER_DRAIN = false;
    float* C; int ldc; const float* bias;
    __device__ __forceinline__ void operator()(const f32x4 (&acc)[2][2][4][2], const Unit& u, int wr, int wc, int fr, int fq) const {
        const int row0 = u.pm * BM + wr * 64 + fr, col0 = u.pn * BM + wc * 32 + 4 * fq;
        f32x4 bv[2][2];
#pragma unroll
        for (int bj = 0; bj < 2; ++bj)
#pragma unroll
            for (int n = 0; n < 2; ++n) bv[bj][n] = bias ? *(const f32x4*)(bias + col0 + bj * HALF + n * 16) : (f32x4){0.f, 0.f, 0.f, 0.f};
#pragma unroll
        for (int ai = 0; ai < 2; ++ai)
#pragma unroll
            for (int m = 0; m < 4; ++m) { float* rowp = C + (size_t)(row0 + ai * HALF + m * 16) * ldc + col0;
#pragma unroll
                for (int bj = 0; bj < 2; ++bj)
#pragma unroll
                    for (int n = 0; n < 2; ++n) *(f32x4*)(rowp + bj * HALF + n * 16) = acc[ai][bj][m][n] + bv[bj][n]; }
    }
};
template <int ACT  > struct EpiBf16 {
    static constexpr bool PERM = true, AFTER_DRAIN = false;
    bf16_t* O; int ldc; const float* bias; int split_cols; size_t split_stride;
    __device__ __forceinline__ void operator()(const f32x4 (&acc)[2][2][4][2], const Unit& u, int wr, int wc, int fr, int fq) const {
        const int row0 = u.pm * BM + wr * 64 + fr; int colt = u.pn * BM; bf16_t* base = O;
        if (split_cols) { const int t = colt / split_cols; base += (size_t)t * split_stride; colt -= t * split_cols; }
        const int col0 = colt + wc * 32 + 8 * fq, bcol0 = u.pn * BM + wc * 32 + 8 * fq;
        f32x4 bv[2][2];
#pragma unroll
        for (int bj = 0; bj < 2; ++bj)
#pragma unroll
            for (int n = 0; n < 2; ++n) bv[bj][n] = bias ? *(const f32x4*)(bias + bcol0 + bj * HALF + 4 * n) : (f32x4){0.f, 0.f, 0.f, 0.f};
#pragma unroll
        for (int ai = 0; ai < 2; ++ai)
#pragma unroll
            for (int m = 0; m < 4; ++m) { bf16_t* rowp = base + (size_t)(row0 + ai * HALF + m * 16) * ldc + col0;
#pragma unroll
                for (int bj = 0; bj < 2; ++bj) { f32x4 v0 = acc[ai][bj][m][0] + bv[bj][0], v1 = acc[ai][bj][m][1] + bv[bj][1];
                    if (ACT == 1) { f32x2 a = gelu_pk((f32x2){v0[0], v0[1]}), b = gelu_pk((f32x2){v0[2], v0[3]}), c = gelu_pk((f32x2){v1[0], v1[1]}), d = gelu_pk((f32x2){v1[2], v1[3]});
                        v0 = (f32x4){a.x, a.y, b.x, b.y}; v1 = (f32x4){c.x, c.y, d.x, d.y}; }
                    if (ACT == 2) {
#pragma unroll
                        for (int j = 0; j < 4; ++j) { v0[j] = 0.5f * v0[j] * (1.0f + erff(v0[j] * 0.70710678f)); v1[j] = 0.5f * v1[j] * (1.0f + erff(v1[j] * 0.70710678f)); } }
                    u32x4 w; w.x = cvt_pk_bf16(v0[0], v0[1]); w.y = cvt_pk_bf16(v0[2], v0[3]); w.z = cvt_pk_bf16(v1[0], v1[1]); w.w = cvt_pk_bf16(v1[2], v1[3]);
                    *(u32x4*)(rowp + bj * HALF) = w; } }
    }
};
template <class Epi, class Sched, bool STAMP = false>
__device__ __forceinline__ void gemm_phase(PG8_LAS unsigned char* lds, const Gemm g, const Sched& S, const Epi& E, unsigned long long* stamps) {
    const int tid = ltid(), wid = __builtin_amdgcn_readfirstlane(tid >> 6), lane = tid & 63, wr = wid >> 2, wc = wid & 3, fr = lane & 15, fq = lane >> 4;
    const int K = g.K, nt = K / BK;
    int ts_lo = 0, ts_hi = 0, nts = 0; const unsigned long long rt_entry = STAMP ? (unsigned long long)wall_clock64() : 0ull;
#define PG8_STAMP() do { if (STAMP && wid == 0 && nts < 64) { const unsigned long long _c = (unsigned long long)clock64(); \
        ts_lo = (lane == nts) ? (int)(unsigned)_c : ts_lo; ts_hi = (lane == nts) ? (int)(unsigned)(_c >> 32) : ts_hi; ++nts; } } while (0)
    PG8_STAMP();
    unsigned voffA[2], voffB[2];
#pragma unroll
    for (int i = 0; i < 2; ++i) { int R, C; stage_rc(tid * 16 + i * 8192, R, C); const int Rb = Epi::PERM ? ((R & ~31) + perm32(R & 31)) : R;
        voffA[i] = (unsigned)(R * K + C) * 2u; voffB[i] = (unsigned)(Rb * K + C) * 2u; }
    const size_t kstep = (size_t)(BK * 2);
    const size_t hstep = (size_t)HALF * K * 2;
    const size_t tstep = 2 * hstep;
    const unsigned ldsw = (unsigned)wid * 1024u;
    const int aoff = lds_byte(wr * 64 + fr, fq * 8), boff = lds_byte(wc * 32 + fr, fq * 8);
#define PG8_SA(b, h) (((b) * 2 + (h)) * HTB)
#define PG8_SB(b, h) ((4 + (b) * 2 + (h)) * HTB)
#define PG8_STAGE(bufoff, gbase, voff) do { _Pragma("unroll") for (int _i = 0; _i < 2; ++_i) \
        __builtin_amdgcn_global_load_lds((const unsigned*)((const char*)(gbase) + (voff)[_i]), (PG8_LAS unsigned*)(lds + (bufoff) + ldsw + _i * 8192), 16, 0, 0); } while (0)
#define PG8_LDA(dst, b, h) do { _Pragma("unroll") for (int m = 0; m < 4; ++m) _Pragma("unroll") for (int k = 0; k < 2; ++k) dst[m][k] = *(const PG8_LAS bf16x8*)(lds + PG8_SA(b, h) + aoff + m * 2048 + k * 1024); } while (0)
#define PG8_LDB(dst, b, h) do { _Pragma("unroll") for (int n = 0; n < 2; ++n) _Pragma("unroll") for (int k = 0; k < 2; ++k) dst[n][k] = *(const PG8_LAS bf16x8*)(lds + PG8_SB(b, h) + boff + n * 2048 + k * 1024); } while (0)
#define PG8_MMA(ai, bj, At, Bt) do { __builtin_amdgcn_s_setprio(1); _Pragma("unroll") for (int m = 0; m < 4; ++m) _Pragma("unroll") for (int n = 0; n < 2; ++n) _Pragma("unroll") for (int k = 0; k < 2; ++k) \
        acc[ai][bj][m][n] = __builtin_amdgcn_mfma_f32_16x16x32_bf16(Bt[n][k], At[m][k], acc[ai][bj][m][n], 0, 0, 0); __builtin_amdgcn_s_setprio(0); } while (0)
#define PG8_WAIT_V(n) asm volatile("s_waitcnt vmcnt(" #n ")" ::: "memory")
#define PG8_WAIT_L(n) asm volatile("s_waitcnt lgkmcnt(" #n ")" ::: "memory")
#define PG8_BAR __builtin_amdgcn_s_barrier()
#define PG8_SCHED __builtin_amdgcn_sched_barrier(0)
    Unit cur, nxt; int ui = 0;
    if (!S.next(0, cur)) return;
    f32x4 acc[2][2][4][2];
#pragma unroll
    for (int a = 0; a < 2; ++a)
#pragma unroll
        for (int b = 0; b < 2; ++b)
#pragma unroll
            for (int m = 0; m < 4; ++m)
#pragma unroll
                for (int n = 0; n < 2; ++n) acc[a][b][m][n] = (f32x4){0.f, 0.f, 0.f, 0.f};
    bf16x8 At[4][2], B0[2][2], B1[2][2];
    const char* cA = (const char*)g.A + (size_t)cur.pm * tstep; const char* cB = (const char*)g.Bt + (size_t)cur.pn * tstep;
    S.a_ready(cur);
    PG8_STAGE(PG8_SB(0, 0), cB, voffB); PG8_STAGE(PG8_SA(0, 0), cA, voffA); PG8_STAGE(PG8_SB(0, 1), cB + hstep, voffB); PG8_STAGE(PG8_SA(0, 1), cA + hstep, voffA);
    if (wr == 1) PG8_BAR;
    PG8_WAIT_V(4); PG8_BAR;
    PG8_STAGE(PG8_SB(1, 0), cB + kstep, voffB); PG8_STAGE(PG8_SA(1, 0), cA + kstep, voffA); PG8_STAGE(PG8_SB(1, 1), cB + hstep + kstep, voffB);
    PG8_WAIT_V(6); PG8_BAR;
    PG8_STAMP();
    for (;;) {
        const bool has_next = S.next(ui + 1, nxt);
        const char* nA = has_next ? (const char*)g.A + (size_t)nxt.pm * tstep : cA; const char* nB = has_next ? (const char*)g.Bt + (size_t)nxt.pn * tstep : cB;
        for (int t = 0; t < nt; t += 2) {
            const bool last = (t == nt - 2);
            const char* a1 = cA + (size_t)(t + 1) * kstep;
            const char* a2 = last ? nA : cA + (size_t)(t + 2) * kstep; const char* b2 = last ? nB : cB + (size_t)(t + 2) * kstep;
            const char* a3 = a2 + kstep; const char* b3 = b2 + kstep;
            if (last && has_next) S.a_ready(nxt);
            PG8_LDB(B0, 0, 0); PG8_SCHED; PG8_LDA(At, 0, 0); PG8_STAGE(PG8_SA(1, 1), a1 + hstep, voffA);
            PG8_WAIT_L(8); PG8_BAR; PG8_WAIT_L(0); PG8_MMA(0, 0, At, B0); PG8_BAR; PG8_SCHED;
            PG8_LDB(B1, 0, 1); PG8_STAGE(PG8_SB(0, 0), b2, voffB);
            PG8_BAR; PG8_WAIT_L(0); PG8_MMA(0, 1, At, B1); PG8_BAR;
            PG8_LDA(At, 0, 1); PG8_STAGE(PG8_SA(0, 0), a2, voffA);
            PG8_BAR; PG8_WAIT_L(0); PG8_MMA(1, 0, At, B0); PG8_BAR; PG8_SCHED;
            PG8_STAGE(PG8_SB(0, 1), b2 + hstep, voffB);
            PG8_WAIT_V(6); PG8_BAR; PG8_MMA(1, 1, At, B1); PG8_BAR;
            PG8_LDB(B0, 1, 0); PG8_SCHED; PG8_LDA(At, 1, 0); PG8_STAGE(PG8_SA(0, 1), a2 + hstep, voffA);
            PG8_WAIT_L(8); PG8_BAR; PG8_WAIT_L(0); PG8_MMA(0, 0, At, B0); PG8_BAR; PG8_SCHED;
            PG8_LDB(B1, 1, 1); PG8_STAGE(PG8_SB(1, 0), b3, voffB);
            PG8_BAR; PG8_WAIT_L(0); PG8_MMA(0, 1, At, B1); PG8_BAR;
            PG8_LDA(At, 1, 1); PG8_STAGE(PG8_SA(1, 0), a3, voffA);
            PG8_BAR; PG8_WAIT_L(0); PG8_MMA(1, 0, At, B0); PG8_BAR; PG8_SCHED;
            PG8_STAGE(PG8_SB(1, 1), b3 + hstep, voffB);
            PG8_WAIT_V(6); PG8_BAR; PG8_MMA(1, 1, At, B1); PG8_BAR;
        }
        PG8_STAMP();
        if constexpr (!Epi::AFTER_DRAIN) { E(acc, cur, wr, wc, fr, fq); S.done(cur); }
        PG8_STAMP();
        if (!has_next) break;
#pragma unroll
        for (int a = 0; a < 2; ++a)
#pragma unroll
            for (int b = 0; b < 2; ++b)
#pragma unroll
                for (int m = 0; m < 4; ++m)
#pragma unroll
                    for (int n = 0; n < 2; ++n) acc[a][b][m][n] = (f32x4){0.f, 0.f, 0.f, 0.f};
        cur = nxt; cA = nA; cB = nB; ++ui;
    }
    PG8_WAIT_V(0);
    if (wr == 0) PG8_BAR;
    PG8_BAR;
    if constexpr (Epi::AFTER_DRAIN) { E.fused(acc, cur, wr, wc, fr, fq, lds, wid, lane); S.done(cur); }
    PG8_STAMP();
    if (STAMP && wid == 0) { stamps[lane] = lane < nts ? (((unsigned long long)(unsigned)ts_hi << 32) | (unsigned)ts_lo) : 0ull;
        if (lane == 62) stamps[62] = rt_entry; if (lane == 63) stamps[63] = (unsigned long long)wall_clock64(); }
#undef PG8_STAMP
#undef PG8_SA
#undef PG8_SB
#undef PG8_STAGE
#undef PG8_LDA
#undef PG8_LDB
#undef PG8_MMA
#undef PG8_WAIT_V
#undef PG8_WAIT_L
#undef PG8_BAR
#undef PG8_SCHED
}
}
#define XB_TMO      128
#define XB_XCNT(j)  (256  + 64 * (j))
#define XB_XSUB(j)  (1280 + 64 * (j))
#define XB_XGEN(j)  (2304 + 64 * (j))
#define XB_TOP      3328
#define XB_TOPGEN   3392
#define XCD_BAR_WORDS 3456
#define XB_SPIN_CAP (1u << 22)
#define LAS __attribute__((address_space(3)))

__device__ __forceinline__ unsigned xb_ld(unsigned* p)              { return __hip_atomic_load(p, __ATOMIC_RELAXED, __HIP_MEMORY_SCOPE_AGENT); }
__device__ __forceinline__ unsigned xb_add(unsigned* p, unsigned v) { return __hip_atomic_fetch_add(p, v, __ATOMIC_RELAXED, __HIP_MEMORY_SCOPE_AGENT); }
__device__ __forceinline__ unsigned xb_xcc_id() { return (unsigned)__builtin_amdgcn_s_getreg((3 << 11) | 20) & 0xFu; }
#define XB_SPIN(cond, bar) do { unsigned _sp = 0; while (cond) { __builtin_amdgcn_s_sleep(1); \
    if ((++_sp & 255u) == 0u) { if (xb_ld(&(bar)[XB_TMO])) break; if (_sp > XB_SPIN_CAP) { atomicAdd(&(bar)[XB_TMO], 1u); break; } } } } while (0)

struct XcdBarrier {
    unsigned* bar; unsigned x;
    volatile LAS unsigned* st;
};

__device__ __forceinline__ XcdBarrier xcd_barrier_post(unsigned* bar, volatile LAS unsigned* st) {
    XcdBarrier b; b.bar = bar; b.x = xb_xcc_id(); b.st = st;
    if (threadIdx.x == 0) (void)xb_add(&bar[XB_XCNT(b.x)], 1u);
    return b;
}
__device__ __forceinline__ void xcd_barrier_complete(unsigned* bar, unsigned x, unsigned& nloc, unsigned& nx) {
    const unsigned G = gridDim.x * gridDim.y * gridDim.z;
    unsigned sum, cnt, mine, sp = 0u;
    for (;;) {
        sum = 0u; cnt = 0u; mine = 0u;
#pragma unroll
        for (unsigned j = 0; j < 16; ++j) { const unsigned c = xb_ld(&bar[XB_XCNT(j)]); sum += c; cnt += (c > 0u) ? 1u : 0u; mine = (j == x) ? c : mine; }
        if (sum == G) break;
        __builtin_amdgcn_s_sleep(1);
        if ((++sp & 255u) == 0u) { if (xb_ld(&bar[XB_TMO])) break; if (sp > XB_SPIN_CAP) { atomicAdd(&bar[XB_TMO], 1u); break; } }
    }
    nloc = mine > 0u ? mine : 1u; nx = cnt > 0u ? cnt : 1u;
}

__device__ __forceinline__ void xcd_barrier(const XcdBarrier& b) {
    asm volatile("s_waitcnt vmcnt(0)" ::: "memory");
    __syncthreads();
    if (threadIdx.x == 0) {
        unsigned* bar = b.bar;
        __builtin_amdgcn_s_waitcnt(0);
        unsigned nloc = b.st[0], nx = b.st[1];
        if (nloc == 0u) { xcd_barrier_complete(bar, b.x, nloc, nx); b.st[0] = nloc; b.st[1] = nx; }
        const unsigned old = xb_add(&bar[XB_XSUB(b.x)], 1u);
        const unsigned gen = old / nloc;
        if (old + 1u == (gen + 1u) * nloc) {
            __builtin_amdgcn_fence(__ATOMIC_RELEASE, "agent");
            asm volatile("s_waitcnt vmcnt(0)" ::: "memory");
            const unsigned og = xb_add(&bar[XB_TOP], 1u);
            const unsigned tg = og / nx;
            if (og + 1u == (tg + 1u) * nx) xb_add(&bar[XB_TOPGEN], 1u);
            else XB_SPIN(xb_ld(&bar[XB_TOPGEN]) == tg, bar);
            __builtin_amdgcn_fence(__ATOMIC_ACQUIRE, "agent");
            xb_add(&bar[XB_XGEN(b.x)], 1u);
            asm volatile("s_waitcnt vmcnt(0)" ::: "memory");
        } else {
            XB_SPIN(xb_ld(&bar[XB_XGEN(b.x)]) == gen, bar);
            __builtin_amdgcn_fence(__ATOMIC_ACQUIRE, "agent");
            asm volatile("s_waitcnt vmcnt(0)" ::: "memory");
        }
    }
    __syncthreads();
}
namespace att {
using bf16 = unsigned short;
constexpr int   D = 128, NW = 8, QBLK = 32, KVBLK = 64;
constexpr float SCALE = 0.088388347648318440f;
constexpr float THR = 8.f;
constexpr int SDEPTH = 2;
constexpr int LDQ = 16384, LDK = 16384, LDO = 4096;
constexpr size_t SHM_V = KVBLK * D * 2, SHM_K = KVBLK * D * 2, SHM_ATTN = 2 * SHM_V + 2 * SHM_K + NW * 64 * 4;
using bf16x8 = __attribute__((ext_vector_type(8))) short;
using s16x4  = __attribute__((ext_vector_type(4))) short;
using f32x16 = __attribute__((ext_vector_type(16))) float;
using f32x8  = __attribute__((ext_vector_type(8))) float;
using u32x4  = __attribute__((ext_vector_type(4))) unsigned;
#define KSWZ(row, colB) ((row) * 256 + ((colB) ^ (((row) & 7) << 4)))
#define SBAR() __builtin_amdgcn_sched_barrier(0)
__device__ __forceinline__ int crow(int r, int hi) { return (r & 3) + 8 * (r >> 2) + 4 * hi; }
__device__ __forceinline__ unsigned cvtpk(float lo, float hi) {
  unsigned r; asm volatile("v_cvt_pk_bf16_f32 %0, %1, %2" : "=v"(r) : "v"(lo), "v"(hi)); return r;
}
template <typename TIn> struct Stage;
template <> struct Stage<bf16>  { using T = bf16x8;
  __device__ static __forceinline__ T ld8(const bf16* p) { return *reinterpret_cast<const bf16x8*>(p); }
  __device__ static __forceinline__ bf16x8 tobf(T x) { return x; } };
template <> struct Stage<float> { using T = f32x8;
  __device__ static __forceinline__ T ld8(const float* p) { return *reinterpret_cast<const f32x8*>(p); }
  __device__ static __forceinline__ bf16x8 tobf(T x) {
    u32x4 w = {cvtpk(x[0], x[1]), cvtpk(x[2], x[3]), cvtpk(x[4], x[5]), cvtpk(x[6], x[7])}; return *reinterpret_cast<bf16x8*>(&w); } };

__device__ __forceinline__ void partialSM(f32x16& p0, f32x16& p1, float& m_reg, float& mn, float& alpha) {
  constexpr float C = SCALE * 1.4426950408889634f;
  float pmax = p0[0]; for (int r = 1; r < 16; ++r) pmax = fmaxf(pmax, p0[r]); for (int r = 0; r < 16; ++r) pmax = fmaxf(pmax, p1[r]);
  { auto rr = __builtin_amdgcn_permlane32_swap(__float_as_uint(pmax), __float_as_uint(pmax), false, false);
    pmax = fmaxf(__uint_as_float(rr[0]), __uint_as_float(rr[1])); }
  if (__builtin_expect(__all(pmax - m_reg <= THR / SCALE), 1)) { mn = m_reg; alpha = 1.f; }
  else { mn = fmaxf(m_reg, pmax); alpha = __builtin_amdgcn_exp2f((m_reg - mn) * C); m_reg = mn; }
  float mnC = -mn * C;
  for (int r = 0; r < 16; ++r) p0[r] = fmaf(p0[r], C, mnC); for (int r = 0; r < 16; ++r) p1[r] = fmaf(p1[r], C, mnC);
  for (int r = 0; r < 16; ++r) p0[r] = __builtin_amdgcn_exp2f(p0[r]);
}
__device__ __forceinline__ void finishSM(f32x16& p0, f32x16& p1, float alpha, float& l_reg, bf16x8& pa0, bf16x8& pa1, bf16x8& pa2, bf16x8& pa3) {
  for (int r = 0; r < 16; ++r) p1[r] = __builtin_amdgcn_exp2f(p1[r]);
  float ps = 0; for (int r = 0; r < 16; ++r) ps += p0[r]; for (int r = 0; r < 16; ++r) ps += p1[r];
  { auto rr = __builtin_amdgcn_permlane32_swap(__float_as_uint(ps), __float_as_uint(ps), false, false);
    ps = __uint_as_float(rr[0]) + __uint_as_float(rr[1]); }
  l_reg = l_reg * alpha + ps;
#define PK4(P, BASE, OUT) do { unsigned a0 = cvtpk(P[BASE + 0], P[BASE + 1]), a1 = cvtpk(P[BASE + 2], P[BASE + 3]);   \
    unsigned b0 = cvtpk(P[BASE + 4], P[BASE + 5]), b1 = cvtpk(P[BASE + 6], P[BASE + 7]);                              \
    auto r0 = __builtin_amdgcn_permlane32_swap(a0, b0, false, false); auto r1 = __builtin_amdgcn_permlane32_swap(a1, b1, false, false); \
    u32x4 w = {r0[0], r1[0], r0[1], r1[1]}; OUT = *reinterpret_cast<bf16x8*>(&w); } while (0)
  PK4(p0, 0, pa0); PK4(p0, 8, pa1); PK4(p1, 0, pa2); PK4(p1, 8, pa3);
#undef PK4
}
__device__ __forceinline__ void qkt(f32x16& p0, f32x16& p1, const bf16* Ks, const bf16x8* qr, int r32, int hi) {
  p0 = f32x16{}; p1 = f32x16{};
  for (int d0 = 0; d0 < 8; ++d0) { int cb = (d0 * 16 + hi * 8) * 2;
    bf16x8 b0 = *reinterpret_cast<const bf16x8*>((const char*)Ks + KSWZ(r32, cb));
    bf16x8 b1 = *reinterpret_cast<const bf16x8*>((const char*)Ks + KSWZ(32 + r32, cb));
    p0 = __builtin_amdgcn_mfma_f32_32x32x16_bf16(b0, qr[d0], p0, 0, 0, 0);
    p1 = __builtin_amdgcn_mfma_f32_32x32x16_bf16(b1, qr[d0], p1, 0, 0, 0); }
}
__device__ __forceinline__ int v_st(int k, int c) { const int kk = (k & ~0xC) | ((k & 4) << 1) | ((k & 8) >> 1); return ((kk >> 3) * 4 + (c >> 5)) * 512 + ((kk & 7) * 32 + (c & 31)) * 2; }
__device__ __forceinline__ int v_rd_base(int lane) { return ((lane & 3) << 3) | (((lane >> 2) & 3) << 6) | (((lane >> 4) & 1) << 5) | (((lane >> 5) & 1) << 8); }
constexpr int v_rd_off(int d0, int ks, int half) { return d0 * 512 + ks * 4096 + half * 2048; }
template <int OFF> __device__ __forceinline__ s16x4 tr_read(int vb) {
  s16x4 r; asm volatile("ds_read_b64_tr_b16 %0, %1 offset:%2" : "=&v"(r) : "v"(vb), "i"(OFF) : "memory"); return r;
}
template <int D0> __device__ __forceinline__ void pv_one(f32x16& od, int vb, bf16x8 pa0, bf16x8 pa1, bf16x8 pa2, bf16x8 pa3) {
  const s16x4 l0 = tr_read<v_rd_off(D0, 0, 0)>(vb), h0 = tr_read<v_rd_off(D0, 0, 1)>(vb), l1 = tr_read<v_rd_off(D0, 1, 0)>(vb), h1 = tr_read<v_rd_off(D0, 1, 1)>(vb);
  const s16x4 l2 = tr_read<v_rd_off(D0, 2, 0)>(vb), h2 = tr_read<v_rd_off(D0, 2, 1)>(vb), l3 = tr_read<v_rd_off(D0, 3, 0)>(vb), h3 = tr_read<v_rd_off(D0, 3, 1)>(vb);
  asm volatile("s_waitcnt lgkmcnt(0)" ::: "memory"); SBAR();
#define PK(L, H) (bf16x8){L[0], L[1], L[2], L[3], H[0], H[1], H[2], H[3]}
  od = __builtin_amdgcn_mfma_f32_32x32x16_bf16(pa0, PK(l0, h0), od, 0, 0, 0);
  od = __builtin_amdgcn_mfma_f32_32x32x16_bf16(pa1, PK(l1, h1), od, 0, 0, 0);
  od = __builtin_amdgcn_mfma_f32_32x32x16_bf16(pa2, PK(l2, h2), od, 0, 0, 0);
  od = __builtin_amdgcn_mfma_f32_32x32x16_bf16(pa3, PK(l3, h3), od, 0, 0, 0);
#undef PK
}
__device__ __forceinline__ void pv_d0(f32x16* o, int vb, bf16x8 pa0, bf16x8 pa1, bf16x8 pa2, bf16x8 pa3) {
  pv_one<0>(o[0], vb, pa0, pa1, pa2, pa3); pv_one<1>(o[1], vb, pa0, pa1, pa2, pa3); pv_one<2>(o[2], vb, pa0, pa1, pa2, pa3); pv_one<3>(o[3], vb, pa0, pa1, pa2, pa3);
}

template <typename TQ>
__device__ __forceinline__ void attn_dense_body(const TQ* __restrict__ Qb, const bf16* __restrict__ Kh, const bf16* __restrict__ Vh,
                                                bf16* __restrict__ Ob, int seq, char* lds) {
  using St = Stage<bf16>; using SQ = Stage<TQ>;
  const int tid = ltid(), wid = tid >> 6, lane = tid & 63, r32 = lane & 31, hi = lane >> 5;
  bf16* V_lds = (bf16*)lds; bf16* K_lds = (bf16*)(lds + 2 * SHM_V);
  float* ws = (float*)(lds + 2 * SHM_V + 2 * SHM_K) + wid * 64; float* li_l = ws; float* al_l = ws + 32;
  float m_reg = -1e30f, l_reg = 0; f32x16 o[4] = {}; bf16x8 qr[8];
  const TQ* Qw = Qb + (long)(wid * QBLK + r32) * LDQ + hi * 8;
#pragma unroll
  for (int d0 = 0; d0 < 8; ++d0) qr[d0] = SQ::tobf(SQ::ld8(Qw + d0 * 16));
  const int sr = tid >> 4, sc = (tid & 15) * 8, vst0 = v_st(sr, sc), vst1 = v_st(32 + sr, sc);
  const int vb0 = (int)(uintptr_t)V_lds + v_rd_base(lane);
  struct { typename St::T vs0, vs1, ks0, ks1; } sr_[SDEPTH];
#define SLOAD(i, k0) do { sr_[i].vs0 = St::ld8(&Vh[(long)((k0) + sr) * LDK + sc]); sr_[i].vs1 = St::ld8(&Vh[(long)((k0) + 32 + sr) * LDK + sc]); \
    sr_[i].ks0 = St::ld8(&Kh[(long)((k0) + sr) * LDK + sc]); sr_[i].ks1 = St::ld8(&Kh[(long)((k0) + 32 + sr) * LDK + sc]); } while (0)
#define SWRITE(b, i) do { *(bf16x8*)((char*)V_lds + (b) * SHM_V + vst0) = St::tobf(sr_[i].vs0);          \
    *(bf16x8*)((char*)V_lds + (b) * SHM_V + vst1) = St::tobf(sr_[i].vs1); int kc = sc * 2;               \
    *(bf16x8*)((char*)K_lds + (b) * SHM_K + KSWZ(sr, kc)) = St::tobf(sr_[i].ks0);                       \
    *(bf16x8*)((char*)K_lds + (b) * SHM_K + KSWZ(32 + sr, kc)) = St::tobf(sr_[i].ks1); } while (0)
#define SWAIT() do { if constexpr (SDEPTH == 2) asm volatile("s_waitcnt vmcnt(4)" ::: "memory"); else asm volatile("s_waitcnt vmcnt(0)" ::: "memory"); } while (0)
#define RESC(a) do { if (__any((a) < 1.f)) { if (hi == 0) al_l[r32] = (a); asm volatile("s_waitcnt lgkmcnt(0)" ::: "memory"); \
    for (int d = 0; d < 4; ++d) for (int r = 0; r < 16; ++r) o[d][r] *= al_l[crow(r, hi)]; } } while (0)
  f32x16 pA0, pA1, pB0, pB1; float mnA, mnB, alA, alB; bf16x8 pa0, pa1, pa2, pa3; const int NT = seq / KVBLK;
  constexpr int SE = 0, SO = SDEPTH - 1;
  SLOAD(SE, 0); asm volatile("s_waitcnt vmcnt(0)" ::: "memory"); SWRITE(0, SE); __syncthreads();
  qkt(pA0, pA1, K_lds, qr, r32, hi); partialSM(pA0, pA1, m_reg, mnA, alA);
  SLOAD(SO, KVBLK); if constexpr (SDEPTH == 2) { if (2 < NT) SLOAD(SE, 2 * KVBLK); }
  SWAIT(); SWRITE(1, SO); __syncthreads();
  for (int j = 1; j + 1 < NT; j += 2) {
    SBAR(); qkt(pB0, pB1, (bf16*)((char*)K_lds + SHM_K), qr, r32, hi);
    finishSM(pA0, pA1, alA, l_reg, pa0, pa1, pa2, pa3); SBAR();
    SLOAD(SO, (j + SDEPTH) * KVBLK); SBAR();
    pv_d0(o, vb0, pa0, pa1, pa2, pa3); partialSM(pB0, pB1, m_reg, mnB, alB);
    __syncthreads(); SWAIT(); SWRITE(0, SE);
    RESC(alB); __syncthreads();
    SBAR(); qkt(pA0, pA1, K_lds, qr, r32, hi);
    finishSM(pB0, pB1, alB, l_reg, pa0, pa1, pa2, pa3); SBAR();
    if (SDEPTH == 1 || j + 3 < NT) SLOAD(SE, (j + 1 + SDEPTH) * KVBLK); SBAR();
    pv_d0(o, vb0 + (int)SHM_V, pa0, pa1, pa2, pa3); partialSM(pA0, pA1, m_reg, mnA, alA);
    __syncthreads(); SWAIT(); SWRITE(1, SO);
    RESC(alA); __syncthreads();
  }
  SBAR(); qkt(pB0, pB1, (bf16*)((char*)K_lds + SHM_K), qr, r32, hi);
  finishSM(pA0, pA1, alA, l_reg, pa0, pa1, pa2, pa3); SBAR();
  pv_d0(o, vb0, pa0, pa1, pa2, pa3); partialSM(pB0, pB1, m_reg, mnB, alB);
  __syncthreads(); RESC(alB);
  finishSM(pB0, pB1, alB, l_reg, pa0, pa1, pa2, pa3); SBAR();
  pv_d0(o, vb0 + (int)SHM_V, pa0, pa1, pa2, pa3);
  if (hi == 0) li_l[r32] = l_reg; asm volatile("s_waitcnt lgkmcnt(0)" ::: "memory");
  float rli[16];
#pragma unroll
  for (int r = 0; r < 16; ++r) rli[r] = __builtin_amdgcn_rcpf(li_l[crow(r, hi)]);
  bf16* Ow = Ob + (long)(wid * QBLK) * LDO;
#pragma unroll
  for (int r = 0; r < 16; ++r) { int orow = crow(r, hi);
    for (int d0 = 0; d0 < 4; ++d0) { const float ov = o[d0][r] * rli[r]; unsigned uu = __float_as_uint(ov); uu += 0x7FFFu + ((uu >> 16) & 1u); Ow[(long)orow * LDO + d0 * 32 + r32] = (bf16)(uu >> 16); } }
#undef SLOAD
#undef SWRITE
#undef SWAIT
#undef RESC
}
}

#ifndef PHM
#define PHM 255
#endif
namespace mk {
__device__ const double INVD[64] = {1,0.86596432336006535,0.74989420933245587,0.64938163157621132,0.56234132519034907,0.48696752516586311,0.42169650342858223,0.36517412725483772,0.31622776601683794,0.27384196342643613,0.23713737056616552,0.20535250264571461,0.17782794100389229,0.15399265260594919,0.1333521432163324,0.11547819846894582,0.10000000000000001,0.086596432336006529,0.074989420933245579,0.064938163157621132,0.056234132519034911,0.048696752516586311,0.042169650342858224,0.036517412725483769,0.031622776601683791,0.027384196342643614,0.023713737056616554,0.02053525026457146,0.017782794100389229,0.015399265260594919,0.013335214321633241,0.011547819846894581,0.01,0.0086596432336006543,0.0074989420933245579,0.006493816315762113,0.005623413251903491,0.004869675251658631,0.0042169650342858229,0.0036517412725483771,0.0031622776601683794,0.0027384196342643613,0.0023713737056616554,0.002053525026457146,0.0017782794100389228,0.001539926526059492,0.0013335214321633241,0.0011547819846894581,0.001,0.00086596432336006539,0.00074989420933245586,0.00064938163157621134,0.0005623413251903491,0.0004869675251658631,0.00042169650342858224,0.0003651741272548377,0.00031622776601683794,0.00027384196342643611,0.00023713737056616554,0.00020535250264571461,0.00017782794100389227,0.00015399265260594919,0.0001333521432163324,0.00011547819846894582};
typedef unsigned short bf16_t;
typedef float f32x4 __attribute__((ext_vector_type(4)));
typedef unsigned u32x4 __attribute__((ext_vector_type(4)));
typedef unsigned u32x2 __attribute__((ext_vector_type(2)));
constexpr int DM = 4096, NPROJ = 16384, DFF = 16384, MH = 16384, MC = 8192;
constexpr size_t MiB = 1ull << 20;
constexpr size_t WS_CTL = 0, WS_WIN = 1 * MiB, WS_WOUT = WS_WIN + 128 * MiB, WS_WUP = WS_WOUT + 32 * MiB, WS_WDN = WS_WUP + 128 * MiB,
                 WS_HB = WS_WDN + 128 * MiB, WS_PROJ = WS_HB + 128 * MiB, WS_OB = WS_PROJ + 512 * MiB, WS_ST = WS_OB + 128 * MiB,
                 WS_PD = WS_ST + 128 * MiB, WS_END = WS_PD + 1 * MiB;
constexpr int LDS_BAR_OFF = 131072, LDS_BYTES = 131072 + 64;
constexpr float EPS = 1e-6f;

__device__ __forceinline__ float bf2f(unsigned b) { return __uint_as_float(b << 16); }
__device__ __forceinline__ float bflo(unsigned w) { return __uint_as_float(w << 16); }
__device__ __forceinline__ float bfhi(unsigned w) { return __uint_as_float(w & 0xffff0000u); }
__device__ __forceinline__ unsigned short f2bf(float f) { unsigned u = __float_as_uint(f); u += 0x7FFFu + ((u >> 16) & 1u); return (unsigned short)(u >> 16); }
__device__ __forceinline__ unsigned pk(float lo, float hi) { return pg8::cvt_pk_bf16(lo, hi); }

template <int ACT> struct EpiB {
    static constexpr bool PERM = true, AFTER_DRAIN = false;
    bf16_t* O; int ldc;
    __device__ __forceinline__ void operator()(const pg8::f32x4 (&acc)[2][2][4][2], const pg8::Unit& u, int wr, int wc, int fr, int fq) const {
        const int row0 = u.pm * 256 + wr * 64 + fr, col0 = u.pn * 256 + wc * 32 + 8 * fq;
#pragma unroll
        for (int ai = 0; ai < 2; ++ai)
#pragma unroll
            for (int m = 0; m < 4; ++m) { bf16_t* rowp = O + (size_t)(row0 + ai * 128 + m * 16) * ldc + col0;
#pragma unroll
                for (int bj = 0; bj < 2; ++bj) { pg8::f32x4 v0 = acc[ai][bj][m][0], v1 = acc[ai][bj][m][1];
                    if (ACT == 1) {
#pragma unroll
                        for (int j = 0; j < 4; ++j) { const float a = fmaxf(v0[j], 0.f), b = fmaxf(v1[j], 0.f); v0[j] = a * a; v1[j] = b * b; } }
                    pg8::u32x4 w; w.x = pk(v0[0], v0[1]); w.y = pk(v0[2], v0[3]); w.z = pk(v1[0], v1[1]); w.w = pk(v1[2], v1[3]);
                    *(pg8::u32x4*)(rowp + bj * 128) = w; } }
    }
};
struct EpiRes {
    static constexpr bool PERM = false, AFTER_DRAIN = false;
    const float* base; float* C; int ldc;
    __device__ __forceinline__ void operator()(const pg8::f32x4 (&acc)[2][2][4][2], const pg8::Unit& u, int wr, int wc, int fr, int fq) const {
        const int row0 = u.pm * 256 + wr * 64 + fr, col0 = u.pn * 256 + wc * 32 + 4 * fq;
#pragma unroll
        for (int ai = 0; ai < 2; ++ai)
#pragma unroll
            for (int m = 0; m < 4; ++m) { const size_t off = (size_t)(row0 + ai * 128 + m * 16) * ldc + col0;
#pragma unroll
                for (int bj = 0; bj < 2; ++bj)
#pragma unroll
                    for (int n = 0; n < 2; ++n) { const pg8::f32x4 b = *(const pg8::f32x4*)(base + off + bj * 128 + n * 16);
                        *(pg8::f32x4*)(C + off + bj * 128 + n * 16) = acc[ai][bj][m][n] + b; } }
    }
};

__device__ __forceinline__ void transpose_cvt(const float* __restrict__ W, bf16_t* __restrict__ Wt, int K, int N, float* tile, int bid, int nb) {
    const int tid = ltid(); const int ntn = N / 64, nt = (K / 64) * ntn;
    for (int t = bid; t < nt; t += nb) {
        const int tn = t % ntn, tk = t / ntn;
        const float* src = W + (size_t)(tk * 64) * N + tn * 64;
#pragma unroll
        for (int i = 0; i < 2; ++i) { const int r = (tid >> 4) + i * 32, c = (tid & 15) * 4; const f32x4 v = *(const f32x4*)(src + (size_t)r * N + c);
            tile[r * 65 + c] = v[0]; tile[r * 65 + c + 1] = v[1]; tile[r * 65 + c + 2] = v[2]; tile[r * 65 + c + 3] = v[3]; }
        __syncthreads();
        const int n = tid >> 3, k8 = (tid & 7) * 8; float v[8];
#pragma unroll
        for (int i = 0; i < 8; ++i) v[i] = tile[(k8 + i) * 65 + n];
        u32x4 w; w.x = pk(v[0], v[1]); w.y = pk(v[2], v[3]); w.z = pk(v[4], v[5]); w.w = pk(v[6], v[7]);
        *(u32x4*)(Wt + (size_t)(tn * 64 + n) * K + tk * 64 + k8) = w;
        __syncthreads();
    }
}

template <bool OUT_BF16>
__device__ __forceinline__ void rmsnorm_rows(const float* X, const float* __restrict__ w, void* out, int rows, int bid, int nb) {
    const int tid_ = ltid(); const int lane = tid_ & 63, wid = tid_ >> 6;
    for (int r = bid * 8 + wid; r < rows; r += nb * 8) {
        const float* x = X + (size_t)r * DM; f32x4 v[16]; float ss = 0.f;
#pragma unroll
        for (int i = 0; i < 16; ++i) { v[i] = *(const f32x4*)(x + i * 256 + lane * 4); ss += v[i][0] * v[i][0] + v[i][1] * v[i][1] + v[i][2] * v[i][2] + v[i][3] * v[i][3]; }
#pragma unroll
        for (int o = 32; o >= 1; o >>= 1) ss += __shfl_xor(ss, o);
        const float rs = rsqrtf(ss * (1.0f / DM) + EPS);
#pragma unroll
        for (int i = 0; i < 16; ++i) { const f32x4 ww = *(const f32x4*)(w + i * 256 + lane * 4); const f32x4 y = v[i] * rs * ww;
            if (OUT_BF16) { u32x2 o2; o2.x = pk(y[0], y[1]); o2.y = pk(y[2], y[3]); *(u32x2*)((bf16_t*)out + (size_t)r * DM + i * 256 + lane * 4) = o2; }
            else *(f32x4*)((float*)out + (size_t)r * DM + i * 256 + lane * 4) = y; }
    }
}

__device__ __forceinline__ void rope_phase(bf16_t* proj, int rows, int L, int bid, int nb) {
    const int tid_ = ltid(); const int lane = tid_ & 63, wid = tid_ >> 6, sub = lane >> 5, d = (lane & 31) * 2;
    const double i2pi = 0.15915494309189533577;
    for (int rp = bid * 8 + wid; rp < rows / 2; rp += nb * 8) {
        const int r = rp * 2 + sub, pos = r & (L - 1);
        double a0 = (double)pos * INVD[d] * i2pi, a1 = (double)pos * INVD[d + 1] * i2pi;
        a0 -= __builtin_rint(a0); a1 -= __builtin_rint(a1);
        const float f0 = (float)a0, f1 = (float)a1;
        const float c0 = __builtin_amdgcn_cosf(f0), s0 = __builtin_amdgcn_sinf(f0), c1 = __builtin_amdgcn_cosf(f1), s1 = __builtin_amdgcn_sinf(f1);
        bf16_t* row = proj + (size_t)r * NPROJ + d;
#pragma unroll 8
        for (int vct = 0; vct < 32; ++vct) { unsigned* p1 = (unsigned*)(row + vct * 128); unsigned* p2 = (unsigned*)(row + vct * 128 + 64);
            const unsigned w1 = *p1, w2 = *p2; const float x10 = bflo(w1), x11 = bfhi(w1), x20 = bflo(w2), x21 = bfhi(w2);
            *p1 = pk(x10 * c0 - x20 * s0, x11 * c1 - x21 * s1); *p2 = pk(x20 * c0 + x10 * s0, x21 * c1 + x11 * s1); }
    }
}

constexpr int HT = 256, HTB = 16;
template <bool PASS3>
__device__ __forceinline__ void hgrn_pass(bf16_t* proj, const float* __restrict__ hgrn_lb, float* ST, float* PD, int nseq, int L, float* lds, int bid, int nb) {
    const int tid = ltid(), g = tid >> 7, j = tid & 127;
    float* qs = lds + g * (3 * HTB * 128); float* fs = qs + HTB * 128; float* vs = fs + HTB * 128;
    const int NSC = L / HT, nitems = nseq * NSC * 8;
    const int sr = j >> 4, c8 = (j & 15) * 8;
    for (int it = bid; it < nitems; it += nb) {
        const int u = it * 4 + g, dir = u & 1, h = (u >> 1) & 15, sc = (u >> 5) % NSC, s = (u >> 5) / NSC;
        const size_t row0 = (size_t)s * L + (size_t)sc * HT;
        const int colq = 6144 + h * 128, colf = (dir ? 10240 : 8192) + h * 128, colv = 12288 + h * 128;
        float lb[8];
#pragma unroll
        for (int e = 0; e < 8; ++e) { const float a0 = hgrn_lb[dir * 4096 + h * 128 + c8 + e], a1 = hgrn_lb[dir * 4096 + 2048 + h * 128 + c8 + e]; lb[e] = 1.0f / (1.0f + __expf(a1 - a0)); }
        float S[128];
#pragma unroll
        for (int k = 0; k < 128; ++k) S[k] = PASS3 ? ST[(size_t)u * 16384 + k * 128 + j] : 0.f;
        float P = 1.f;
        u32x4 rq[2], rf[2], rv[2];
#define HLOAD(b) do { const size_t rb_ = row0 + (dir ? (HT - HTB * ((b) + 1)) : HTB * (b)); _Pragma("unroll") for (int i = 0; i < 2; ++i) { const bf16_t* p_ = proj + (rb_ + sr + 8 * i) * NPROJ + c8; \
            if (PASS3) rq[i] = *(const u32x4*)(p_ + colq); rf[i] = *(const u32x4*)(p_ + colf); rv[i] = *(const u32x4*)(p_ + colv); } } while (0)
        HLOAD(0);
        for (int b = 0; b < HT / HTB; ++b) {
            __syncthreads();
#pragma unroll
            for (int i = 0; i < 2; ++i) { const int ro = (sr + 8 * i) * 128 + c8;
#pragma unroll
                for (int e = 0; e < 4; ++e) {
                    const unsigned wf = rf[i][e], wv = rv[i][e];
                    const float f0 = bflo(wf), f1 = bfhi(wf);
                    fs[ro + 2 * e] = lb[2 * e] + (1.f - lb[2 * e]) / (1.f + __expf(-f0)); fs[ro + 2 * e + 1] = lb[2 * e + 1] + (1.f - lb[2 * e + 1]) / (1.f + __expf(-f1));
                    vs[ro + 2 * e] = bflo(wv); vs[ro + 2 * e + 1] = bfhi(wv);
                    if (PASS3) { const unsigned wq = rq[i][e]; const float q0 = bflo(wq), q1 = bfhi(wq); qs[ro + 2 * e] = q0 / (1.f + __expf(-q0)); qs[ro + 2 * e + 1] = q1 / (1.f + __expf(-q1)); }
                } }
            __syncthreads();
            if (b + 1 < HT / HTB) HLOAD(b + 1);
            const size_t rb = row0 + (dir ? (HT - HTB * (b + 1)) : HTB * b);
#pragma unroll 1
            for (int tt = 0; tt < HTB; ++tt) {
                const int t = dir ? (HTB - 1 - tt) : tt;
                const float v = vs[t * 128 + j]; float o = 0.f;
#pragma unroll
                for (int k4 = 0; k4 < 32; ++k4) { const f32x4 f4 = *(const f32x4*)(fs + t * 128 + k4 * 4);
#pragma unroll
                    for (int e = 0; e < 4; ++e) S[k4 * 4 + e] = fmaf(f4[e], S[k4 * 4 + e] - v, v);
                    if (PASS3) { const f32x4 q4 = *(const f32x4*)(qs + t * 128 + k4 * 4);
#pragma unroll
                        for (int e = 0; e < 4; ++e) o = fmaf(q4[e], S[k4 * 4 + e], o); } }
                if (PASS3) proj[(rb + t) * NPROJ + colf + j] = f2bf(o);
                else P *= fs[t * 128 + j];
            }
        }
#undef HLOAD
        if (!PASS3) {
#pragma unroll
            for (int k = 0; k < 128; ++k) ST[(size_t)u * 16384 + k * 128 + j] = S[k];
            PD[(size_t)u * 128 + j] = P; }
        __syncthreads();
    }
}
__device__ __forceinline__ void hgrn_scan(float* ST, const float* PD, int nseq, int NSC, int bid, int nb) {
    const int nitems = nseq * 32 * 32; const int tid_ = ltid();
    for (int it = bid; it < nitems; it += nb) {
        const int eb = it & 31, hd = (it >> 5) & 31, s = it >> 10, dir = hd & 1;
        const int e = eb * 512 + tid_, k = e >> 7; float carry = 0.f;
        for (int cc = 0; cc < NSC; cc += 4) { float E[4], p[4]; size_t ui[4];
#pragma unroll
            for (int q = 0; q < 4; ++q) { const int c = dir ? NSC - 1 - (cc + q) : (cc + q); ui[q] = ((size_t)(s * NSC + c)) * 32 + hd; E[q] = ST[ui[q] * 16384 + e]; p[q] = PD[ui[q] * 128 + k]; }
#pragma unroll
            for (int q = 0; q < 4; ++q) { ST[ui[q] * 16384 + e] = carry; carry = fmaf(p[q], carry, E[q]); } }
    }
}

__device__ __forceinline__ void combine_phase(const bf16_t* OB, const bf16_t* proj, bf16_t* mix, const float* __restrict__ dl, const float* __restrict__ subln_w, const float* __restrict__ hnw, int rows, int bid, int nb) {
    const int tid_ = ltid(); const int lane = tid_ & 63, wid = tid_ >> 6;
    float a = dl[lane] * dl[128 + lane] + dl[64 + lane] * dl[192 + lane], b = dl[256 + lane] * dl[384 + lane] + dl[320 + lane] * dl[448 + lane];
#pragma unroll
    for (int o = 32; o >= 1; o >>= 1) { a += __shfl_xor(a, o); b += __shfl_xor(b, o); }
    const float lam = expf(a) - expf(b) + 0.2f;
    for (int r = bid * 8 + wid; r < rows; r += nb * 8) {
#pragma unroll
        for (int i = 0; i < 4; ++i) { const int head = i * 2 + (lane >> 5), e = (lane & 31) * 8;
            const bf16_t* o0 = OB + (size_t)r * DM + head * 512 + e; const u32x4 x0 = *(const u32x4*)o0, x1 = *(const u32x4*)(o0 + 256);
            float dv[8]; float ss = 0.f;
#pragma unroll
            for (int q = 0; q < 4; ++q) { dv[2 * q] = bflo(x0[q]) - lam * bflo(x1[q]); dv[2 * q + 1] = bfhi(x0[q]) - lam * bfhi(x1[q]); ss += dv[2 * q] * dv[2 * q] + dv[2 * q + 1] * dv[2 * q + 1]; }
#pragma unroll
            for (int o = 16; o >= 1; o >>= 1) ss += __shfl_xor(ss, o);
            const float rs = rsqrtf(ss * (1.0f / 256.0f) + EPS) * 0.8f;
            const f32x4 w0 = *(const f32x4*)(subln_w + e), w1 = *(const f32x4*)(subln_w + e + 4);
            u32x4 w; w.x = pk(dv[0] * rs * w0[0], dv[1] * rs * w0[1]); w.y = pk(dv[2] * rs * w0[2], dv[3] * rs * w0[3]); w.z = pk(dv[4] * rs * w1[0], dv[5] * rs * w1[1]); w.w = pk(dv[6] * rs * w1[2], dv[7] * rs * w1[3]);
            *(u32x4*)(mix + (size_t)r * DM + head * 256 + e) = w; }
#pragma unroll
        for (int i = 0; i < 4; ++i) { const int col = i * 512 + lane * 8, dd = col & 127;
            const bf16_t* pr = proj + (size_t)r * NPROJ + col; const u32x4 xf = *(const u32x4*)(pr + 8192), xb = *(const u32x4*)(pr + 10240), xg = *(const u32x4*)(pr + 14336);
            float ov[8], gv[8]; float ss = 0.f;
#pragma unroll
            for (int q = 0; q < 4; ++q) { ov[2 * q] = bflo(xf[q]) + bflo(xb[q]); ov[2 * q + 1] = bfhi(xf[q]) + bfhi(xb[q]); gv[2 * q] = bflo(xg[q]); gv[2 * q + 1] = bfhi(xg[q]); ss += ov[2 * q] * ov[2 * q] + ov[2 * q + 1] * ov[2 * q + 1]; }
#pragma unroll
            for (int o = 8; o >= 1; o >>= 1) ss += __shfl_xor(ss, o);
            const float rs = rsqrtf(ss * (1.0f / 128.0f) + EPS);
            const f32x4 w0 = *(const f32x4*)(hnw + dd), w1 = *(const f32x4*)(hnw + dd + 4);
            float y[8];
#pragma unroll
            for (int q = 0; q < 8; ++q) { const float wq = q < 4 ? w0[q & 3] : w1[q & 3]; y[q] = ov[q] * rs * wq * (gv[q] / (1.f + __expf(-gv[q]))); }
            u32x4 w; w.x = pk(y[0], y[1]); w.y = pk(y[2], y[3]); w.z = pk(y[4], y[5]); w.w = pk(y[6], y[7]);
            *(u32x4*)(mix + (size_t)r * DM + 2048 + col) = w; }
    }
}

__device__ __forceinline__ void attn_phase(const bf16_t* proj, bf16_t* OB, int nseq, int L, char* lds, int bid, int nb) {
    const int nqb = L / 256, nunits = nseq * 32 * nqb;
    for (int u = bid; u < nunits; u += nb) {
        const int qb = u % nqb, r = u / nqb, vh = r & 1, c = (r >> 1) & 1, h = (r >> 2) & 7, s = r >> 5;
        const size_t row0 = (size_t)s * L;
        att::attn_dense_body<att::bf16>(proj + (row0 + (size_t)qb * 256) * NPROJ + h * 256 + c * 128, proj + row0 * NPROJ + 2048 + h * 256 + c * 128,
                                        proj + row0 * NPROJ + 4096 + h * 256 + vh * 128, OB + (row0 + (size_t)qb * 256) * DM + h * 512 + c * 256 + vh * 128, L, lds);
        __syncthreads();
    }
}

struct Params { const float* in[13]; float* out; unsigned char* ws; };

__global__ void __launch_bounds__(512, 2) fwd(Params p) {
    extern __shared__ __attribute__((aligned(16))) unsigned char lds[];
    const int tid = threadIdx.x, bid = blockIdx.x, nb = gridDim.x;
    if (tid < 4) ((unsigned*)(lds + LDS_BAR_OFF))[tid] = 0u;
    __syncthreads();
    XcdBarrier bar = xcd_barrier_post((unsigned*)(p.ws + WS_CTL), (volatile LAS unsigned*)(lds + LDS_BAR_OFF));
    const float* attn_norm_w = p.in[2]; const float* w_in = p.in[3]; const float* diff_lambda = p.in[4]; const float* subln_w = p.in[5];
    const float* hgrn_lb = p.in[6]; const float* hgrn_norm_w = p.in[7]; const float* w_out = p.in[8]; const float* mlp_norm_w = p.in[9];
    const float* w_up = p.in[10]; const float* w_down = p.in[11]; const float* final_norm_w = p.in[12];
    bf16_t* WIN = (bf16_t*)(p.ws + WS_WIN); bf16_t* WOUT = (bf16_t*)(p.ws + WS_WOUT); bf16_t* WUP = (bf16_t*)(p.ws + WS_WUP); bf16_t* WDN = (bf16_t*)(p.ws + WS_WDN);
    bf16_t* HB = (bf16_t*)(p.ws + WS_HB); bf16_t* PROJ = (bf16_t*)(p.ws + WS_PROJ); bf16_t* OB = (bf16_t*)(p.ws + WS_OB);
    float* ST = (float*)(p.ws + WS_ST); float* PD = (float*)(p.ws + WS_PD);
    PG8_LAS unsigned char* ldsl = (PG8_LAS unsigned char*)lds;

#if PHM & 1
    transpose_cvt(w_in, WIN, DM, NPROJ, (float*)lds, bid, nb);
    transpose_cvt(w_out, WOUT, DM, DM, (float*)lds, bid, nb);
    transpose_cvt(w_up, WUP, DM, DFF, (float*)lds, bid, nb);
    transpose_cvt(w_down, WDN, DFF, DM, (float*)lds, bid, nb);
#endif

    for (int hf = 0; hf < 2; ++hf) {
        const float* x = hf ? p.in[1] : p.in[0]; const int nseq = hf ? 1 : 8, L = hf ? 16384 : 2048;
        float* outp = p.out + (size_t)hf * MH * DM;
        rmsnorm_rows<true>(x, attn_norm_w, HB, MH, bid, nb);
        xcd_barrier(bar);
#if PHM & 2
        { pg8::Gemm g{HB, WIN, MH, NPROJ, DM}; pg8::StaticOrder S; S.init(MH, NPROJ, nb, bid); EpiB<0> E{PROJ, NPROJ};
          pg8::gemm_phase<EpiB<0>, pg8::StaticOrder>(ldsl, g, S, E, nullptr); }
#endif
        xcd_barrier(bar);
        rope_phase(PROJ, MH, L, bid, nb);
#if PHM & 4
        hgrn_pass<false>(PROJ, hgrn_lb, ST, PD, nseq, L, (float*)lds, bid, nb);
#endif
        xcd_barrier(bar);
        hgrn_scan(ST, PD, nseq, L / HT, bid, nb);
#if PHM & 8
        attn_phase(PROJ, OB, nseq, L, (char*)lds, bid, nb);
#endif
        xcd_barrier(bar);
#if PHM & 16
        hgrn_pass<true>(PROJ, hgrn_lb, ST, PD, nseq, L, (float*)lds, bid, nb);
#endif
        xcd_barrier(bar);
        combine_phase(OB, PROJ, HB, diff_lambda, subln_w, hgrn_norm_w, MH, bid, nb);
        xcd_barrier(bar);
#if PHM & 32
        { pg8::Gemm g{HB, WOUT, MH, DM, DM}; pg8::StaticOrder S; S.init(MH, DM, nb, bid); EpiRes E{x, outp, DM};
          pg8::gemm_phase<EpiRes, pg8::StaticOrder>(ldsl, g, S, E, nullptr); }
#endif
        xcd_barrier(bar);
        rmsnorm_rows<true>(outp, mlp_norm_w, HB, MH, bid, nb);
        xcd_barrier(bar);
        for (int ch = 0; ch < 2; ++ch) {
#if PHM & 64
            { pg8::Gemm g{HB + (size_t)ch * MC * DM, WUP, MC, DFF, DM}; pg8::StaticOrder S; S.init(MC, DFF, nb, bid); EpiB<1> E{PROJ, DFF};
              pg8::gemm_phase<EpiB<1>, pg8::StaticOrder>(ldsl, g, S, E, nullptr); }
#endif
            xcd_barrier(bar);
#if PHM & 128
            { float* oc = outp + (size_t)ch * MC * DM; pg8::Gemm g{PROJ, WDN, MC, DM, DFF}; pg8::StaticOrder S; S.init(MC, DM, nb, bid); EpiRes E{oc, oc, DM};
              pg8::gemm_phase<EpiRes, pg8::StaticOrder>(ldsl, g, S, E, nullptr); }
#endif
            xcd_barrier(bar);
        }
        rmsnorm_rows<false>(outp, final_norm_w, outp, MH, bid, nb);
    }
}
}

extern "C" void kernel_launch(void* const* d_in, const int* in_sizes, int n_in, void* d_out, int out_size, void* d_ws, size_t ws_size, hipStream_t stream) {
    static int grid = 0;
    if (grid == 0) {
        if (n_in != 13 || ws_size < mk::WS_END) { fprintf(stderr, "kernel_launch: n_in %d ws %zu (need %zu)\n", n_in, ws_size, (size_t)mk::WS_END); grid = -1; return; }
        int dev = 0, cus = 0, per_cu = 0;
        hipGetDevice(&dev); hipDeviceGetAttribute(&cus, hipDeviceAttributeMultiprocessorCount, dev);
        if (hipFuncSetAttribute((const void*)mk::fwd, hipFuncAttributeMaxDynamicSharedMemorySize, mk::LDS_BYTES) != hipSuccess) { fprintf(stderr, "kernel_launch: hipFuncSetAttribute failed\n"); grid = -1; return; }
        if (hipOccupancyMaxActiveBlocksPerMultiprocessor(&per_cu, (const void*)mk::fwd, 512, mk::LDS_BYTES) != hipSuccess || per_cu < 1) { fprintf(stderr, "kernel_launch: occupancy %d\n", per_cu); grid = -1; return; }
        (void)hipGetLastError();
        grid = cus;
    }
    if (grid < 0) return;
    hipMemsetAsync((char*)d_ws + mk::WS_CTL, 0, 65536, stream);
    mk::Params p{};
    for (int i = 0; i < 13; ++i) p.in[i] = (const float*)d_in[i];
    p.out = (float*)d_out; p.ws = (unsigned char*)d_ws;
    hipLaunchKernelGGL(mk::fwd, dim3(grid), dim3(512), mk::LDS_BYTES, stream, p);
}
```

```cpp
#include <hip/hip_runtime.h>
#include <cstdio>
#include <cstdint>
__device__ __forceinline__ int ltid() { int t = threadIdx.x; asm volatile("" : "+v"(t)); return t; }
__device__ __forceinline__ int lsg(int v) { asm volatile("" : "+s"(v)); return v; }
namespace pg8 {
#define PG8_LAS __attribute__((address_space(3)))
typedef unsigned short bf16_t;
typedef short bf16x8 __attribute__((ext_vector_type(8)));
typedef float f32x4 __attribute__((ext_vector_type(4)));
typedef unsigned u32x4 __attribute__((ext_vector_type(4)));
constexpr int BM = 256, BK = 64, HALF = 128, HTB = HALF * BK * 2  , STAGE_BYTES = 8 * HTB, NXCD = 8, WGM = 8;

__host__ __device__ __forceinline__ int lds_byte(int r, int c) { const int st = (r >> 4) * 2 + (c >> 5), rr = r & 15, cc = c & 31, ob = rr * 64 + cc * 2; return st * 1024 + (ob ^ (((ob >> 9) & 1) << 5)); }
__host__ __device__ __forceinline__ void stage_rc(int b, int& R, int& C) { const int st = b / 1024, sb = b % 1024, swz = sb ^ (((sb >> 9) & 1) << 5); R = (st >> 1) * 16 + swz / 64; C = (st & 1) * 32 + (swz % 64) / 2; }
__host__ __device__ __forceinline__ int perm32(int rho) { const int n = rho >> 4, i = rho & 15; return 8 * (i >> 2) + 4 * n + (i & 3); }

struct Unit { int pm, pn; };
struct Gemm { const bf16_t* A; const bf16_t* Bt; int M, N, K; };

struct StaticOrder {
    int nM, nN, nwg, G, c;
    __host__ __device__ void init(int M, int N, int G_, int c_) { nM = M / BM; nN = N / BM; nwg = nM * nN; G = G_; c = c_; }
    __host__ __device__ bool next(int i, Unit& u) const {
        const long L = (long)i * G + c; if (L >= nwg) return false;
        int wgid = (int)L; { const int q = nwg / NXCD, r = nwg % NXCD, xcd = wgid % NXCD, off = wgid / NXCD; wgid = (xcd < r ? xcd * (q + 1) : r * (q + 1) + (xcd - r) * q) + off; }
        const int nig = WGM * nN, gid = wgid / nig, fm = gid * WGM, gsz = (nM - fm) < WGM ? (nM - fm) : WGM;
        u.pm = fm + ((wgid % nig) % gsz); u.pn = (wgid % nig) / gsz; return true;
    }
    __device__ __forceinline__ void a_ready(const Unit&) const {}
    __device__ __forceinline__ void done(const Unit&) const {}
};
struct CountedOrder : StaticOrder {
    const unsigned* ready; unsigned need; unsigned* tmo;
    __device__ __forceinline__ void a_ready(const Unit& u) const {
        if (threadIdx.x < 64) {
            const unsigned long long t0 = __builtin_amdgcn_s_memrealtime(); unsigned polls = 0;
            while ((unsigned)__builtin_amdgcn_readfirstlane(__hip_atomic_load(ready + 64 * u.pm, __ATOMIC_RELAXED, __HIP_MEMORY_SCOPE_AGENT)) < need) {
                if ((++polls & 255u) == 0u && __builtin_amdgcn_readfirstlane(__hip_atomic_load(tmo, __ATOMIC_RELAXED, __HIP_MEMORY_SCOPE_AGENT)) != 0u) break;
                if (__builtin_amdgcn_s_memrealtime() - t0 > 2000000ull) {
                    if (threadIdx.x == 0) { unsigned expect = 0u; __hip_atomic_compare_exchange_strong(tmo + 1, &expect, 0x600u | (unsigned)(u.pm & 0xff), __ATOMIC_RELAXED, __ATOMIC_RELAXED, __HIP_MEMORY_SCOPE_AGENT); __hip_atomic_store(tmo, 1u, __ATOMIC_RELAXED, __HIP_MEMORY_SCOPE_AGENT); }
                    break; }
                __builtin_amdgcn_s_sleep(2); }
            __builtin_amdgcn_fence(__ATOMIC_ACQUIRE, "agent");
            asm volatile("s_waitcnt vmcnt(0)" ::: "memory");
        }
#if !defined(BROKEN_HOOK_NO_BARRIER)
        asm volatile("" ::: "memory"); __builtin_amdgcn_s_barrier(); asm volatile("" ::: "memory");
#endif
    }
};

__device__ __forceinline__ unsigned cvt_pk_bf16(float lo, float hi) { unsigned r; asm volatile("v_cvt_pk_bf16_f32 %0, %1, %2" : "=v"(r) : "v"(lo), "v"(hi)); return r; }
typedef float f32x2 __attribute__((ext_vector_type(2)));
__device__ __forceinline__ f32x2 gelu_pk(f32x2 v) {
    const f32x2 av = __builtin_elementwise_abs(v), d = av * 0.2316418882f + 1.0f;
    f32x2 t; t.x = __builtin_amdgcn_rcpf(d.x); t.y = __builtin_amdgcn_rcpf(d.y);
    f32x2 q = t * 0.5307027145f + (-0.7265760135f); q = q * t + 0.7107068705f; q = q * t + (-0.142248368f); q = q * t + 0.127414796f; q = q * t;
    const f32x2 s = (v * v) * (-0.72134752044f);
    f32x2 e; e.x = __builtin_amdgcn_exp2f(s.x); e.y = __builtin_amdgcn_exp2f(s.y);
    const f32x2 m = v * (q * e), r = v - m;
    f32x2 o; o.x = v.x < 0.f ? m.x : r.x; o.y = v.y < 0.f ? m.y : r.y; return o;
}

struct EpiF32 {
    static constexpr bool PERM = false, AFTER_DRAIN = false;
    float* C; int ldc; const float* bias;
    __device__ __forceinline__ void operator()(const f32x4 (&acc)[2][2][4][2], const Unit& u, int wr, int wc, int fr, int fq) const {
        const int row0 = u.pm * BM + wr * 64 + fr, col0 = u.pn * BM + wc * 32 + 4 * fq;
        f32x4 bv[2][2];
#pragma unroll
        for (int bj = 0; bj < 2; ++bj)
#pragma unroll
            for (int n = 0; n < 2; ++n) bv[bj][n] = bias ? *(const f32x4*)(bias + col0 + bj * HALF + n * 16) : (f32x4){0.f, 0.f, 0.f, 0.f};
#pragma unroll
        for (int ai = 0; ai < 2; ++ai)
#pragma unroll
            for (int m = 0; m < 4; ++m) { float* rowp = C + (size_t)(row0 + ai * HALF + m * 16) * ldc + col0;
#pragma unroll
                for (int bj = 0; bj < 2; ++bj)
#pragma unroll
                    for (int n = 0; n < 2; ++n) *(f32x4*)(rowp + bj * HALF + n * 16) = acc[ai][bj][m][n] + bv[bj][n]; }
    }
};
template <int ACT  > struct EpiBf16 {
    static constexpr bool PERM = true, AFTER_DRAIN = false;
    bf16_t* O; int ldc; const float* bias; int split_cols; size_t split_stride;
    __device__ __forceinline__ void operator()(const f32x4 (&acc)[2][2][4][2], const Unit& u, int wr, int wc, int fr, int fq) const {
        const int row0 = u.pm * BM + wr * 64 + fr; int colt = u.pn * BM; bf16_t* base = O;
        if (split_cols) { const int t = colt / split_cols; base += (size_t)t * split_stride; colt -= t * split_cols; }
        const int col0 = colt + wc * 32 + 8 * fq, bcol0 = u.pn * BM + wc * 32 + 8 * fq;
        f32x4 bv[2][2];
#pragma unroll
        for (int bj = 0; bj < 2; ++bj)
#pragma unroll
            for (int n = 0; n < 2; ++n) bv[bj][n] = bias ? *(const f32x4*)(bias + bcol0 + bj * HALF + 4 * n) : (f32x4){0.f, 0.f, 0.f, 0.f};
#pragma unroll
        for (int ai = 0; ai < 2; ++ai)
#pragma unroll
            for (int m = 0; m < 4; ++m) { bf16_t* rowp = base + (size_t)(row0 + ai * HALF + m * 16) * ldc + col0;
#pragma unroll
                for (int bj = 0; bj < 2; ++bj) { f32x4 v0 = acc[ai][bj][m][0] + bv[bj][0], v1 = acc[ai][bj][m][1] + bv[bj][1];
                    if (ACT == 1) { f32x2 a = gelu_pk((f32x2){v0[0], v0[1]}), b = gelu_pk((f32x2){v0[2], v0[3]}), c = gelu_pk((f32x2){v1[0], v1[1]}), d = gelu_pk((f32x2){v1[2], v1[3]});
                        v0 = (f32x4){a.x, a.y, b.x, b.y}; v1 = (f32x4){c.x, c.y, d.x, d.y}; }
                    if (ACT == 2) {
#pragma unroll
                        for (int j = 0; j < 4; ++j) { v0[j] = 0.5f * v0[j] * (1.0f + erff(v0[j] * 0.70710678f)); v1[j] = 0.5f * v1[j] * (1.0f + erff(v1[j] * 0.70710678f)); } }
                    u32x4 w; w.x = cvt_pk_bf16(v0[0], v0[1]); w.y = cvt_pk_bf16(v0[2], v0[3]); w.z = cvt_pk_bf16(v1[0], v1[1]); w.w = cvt_pk_bf16(v1[2], v1[3]);
                    *(u32x4*)(rowp + bj * HALF) = w; } }
    }
};
template <class Epi, class Sched, bool STAMP = false>
__device__ __forceinline__ void gemm_phase(PG8_LAS unsigned char* lds, const Gemm g, const Sched& S, const Epi& E, unsigned long long* stamps) {
    const int tid = ltid(), wid = __builtin_amdgcn_readfirstlane(tid >> 6), lane = tid & 63, wr = wid >> 2, wc = wid & 3, fr = lane & 15, fq = lane >> 4;
    const int K = g.K, nt = K / BK;
    int ts_lo = 0, ts_hi = 0, nts = 0; const unsigned long long rt_entry = STAMP ? (unsigned long long)wall_clock64() : 0ull;
#define PG8_STAMP() do { if (STAMP && wid == 0 && nts < 64) { const unsigned long long _c = (unsigned long long)clock64(); \
        ts_lo = (lane == nts) ? (int)(unsigned)_c : ts_lo; ts_hi = (lane == nts) ? (int)(unsigned)(_c >> 32) : ts_hi; ++nts; } } while (0)
    PG8_STAMP();
    unsigned voffA[2], voffB[2];
#pragma unroll
    for (int i = 0; i < 2; ++i) { int R, C; stage_rc(tid * 16 + i * 8192, R, C); const int Rb = Epi::PERM ? ((R & ~31) + perm32(R & 31)) : R;
        voffA[i] = (unsigned)(R * K + C) * 2u; voffB[i] = (unsigned)(Rb * K + C) * 2u; }
    const size_t kstep = (size_t)(BK * 2);
    const size_t hstep = (size_t)HALF * K * 2;
    const size_t tstep = 2 * hstep;
    const unsigned ldsw = (unsigned)wid * 1024u;
    const int aoff = lds_byte(wr * 64 + fr, fq * 8), boff = lds_byte(wc * 32 + fr, fq * 8);
#define PG8_SA(b, h) (((b) * 2 + (h)) * HTB)
#define PG8_SB(b, h) ((4 + (b) * 2 + (h)) * HTB)
#define PG8_STAGE(bufoff, gbase, voff) do { _Pragma("unroll") for (int _i = 0; _i < 2; ++_i) \
        __builtin_amdgcn_global_load_lds((const unsigned*)((const char*)(gbase) + (voff)[_i]), (PG8_LAS unsigned*)(lds + (bufoff) + ldsw + _i * 8192), 16, 0, 0); } while (0)
#define PG8_LDA(dst, b, h) do { _Pragma("unroll") for (int m = 0; m < 4; ++m) _Pragma("unroll") for (int k = 0; k < 2; ++k) dst[m][k] = *(const PG8_LAS bf16x8*)(lds + PG8_SA(b, h) + aoff + m * 2048 + k * 1024); } while (0)
#define PG8_LDB(dst, b, h) do { _Pragma("unroll") for (int n = 0; n < 2; ++n) _Pragma("unroll") for (int k = 0; k < 2; ++k) dst[n][k] = *(const PG8_LAS bf16x8*)(lds + PG8_SB(b, h) + boff + n * 2048 + k * 1024); } while (0)
#define PG8_MMA(ai, bj, At, Bt) do { __builtin_amdgcn_s_setprio(1); _Pragma("unroll") for (int m = 0; m < 4; ++m) _Pragma("unroll") for (int n = 0; n < 2; ++n) _Pragma("unroll") for (int k = 0; k < 2; ++k) \
        acc[ai][bj][m][n] = __builtin_amdgcn_mfma_f32_16x16x32_bf16(Bt[n][k], At[m][k], acc[ai][bj][m][n], 0, 0, 0); __builtin_amdgcn_s_setprio(0); } while (0)
#define PG8_WAIT_V(n) asm volatile("s_waitcnt vmcnt(" #n ")" ::: "memory")
#define PG8_WAIT_L(n) asm volatile("s_waitcnt lgkmcnt(" #n ")" ::: "memory")
#define PG8_BAR __builtin_amdgcn_s_barrier()
#define PG8_SCHED __builtin_amdgcn_sched_barrier(0)
    Unit cur, nxt; int ui = 0;
    if (!S.next(0, cur)) return;
    f32x4 acc[2][2][4][2];
#pragma unroll
    for (int a = 0; a < 2; ++a)
#pragma unroll
        for (int b = 0; b < 2; ++b)
#pragma unroll
            for (int m = 0; m < 4; ++m)
#pragma unroll
                for (int n = 0; n < 2; ++n) acc[a][b][m][n] = (f32x4){0.f, 0.f, 0.f, 0.f};
    bf16x8 At[4][2], B0[2][2], B1[2][2];
    const char* cA = (const char*)g.A + (size_t)cur.pm * tstep; const char* cB = (const char*)g.Bt + (size_t)cur.pn * tstep;
    S.a_ready(cur);
    PG8_STAGE(PG8_SB(0, 0), cB, voffB); PG8_STAGE(PG8_SA(0, 0), cA, voffA); PG8_STAGE(PG8_SB(0, 1), cB + hstep, voffB); PG8_STAGE(PG8_SA(0, 1), cA + hstep, voffA);
    if (wr == 1) PG8_BAR;
    PG8_WAIT_V(4); PG8_BAR;
    PG8_STAGE(PG8_SB(1, 0), cB + kstep, voffB); PG8_STAGE(PG8_SA(1, 0), cA + kstep, voffA); PG8_STAGE(PG8_SB(1, 1), cB + hstep + kstep, voffB);
    PG8_WAIT_V(6); PG8_BAR;
    PG8_STAMP();
    for (;;) {
        const bool has_next = S.next(ui + 1, nxt);
        const char* nA = has_next ? (const char*)g.A + (size_t)nxt.pm * tstep : cA; const char* nB = has_next ? (const char*)g.Bt + (size_t)nxt.pn * tstep : cB;
        for (int t = 0; t < nt; t += 2) {
            const bool last = (t == nt - 2);
            const char* a1 = cA + (size_t)(t + 1) * kstep;
            const char* a2 = last ? nA : cA + (size_t)(t + 2) * kstep; const char* b2 = last ? nB : cB + (size_t)(t + 2) * kstep;
            const char* a3 = a2 + kstep; const char* b3 = b2 + kstep;
            if (last && has_next) S.a_ready(nxt);
            PG8_LDB(B0, 0, 0); PG8_SCHED; PG8_LDA(At, 0, 0); PG8_STAGE(PG8_SA(1, 1), a1 + hstep, voffA);
            PG8_WAIT_L(8); PG8_BAR; PG8_WAIT_L(0); PG8_MMA(0, 0, At, B0); PG8_BAR; PG8_SCHED;
            PG8_LDB(B1, 0, 1); PG8_STAGE(PG8_SB(0, 0), b2, voffB);
            PG8_BAR; PG8_WAIT_L(0); PG8_MMA(0, 1, At, B1); PG8_BAR;
            PG8_LDA(At, 0, 1); PG8_STAGE(PG8_SA(0, 0), a2, voffA);
            PG8_BAR; PG8_WAIT_L(0); PG8_MMA(1, 0, At, B0); PG8_BAR; PG8_SCHED;
            PG8_STAGE(PG8_SB(0, 1), b2 + hstep, voffB);
            PG8_WAIT_V(6); PG8_BAR; PG8_MMA(1, 1, At, B1); PG8_BAR;
            PG8_LDB(B0, 1, 0); PG8_SCHED; PG8_LDA(At, 1, 0); PG8_STAGE(PG8_SA(0, 1), a2 + hstep, voffA);
            PG8_WAIT_L(8); PG8_BAR; PG8_WAIT_L(0); PG8_MMA(0, 0, At, B0); PG8_BAR; PG8_SCHED;
            PG8_LDB(B1, 1, 1); PG8_STAGE(PG8_SB(1, 0), b3, voffB);
            PG8_BAR; PG8_WAIT_L(0); PG8_MMA(0, 1, At, B1); PG8_BAR;
            PG8_LDA(At, 1, 1); PG8_STAGE(PG8_SA(1, 0), a3, voffA);
            PG8_BAR; PG8_WAIT_L(0); PG8_MMA(1, 0, At, B0); PG8_BAR; PG8_SCHED;
            PG8_STAGE(PG8_SB(1, 1), b3 + hstep, voffB);
            PG8_WAIT_V(6); PG8_BAR; PG8_MMA(1, 1, At, B1); PG8_BAR;
        }
        PG8_STAMP();
        if constexpr (!Epi::AFTER_DRAIN) { E(acc, cur, wr, wc, fr, fq); S.done(cur); }
        PG8_STAMP();
        if (!has_next) break;
#pragma unroll
        for (int a = 0; a < 2; ++a)
#pragma unroll
            for (int b = 0; b < 2; ++b)
#pragma unroll
                for (int m = 0; m < 4; ++m)
#pragma unroll
                    for (int n = 0; n < 2; ++n) acc[a][b][m][n] = (f32x4){0.f, 0.f, 0.f, 0.f};
        cur = nxt; cA = nA; cB = nB; ++ui;
    }
    PG8_WAIT_V(0);
    if (wr == 0) PG8_BAR;
    PG8_BAR;
    if constexpr (Epi::AFTER_DRAIN) { E.fused(acc, cur, wr, wc, fr, fq, lds, wid, lane); S.done(cur); }
    PG8_STAMP();
    if (STAMP && wid == 0) { stamps[lane] = lane < nts ? (((unsigned long long)(unsigned)ts_hi << 32) | (unsigned)ts_lo) : 0ull;
        if (lane == 62) stamps[62] = rt_entry; if (lane == 63) stamps[63] = (unsigned long long)wall_clock64(); }
#undef PG8_STAMP
#undef PG8_SA
#undef PG8_SB
#undef PG8_STAGE
#undef PG8_LDA
#undef PG8_LDB
#undef PG8_MMA
#undef PG8_WAIT_V
#undef PG8_WAIT_L
#undef PG8_BAR
#undef PG8_SCHED
}
}
#define XB_TMO      128
#define XB_XCNT(j)  (256  + 64 * (j))
#define XB_XSUB(j)  (1280 + 64 * (j))
#define XB_XGEN(j)  (2304 + 64 * (j))
#define XB_TOP      3328
#define XB_TOPGEN   3392
#define XCD_BAR_WORDS 3456
#define XB_SPIN_CAP (1u << 22)
#define LAS __attribute__((address_space(3)))

__device__ __forceinline__ unsigned xb_ld(unsigned* p)              { return __hip_atomic_load(p, __ATOMIC_RELAXED, __HIP_MEMORY_SCOPE_AGENT); }
__device__ __forceinline__ unsigned xb_add(unsigned* p, unsigned v) { return __hip_atomic_fetch_add(p, v, __ATOMIC_RELAXED, __HIP_MEMORY_SCOPE_AGENT); }
__device__ __forceinline__ unsigned xb_xcc_id() { return (unsigned)__builtin_amdgcn_s_getreg((3 << 11) | 20) & 0xFu; }
#define XB_SPIN(cond, bar) do { unsigned _sp = 0; while (cond) { __builtin_amdgcn_s_sleep(1); \
    if ((++_sp & 255u) == 0u) { if (xb_ld(&(bar)[XB_TMO])) break; if (_sp > XB_SPIN_CAP) { atomicAdd(&(bar)[XB_TMO], 1u); break; } } } } while (0)

struct XcdBarrier {
    unsigned* bar; unsigned x;
    volatile LAS unsigned* st;
};

__device__ __forceinline__ XcdBarrier xcd_barrier_post(unsigned* bar, volatile LAS unsigned* st) {
    XcdBarrier b; b.bar = bar; b.x = xb_xcc_id(); b.st = st;
    if (threadIdx.x == 0) (void)xb_add(&bar[XB_XCNT(b.x)], 1u);
    return b;
}
__device__ __forceinline__ void xcd_barrier_complete(unsigned* bar, unsigned x, unsigned& nloc, unsigned& nx) {
    const unsigned G = gridDim.x * gridDim.y * gridDim.z;
    unsigned sum, cnt, mine, sp = 0u;
    for (;;) {
        sum = 0u; cnt = 0u; mine = 0u;
#pragma unroll
        for (unsigned j = 0; j < 16; ++j) { const unsigned c = xb_ld(&bar[XB_XCNT(j)]); sum += c; cnt += (c > 0u) ? 1u : 0u; mine = (j == x) ? c : mine; }
        if (sum == G) break;
        __builtin_amdgcn_s_sleep(1);
        if ((++sp & 255u) == 0u) { if (xb_ld(&bar[XB_TMO])) break; if (sp > XB_SPIN_CAP) { atomicAdd(&bar[XB_TMO], 1u); break; } }
    }
    nloc = mine > 0u ? mine : 1u; nx = cnt > 0u ? cnt : 1u;
}

__device__ __forceinline__ void xcd_barrier(const XcdBarrier& b) {
    asm volatile("s_waitcnt vmcnt(0)" ::: "memory");
    __syncthreads();
    if (threadIdx.x == 0) {
        unsigned* bar = b.bar;
        __builtin_amdgcn_s_waitcnt(0);
        unsigned nloc = b.st[0], nx = b.st[1];
        if (nloc == 0u) { xcd_barrier_complete(bar, b.x, nloc, nx); b.st[0] = nloc; b.st[1] = nx; }
        const unsigned old = xb_add(&bar[XB_XSUB(b.x)], 1u);
        const unsigned gen = old / nloc;
        if (old + 1u == (gen + 1u) * nloc) {
            __builtin_amdgcn_fence(__ATOMIC_RELEASE, "agent");
            asm volatile("s_waitcnt vmcnt(0)" ::: "memory");
            const unsigned og = xb_add(&bar[XB_TOP], 1u);
            const unsigned tg = og / nx;
            if (og + 1u == (tg + 1u) * nx) xb_add(&bar[XB_TOPGEN], 1u);
            else XB_SPIN(xb_ld(&bar[XB_TOPGEN]) == tg, bar);
            __builtin_amdgcn_fence(__ATOMIC_ACQUIRE, "agent");
            xb_add(&bar[XB_XGEN(b.x)], 1u);
            asm volatile("s_waitcnt vmcnt(0)" ::: "memory");
        } else {
            XB_SPIN(xb_ld(&bar[XB_XGEN(b.x)]) == gen, bar);
            __builtin_amdgcn_fence(__ATOMIC_ACQUIRE, "agent");
            asm volatile("s_waitcnt vmcnt(0)" ::: "memory");
        }
    }
    __syncthreads();
}
namespace att {
using bf16 = unsigned short;
constexpr int   D = 128, NW = 8, QBLK = 32, KVBLK = 64;
constexpr float SCALE = 0.088388347648318440f;
constexpr float THR = 8.f;
constexpr int SDEPTH = 2;
constexpr int LDQ = 16512, LDK = 16512, LDO = 4096;
constexpr size_t SHM_V = KVBLK * D * 2, SHM_K = KVBLK * D * 2, SHM_ATTN = 2 * SHM_V + 2 * SHM_K + NW * 64 * 4;
using bf16x8 = __attribute__((ext_vector_type(8))) short;
using s16x4  = __attribute__((ext_vector_type(4))) short;
using f32x16 = __attribute__((ext_vector_type(16))) float;
using f32x8  = __attribute__((ext_vector_type(8))) float;
using u32x4  = __attribute__((ext_vector_type(4))) unsigned;
#define KSWZ(row, colB) ((row) * 256 + ((colB) ^ (((row) & 7) << 4)))
#define SBAR() __builtin_amdgcn_sched_barrier(0)
__device__ __forceinline__ int crow(int r, int hi) { return (r & 3) + 8 * (r >> 2) + 4 * hi; }
__device__ __forceinline__ unsigned cvtpk(float lo, float hi) {
  unsigned r; asm volatile("v_cvt_pk_bf16_f32 %0, %1, %2" : "=v"(r) : "v"(lo), "v"(hi)); return r;
}
template <typename TIn> struct Stage;
template <> struct Stage<bf16>  { using T = bf16x8;
  __device__ static __forceinline__ T ld8(const bf16* p) { return *reinterpret_cast<const bf16x8*>(p); }
  __device__ static __forceinline__ bf16x8 tobf(T x) { return x; } };
template <> struct Stage<float> { using T = f32x8;
  __device__ static __forceinline__ T ld8(const float* p) { return *reinterpret_cast<const f32x8*>(p); }
  __device__ static __forceinline__ bf16x8 tobf(T x) {
    u32x4 w = {cvtpk(x[0], x[1]), cvtpk(x[2], x[3]), cvtpk(x[4], x[5]), cvtpk(x[6], x[7])}; return *reinterpret_cast<bf16x8*>(&w); } };

__device__ __forceinline__ void partialSM(f32x16& p0, f32x16& p1, float& m_reg, float& mn, float& alpha) {
  constexpr float C = SCALE * 1.4426950408889634f;
  float pmax = p0[0]; for (int r = 1; r < 16; ++r) pmax = fmaxf(pmax, p0[r]); for (int r = 0; r < 16; ++r) pmax = fmaxf(pmax, p1[r]);
  { auto rr = __builtin_amdgcn_permlane32_swap(__float_as_uint(pmax), __float_as_uint(pmax), false, false);
    pmax = fmaxf(__uint_as_float(rr[0]), __uint_as_float(rr[1])); }
  if (__builtin_expect(__all(pmax - m_reg <= THR / SCALE), 1)) { mn = m_reg; alpha = 1.f; }
  else { mn = fmaxf(m_reg, pmax); alpha = __builtin_amdgcn_exp2f((m_reg - mn) * C); m_reg = mn; }
  float mnC = -mn * C;
  for (int r = 0; r < 16; ++r) p0[r] = fmaf(p0[r], C, mnC); for (int r = 0; r < 16; ++r) p1[r] = fmaf(p1[r], C, mnC);
  for (int r = 0; r < 16; ++r) p0[r] = __builtin_amdgcn_exp2f(p0[r]);
}
__device__ __forceinline__ void finishSM(f32x16& p0, f32x16& p1, float alpha, float& l_reg, bf16x8& pa0, bf16x8& pa1, bf16x8& pa2, bf16x8& pa3) {
  for (int r = 0; r < 16; ++r) p1[r] = __builtin_amdgcn_exp2f(p1[r]);
  float ps = 0; for (int r = 0; r < 16; ++r) ps += p0[r]; for (int r = 0; r < 16; ++r) ps += p1[r];
  { auto rr = __builtin_amdgcn_permlane32_swap(__float_as_uint(ps), __float_as_uint(ps), false, false);
    ps = __uint_as_float(rr[0]) + __uint_as_float(rr[1]); }
  l_reg = l_reg * alpha + ps;
#define PK4(P, BASE, OUT) do { unsigned a0 = cvtpk(P[BASE + 0], P[BASE + 1]), a1 = cvtpk(P[BASE + 2], P[BASE + 3]);   \
    unsigned b0 = cvtpk(P[BASE + 4], P[BASE + 5]), b1 = cvtpk(P[BASE + 6], P[BASE + 7]);                              \
    auto r0 = __builtin_amdgcn_permlane32_swap(a0, b0, false, false); auto r1 = __builtin_amdgcn_permlane32_swap(a1, b1, false, false); \
    u32x4 w = {r0[0], r1[0], r0[1], r1[1]}; OUT = *reinterpret_cast<bf16x8*>(&w); } while (0)
  PK4(p0, 0, pa0); PK4(p0, 8, pa1); PK4(p1, 0, pa2); PK4(p1, 8, pa3);
#undef PK4
}
__device__ __forceinline__ void qkt(f32x16& p0, f32x16& p1, const bf16* Ks, const bf16x8* qr, int r32, int hi) {
  p0 = f32x16{}; p1 = f32x16{};
  for (int d0 = 0; d0 < 8; ++d0) { int cb = (d0 * 16 + hi * 8) * 2;
    bf16x8 b0 = *reinterpret_cast<const bf16x8*>((const char*)Ks + KSWZ(r32, cb));
    bf16x8 b1 = *reinterpret_cast<const bf16x8*>((const char*)Ks + KSWZ(32 + r32, cb));
    p0 = __builtin_amdgcn_mfma_f32_32x32x16_bf16(b0, qr[d0], p0, 0, 0, 0);
    p1 = __builtin_amdgcn_mfma_f32_32x32x16_bf16(b1, qr[d0], p1, 0, 0, 0); }
}
__device__ __forceinline__ int v_st(int k, int c) { const int kk = (k & ~0xC) | ((k & 4) << 1) | ((k & 8) >> 1); return ((kk >> 3) * 4 + (c >> 5)) * 512 + ((kk & 7) * 32 + (c & 31)) * 2; }
__device__ __forceinline__ int v_rd_base(int lane) { return ((lane & 3) << 3) | (((lane >> 2) & 3) << 6) | (((lane >> 4) & 1) << 5) | (((lane >> 5) & 1) << 8); }
constexpr int v_rd_off(int d0, int ks, int half) { return d0 * 512 + ks * 4096 + half * 2048; }
template <int OFF> __device__ __forceinline__ s16x4 tr_read(int vb) {
  s16x4 r; asm volatile("ds_read_b64_tr_b16 %0, %1 offset:%2" : "=&v"(r) : "v"(vb), "i"(OFF) : "memory"); return r;
}
template <int D0> __device__ __forceinline__ void pv_one(f32x16& od, int vb, bf16x8 pa0, bf16x8 pa1, bf16x8 pa2, bf16x8 pa3) {
  const s16x4 l0 = tr_read<v_rd_off(D0, 0, 0)>(vb), h0 = tr_read<v_rd_off(D0, 0, 1)>(vb), l1 = tr_read<v_rd_off(D0, 1, 0)>(vb), h1 = tr_read<v_rd_off(D0, 1, 1)>(vb);
  const s16x4 l2 = tr_read<v_rd_off(D0, 2, 0)>(vb), h2 = tr_read<v_rd_off(D0, 2, 1)>(vb), l3 = tr_read<v_rd_off(D0, 3, 0)>(vb), h3 = tr_read<v_rd_off(D0, 3, 1)>(vb);
  asm volatile("s_waitcnt lgkmcnt(0)" ::: "memory"); SBAR();
#define PK(L, H) (bf16x8){L[0], L[1], L[2], L[3], H[0], H[1], H[2], H[3]}
  od = __builtin_amdgcn_mfma_f32_32x32x16_bf16(pa0, PK(l0, h0), od, 0, 0, 0);
  od = __builtin_amdgcn_mfma_f32_32x32x16_bf16(pa1, PK(l1, h1), od, 0, 0, 0);
  od = __builtin_amdgcn_mfma_f32_32x32x16_bf16(pa2, PK(l2, h2), od, 0, 0, 0);
  od = __builtin_amdgcn_mfma_f32_32x32x16_bf16(pa3, PK(l3, h3), od, 0, 0, 0);
#undef PK
}
__device__ __forceinline__ void pv_d0(f32x16* o, int vb, bf16x8 pa0, bf16x8 pa1, bf16x8 pa2, bf16x8 pa3) {
  pv_one<0>(o[0], vb, pa0, pa1, pa2, pa3); pv_one<1>(o[1], vb, pa0, pa1, pa2, pa3); pv_one<2>(o[2], vb, pa0, pa1, pa2, pa3); pv_one<3>(o[3], vb, pa0, pa1, pa2, pa3);
}

template <typename TQ>
__device__ __forceinline__ void attn_dense_body(const TQ* __restrict__ Qb, const bf16* __restrict__ Kh, const bf16* __restrict__ Vh,
                                                bf16* __restrict__ Ob, int seq, char* lds) {
  using St = Stage<bf16>; using SQ = Stage<TQ>;
  const int tid = ltid(), wid = tid >> 6, lane = tid & 63, r32 = lane & 31, hi = lane >> 5;
  bf16* V_lds = (bf16*)lds; bf16* K_lds = (bf16*)(lds + 2 * SHM_V);
  float* ws = (float*)(lds + 2 * SHM_V + 2 * SHM_K) + wid * 64; float* li_l = ws; float* al_l = ws + 32;
  float m_reg = -1e30f, l_reg = 0; f32x16 o[4] = {}; bf16x8 qr[8];
  const TQ* Qw = Qb + (long)(wid * QBLK + r32) * LDQ + hi * 8;
#pragma unroll
  for (int d0 = 0; d0 < 8; ++d0) qr[d0] = SQ::tobf(SQ::ld8(Qw + d0 * 16));
  const int sr = tid >> 4, sc = (tid & 15) * 8, vst0 = v_st(sr, sc), vst1 = v_st(32 + sr, sc);
  const int vb0 = (int)(uintptr_t)V_lds + v_rd_base(lane);
  struct { typename St::T vs0, vs1, ks0, ks1; } sr_[SDEPTH];
#define SLOAD(i, k0) do { sr_[i].vs0 = St::ld8(&Vh[(long)((k0) + sr) * LDK + sc]); sr_[i].vs1 = St::ld8(&Vh[(long)((k0) + 32 + sr) * LDK + sc]); \
    sr_[i].ks0 = St::ld8(&Kh[(long)((k0) + sr) * LDK + sc]); sr_[i].ks1 = St::ld8(&Kh[(long)((k0) + 32 + sr) * LDK + sc]); } while (0)
#define SWRITE(b, i) do { *(bf16x8*)((char*)V_lds + (b) * SHM_V + vst0) = St::tobf(sr_[i].vs0);          \
    *(bf16x8*)((char*)V_lds + (b) * SHM_V + vst1) = St::tobf(sr_[i].vs1); int kc = sc * 2;               \
    *(bf16x8*)((char*)K_lds + (b) * SHM_K + KSWZ(sr, kc)) = St::tobf(sr_[i].ks0);                       \
    *(bf16x8*)((char*)K_lds + (b) * SHM_K + KSWZ(32 + sr, kc)) = St::tobf(sr_[i].ks1); } while (0)
#define SWAIT() do { if constexpr (SDEPTH == 2) asm volatile("s_waitcnt vmcnt(4)" ::: "memory"); else asm volatile("s_waitcnt vmcnt(0)" ::: "memory"); } while (0)
#define RESC(a) do { if (__any((a) < 1.f)) { if (hi == 0) al_l[r32] = (a); asm volatile("s_waitcnt lgkmcnt(0)" ::: "memory"); \
    for (int d = 0; d < 4; ++d) for (int r = 0; r < 16; ++r) o[d][r] *= al_l[crow(r, hi)]; } } while (0)
  f32x16 pA0, pA1, pB0, pB1; float mnA, mnB, alA, alB; bf16x8 pa0, pa1, pa2, pa3; const int NT = seq / KVBLK;
  constexpr int SE = 0, SO = SDEPTH - 1;
  SLOAD(SE, 0); asm volatile("s_waitcnt vmcnt(0)" ::: "memory"); SWRITE(0, SE); __syncthreads();
  qkt(pA0, pA1, K_lds, qr, r32, hi); partialSM(pA0, pA1, m_reg, mnA, alA);
  SLOAD(SO, KVBLK); if constexpr (SDEPTH == 2) { if (2 < NT) SLOAD(SE, 2 * KVBLK); }
  SWAIT(); SWRITE(1, SO); __syncthreads();
  for (int j = 1; j + 1 < NT; j += 2) {
    SBAR(); qkt(pB0, pB1, (bf16*)((char*)K_lds + SHM_K), qr, r32, hi);
    finishSM(pA0, pA1, alA, l_reg, pa0, pa1, pa2, pa3); SBAR();
    SLOAD(SO, (j + SDEPTH) * KVBLK); SBAR();
    pv_d0(o, vb0, pa0, pa1, pa2, pa3); partialSM(pB0, pB1, m_reg, mnB, alB);
    __syncthreads(); SWAIT(); SWRITE(0, SE);
    RESC(alB); __syncthreads();
    SBAR(); qkt(pA0, pA1, K_lds, qr, r32, hi);
    finishSM(pB0, pB1, alB, l_reg, pa0, pa1, pa2, pa3); SBAR();
    if (SDEPTH == 1 || j + 3 < NT) SLOAD(SE, (j + 1 + SDEPTH) * KVBLK); SBAR();
    pv_d0(o, vb0 + (int)SHM_V, pa0, pa1, pa2, pa3); partialSM(pA0, pA1, m_reg, mnA, alA);
    __syncthreads(); SWAIT(); SWRITE(1, SO);
    RESC(alA); __syncthreads();
  }
  SBAR(); qkt(pB0, pB1, (bf16*)((char*)K_lds + SHM_K), qr, r32, hi);
  finishSM(pA0, pA1, alA, l_reg, pa0, pa1, pa2, pa3); SBAR();
  pv_d0(o, vb0, pa0, pa1, pa2, pa3); partialSM(pB0, pB1, m_reg, mnB, alB);
  __syncthreads(); RESC(alB);
  finishSM(pB0, pB1, alB, l_reg, pa0, pa1, pa2, pa3); SBAR();
  pv_d0(o, vb0 + (int)SHM_V, pa0, pa1, pa2, pa3);
  if (hi == 0) li_l[r32] = l_reg; asm volatile("s_waitcnt lgkmcnt(0)" ::: "memory");
  float rli[16];
#pragma unroll
  for (int r = 0; r < 16; ++r) rli[r] = __builtin_amdgcn_rcpf(li_l[crow(r, hi)]);
  bf16* Ow = Ob + (long)(wid * QBLK) * LDO;
#pragma unroll
  for (int r = 0; r < 16; ++r) { int orow = crow(r, hi);
    for (int d0 = 0; d0 < 4; ++d0) { const float ov = o[d0][r] * rli[r]; unsigned uu = __float_as_uint(ov); uu += 0x7FFFu + ((uu >> 16) & 1u); Ow[(long)orow * LDO + d0 * 32 + r32] = (bf16)(uu >> 16); } }
#undef SLOAD
#undef SWRITE
#undef SWAIT
#undef RESC
}
}

#ifndef PHM
#define PHM 255
#endif
namespace mk {
__device__ const double INVD[64] = {1,0.86596432336006535,0.74989420933245587,0.64938163157621132,0.56234132519034907,0.48696752516586311,0.42169650342858223,0.36517412725483772,0.31622776601683794,0.27384196342643613,0.23713737056616552,0.20535250264571461,0.17782794100389229,0.15399265260594919,0.1333521432163324,0.11547819846894582,0.10000000000000001,0.086596432336006529,0.074989420933245579,0.064938163157621132,0.056234132519034911,0.048696752516586311,0.042169650342858224,0.036517412725483769,0.031622776601683791,0.027384196342643614,0.023713737056616554,0.02053525026457146,0.017782794100389229,0.015399265260594919,0.013335214321633241,0.011547819846894581,0.01,0.0086596432336006543,0.0074989420933245579,0.006493816315762113,0.005623413251903491,0.004869675251658631,0.0042169650342858229,0.0036517412725483771,0.0031622776601683794,0.0027384196342643613,0.0023713737056616554,0.002053525026457146,0.0017782794100389228,0.001539926526059492,0.0013335214321633241,0.0011547819846894581,0.001,0.00086596432336006539,0.00074989420933245586,0.00064938163157621134,0.0005623413251903491,0.0004869675251658631,0.00042169650342858224,0.0003651741272548377,0.00031622776601683794,0.00027384196342643611,0.00023713737056616554,0.00020535250264571461,0.00017782794100389227,0.00015399265260594919,0.0001333521432163324,0.00011547819846894582};
typedef unsigned short bf16_t;
typedef float f32x4 __attribute__((ext_vector_type(4)));
typedef unsigned u32x4 __attribute__((ext_vector_type(4)));
typedef unsigned u32x2 __attribute__((ext_vector_type(2)));
typedef float f32x2 __attribute__((ext_vector_type(2)));
constexpr int DM = 4096, NPROJ = 16384, LDP = 16512  , DFF = 16384, MH = 16384, MC = 8192;
constexpr size_t MiB = 1ull << 20;
constexpr size_t WS_CTL = 0, WS_WIN = 1 * MiB, WS_WOUT = WS_WIN + 128 * MiB, WS_WUP = WS_WOUT + 32 * MiB, WS_WDN = WS_WUP + 128 * MiB,
                 WS_HB = WS_WDN + 128 * MiB, WS_PROJ = WS_HB + 128 * MiB, WS_OB = WS_PROJ + 520 * MiB, WS_ST = WS_OB + 128 * MiB,
                 WS_PD = WS_ST + 128 * MiB, WS_END = WS_PD + 1 * MiB;
constexpr int LDS_BAR_OFF = 135168, LDS_BYTES = 135168 + 64;
constexpr float EPS = 1e-6f;

__device__ __forceinline__ float bf2f(unsigned b) { return __uint_as_float(b << 16); }
__device__ __forceinline__ float bflo(unsigned w) { return __uint_as_float(w << 16); }
__device__ __forceinline__ float bfhi(unsigned w) { return __uint_as_float(w & 0xffff0000u); }
__device__ __forceinline__ unsigned short f2bf(float f) { unsigned u = __float_as_uint(f); u += 0x7FFFu + ((u >> 16) & 1u); return (unsigned short)(u >> 16); }
__device__ __forceinline__ unsigned pk(float lo, float hi) { return pg8::cvt_pk_bf16(lo, hi); }

template <int ACT> struct EpiB {
    static constexpr bool PERM = true, AFTER_DRAIN = false;
    bf16_t* O; int ldc;
    __device__ __forceinline__ void operator()(const pg8::f32x4 (&acc)[2][2][4][2], const pg8::Unit& u, int wr, int wc, int fr, int fq) const {
        const int row0 = u.pm * 256 + wr * 64 + fr, col0 = u.pn * 256 + wc * 32 + 8 * fq;
#pragma unroll
        for (int ai = 0; ai < 2; ++ai)
#pragma unroll
            for (int m = 0; m < 4; ++m) { bf16_t* rowp = O + (size_t)(row0 + ai * 128 + m * 16) * ldc + col0;
#pragma unroll
                for (int bj = 0; bj < 2; ++bj) { pg8::f32x4 v0 = acc[ai][bj][m][0], v1 = acc[ai][bj][m][1];
                    if (ACT == 1) {
#pragma unroll
                        for (int j = 0; j < 4; ++j) { const float a = fmaxf(v0[j], 0.f), b = fmaxf(v1[j], 0.f); v0[j] = a * a; v1[j] = b * b; } }
                    pg8::u32x4 w; w.x = pk(v0[0], v0[1]); w.y = pk(v0[2], v0[3]); w.z = pk(v1[0], v1[1]); w.w = pk(v1[2], v1[3]);
                    *(pg8::u32x4*)(rowp + bj * 128) = w; } }
    }
};
struct EpiRes {
    static constexpr bool PERM = false, AFTER_DRAIN = false;
    const float* base; float* C; int ldc;
    __device__ __forceinline__ void operator()(const pg8::f32x4 (&acc)[2][2][4][2], const pg8::Unit& u, int wr, int wc, int fr, int fq) const {
        const int row0 = u.pm * 256 + wr * 64 + fr, col0 = u.pn * 256 + wc * 32 + 4 * fq;
#pragma unroll
        for (int ai = 0; ai < 2; ++ai)
#pragma unroll
            for (int m = 0; m < 4; ++m) { const size_t off = (size_t)(row0 + ai * 128 + m * 16) * ldc + col0;
#pragma unroll
                for (int bj = 0; bj < 2; ++bj)
#pragma unroll
                    for (int n = 0; n < 2; ++n) { const pg8::f32x4 b = *(const pg8::f32x4*)(base + off + bj * 128 + n * 16);
                        *(pg8::f32x4*)(C + off + bj * 128 + n * 16) = acc[ai][bj][m][n] + b; } }
    }
};

__device__ __forceinline__ void transpose_cvt(const float* __restrict__ W, bf16_t* __restrict__ Wt, int K, int N, float* tile, int bid, int nb) {
    const int tid = ltid(); const int ntn = N / 64, nt = (K / 64) * ntn;
    f32x4 pv[2];
#define TLOAD(t_) do { const int tn_ = (t_) % ntn, tk_ = (t_) / ntn; const float* src_ = W + (size_t)(tk_ * 64) * N + tn_ * 64; \
        _Pragma("unroll") for (int i = 0; i < 2; ++i) pv[i] = *(const f32x4*)(src_ + (size_t)((tid >> 4) + i * 32) * N + (tid & 15) * 4); } while (0)
    if (bid < nt) TLOAD(bid);
    for (int t = bid; t < nt; t += nb) {
        const int tn = t % ntn, tk = t / ntn;
#pragma unroll
        for (int i = 0; i < 2; ++i) { const int r = (tid >> 4) + i * 32, c = (tid & 15) * 4;
            tile[r * 65 + c] = pv[i][0]; tile[r * 65 + c + 1] = pv[i][1]; tile[r * 65 + c + 2] = pv[i][2]; tile[r * 65 + c + 3] = pv[i][3]; }
        __syncthreads();
        if (t + nb < nt) TLOAD(t + nb);
        const int n = tid >> 3, k8 = (tid & 7) * 8; float v[8];
#pragma unroll
        for (int i = 0; i < 8; ++i) v[i] = tile[(k8 + i) * 65 + n];
        u32x4 w; w.x = pk(v[0], v[1]); w.y = pk(v[2], v[3]); w.z = pk(v[4], v[5]); w.w = pk(v[6], v[7]);
        *(u32x4*)(Wt + (size_t)(tn * 64 + n) * K + tk * 64 + k8) = w;
        __syncthreads();
    }
#undef TLOAD
}

template <bool OUT_BF16>
__device__ __forceinline__ void rmsnorm_rows(const float* X, const float* __restrict__ w, void* out, int rows, int bid, int nb) {
    const int tid_ = ltid(); const int lane = tid_ & 63, wid = tid_ >> 6;
    for (int r = bid * 8 + wid; r < rows; r += nb * 8) {
        const float* x = X + (size_t)r * DM; f32x4 v[16]; float ss = 0.f;
#pragma unroll
        for (int i = 0; i < 16; ++i) { v[i] = *(const f32x4*)(x + i * 256 + lane * 4); ss += v[i][0] * v[i][0] + v[i][1] * v[i][1] + v[i][2] * v[i][2] + v[i][3] * v[i][3]; }
#pragma unroll
        for (int o = 32; o >= 1; o >>= 1) ss += __shfl_xor(ss, o);
        const float rs = rsqrtf(ss * (1.0f / DM) + EPS);
#pragma unroll
        for (int i = 0; i < 16; ++i) { const f32x4 ww = *(const f32x4*)(w + i * 256 + lane * 4); const f32x4 y = v[i] * rs * ww;
            if (OUT_BF16) { u32x2 o2; o2.x = pk(y[0], y[1]); o2.y = pk(y[2], y[3]); *(u32x2*)((bf16_t*)out + (size_t)r * DM + i * 256 + lane * 4) = o2; }
            else *(f32x4*)((float*)out + (size_t)r * DM + i * 256 + lane * 4) = y; }
    }
}

__device__ __forceinline__ void rope_phase(bf16_t* proj, int rows, int L, int bid, int nb) {
    const int tid_ = ltid(); const int lane = tid_ & 63, wid = tid_ >> 6, sub = lane >> 5, d = (lane & 31) * 2;
    const double i2pi = 0.15915494309189533577;
    for (int rp = bid * 8 + wid; rp < rows / 2; rp += nb * 8) {
        const int r = rp * 2 + sub, pos = r & (L - 1);
        double a0 = (double)pos * INVD[d] * i2pi, a1 = (double)pos * INVD[d + 1] * i2pi;
        a0 -= __builtin_rint(a0); a1 -= __builtin_rint(a1);
        const float f0 = (float)a0, f1 = (float)a1;
        const float c0 = __builtin_amdgcn_cosf(f0), s0 = __builtin_amdgcn_sinf(f0), c1 = __builtin_amdgcn_cosf(f1), s1 = __builtin_amdgcn_sinf(f1);
        bf16_t* row = proj + (size_t)r * LDP + d;
#pragma unroll 8
        for (int vct = 0; vct < 32; ++vct) { unsigned* p1 = (unsigned*)(row + vct * 128); unsigned* p2 = (unsigned*)(row + vct * 128 + 64);
            const unsigned w1 = *p1, w2 = *p2; const float x10 = bflo(w1), x11 = bfhi(w1), x20 = bflo(w2), x21 = bfhi(w2);
            *p1 = pk(x10 * c0 - x20 * s0, x11 * c1 - x21 * s1); *p2 = pk(x20 * c0 + x10 * s0, x21 * c1 + x11 * s1); }
    }
}

constexpr int HT = 256, HTB = 16;
template <bool PASS3>
__device__ __forceinline__ void hgrn_pass(bf16_t* proj, const float* __restrict__ hgrn_lb, float* ST, float* PD, int nseq, int L, float* lds, int bid, int nb) {
    const int tid = ltid(), g = tid >> 7, j = tid & 127;
    float* qs = lds + g * (3 * HTB * 128); float* fs = qs + HTB * 128; float* vs = fs + HTB * 128;
    const int NSC = L / HT, nitems = nseq * NSC * 8;
    const int sr = j >> 4, c8 = (j & 15) * 8;
    for (int it = bid; it < nitems; it += nb) {
        const int u = it * 4 + g, dir = u & 1, h = (u >> 1) & 15, sc = (u >> 5) % NSC, s = (u >> 5) / NSC;
        const size_t row0 = (size_t)s * L + (size_t)sc * HT;
        const int colq = 6144 + h * 128, colf = (dir ? 10240 : 8192) + h * 128, colv = 12288 + h * 128;
        float lb[8];
#pragma unroll
        for (int e = 0; e < 8; ++e) { const float a0 = hgrn_lb[dir * 4096 + h * 128 + c8 + e], a1 = hgrn_lb[dir * 4096 + 2048 + h * 128 + c8 + e]; lb[e] = 1.0f / (1.0f + __expf(a1 - a0)); }
        float S[128];
#pragma unroll
        for (int k = 0; k < 128; ++k) S[k] = PASS3 ? ST[(size_t)u * 16384 + k * 128 + j] : 0.f;
        float P = 1.f;
        u32x4 rq[2], rf[2], rv[2];
#define HLOAD(b) do { const size_t rb_ = row0 + (dir ? (HT - HTB * ((b) + 1)) : HTB * (b)); _Pragma("unroll") for (int i = 0; i < 2; ++i) { const bf16_t* p_ = proj + (rb_ + sr + 8 * i) * LDP + c8; \
            if (PASS3) rq[i] = *(const u32x4*)(p_ + colq); rf[i] = *(const u32x4*)(p_ + colf); rv[i] = *(const u32x4*)(p_ + colv); } } while (0)
        HLOAD(0);
        for (int b = 0; b < HT / HTB; ++b) {
            __syncthreads();
#pragma unroll
            for (int i = 0; i < 2; ++i) { const int ro = (sr + 8 * i) * 128 + c8;
#pragma unroll
                for (int e = 0; e < 4; ++e) {
                    const unsigned wf = rf[i][e], wv = rv[i][e];
                    const float f0 = bflo(wf), f1 = bfhi(wf);
                    fs[ro + 2 * e] = lb[2 * e] + (1.f - lb[2 * e]) / (1.f + __expf(-f0)); fs[ro + 2 * e + 1] = lb[2 * e + 1] + (1.f - lb[2 * e + 1]) / (1.f + __expf(-f1));
                    vs[ro + 2 * e] = bflo(wv); vs[ro + 2 * e + 1] = bfhi(wv);
                    if (PASS3) { const unsigned wq = rq[i][e]; const float q0 = bflo(wq), q1 = bfhi(wq); qs[ro + 2 * e] = q0 / (1.f + __expf(-q0)); qs[ro + 2 * e + 1] = q1 / (1.f + __expf(-q1)); }
                } }
            __syncthreads();
            if (b + 1 < HT / HTB) HLOAD(b + 1);
            const size_t rb = row0 + (dir ? (HT - HTB * (b + 1)) : HTB * b);
#pragma unroll 1
            for (int tt = 0; tt < HTB; ++tt) {
                const int t = dir ? (HTB - 1 - tt) : tt;
                const float v = vs[t * 128 + j]; f32x2 o2 = {0.f, 0.f};
#pragma unroll
                for (int k4 = 0; k4 < 32; ++k4) { const f32x4 f4 = *(const f32x4*)(fs + t * 128 + k4 * 4);
#pragma unroll
                    for (int e = 0; e < 4; ++e) S[k4 * 4 + e] = fmaf(f4[e], S[k4 * 4 + e] - v, v);
                    if (PASS3) { const f32x4 q4 = *(const f32x4*)(qs + t * 128 + k4 * 4);
#pragma unroll
                        for (int e = 0; e < 4; e += 2) { const f32x2 qq = {q4[e], q4[e + 1]}, sv = {S[k4 * 4 + e], S[k4 * 4 + e + 1]}; o2 = __builtin_elementwise_fma(qq, sv, o2); } } }
                if (PASS3) proj[(rb + t) * LDP + colf + j] = f2bf(o2[0] + o2[1]);
                else P *= fs[t * 128 + j];
            }
        }
#undef HLOAD
        if (!PASS3) {
#pragma unroll
            for (int k = 0; k < 128; ++k) ST[(size_t)u * 16384 + k * 128 + j] = S[k];
            PD[(size_t)u * 128 + j] = P; }
        __syncthreads();
    }
}

constexpr int LDT = 264;
__device__ __forceinline__ void hgrn_ends(const bf16_t* proj, const float* __restrict__ hgrn_lb, float* ST, float* PD, int nseq, int L, unsigned char* lds, int bid, int nb) {
    const int tid = ltid(), grp = tid >> 7, x = tid & 127, wid = tid >> 6, lane = tid & 63, fr = lane & 15, fq = lane >> 4;
    bf16_t* wT = (bf16_t*)lds; bf16_t* vT = (bf16_t*)(lds + 128 * LDT * 2);
    const int NSC = L / HT, nunits = nseq * NSC * 32;
    for (int u = bid; u < nunits; u += nb) {
        const int dir = u & 1, h = (u >> 1) & 15, sc = (u >> 5) % NSC, s = (u >> 5) / NSC;
        const size_t row0 = (size_t)s * L + (size_t)sc * HT;
        if (grp == 0) {
            const bf16_t* pf = proj + row0 * LDP + (dir ? 10240 : 8192) + h * 128 + x;
            const float a0 = hgrn_lb[dir * 4096 + h * 128 + x], a1 = hgrn_lb[dir * 4096 + 2048 + h * 128 + x]; const float lb = 1.0f / (1.0f + __expf(a1 - a0));
            float R = 1.f; unsigned short raw[32], nxt[32];
#pragma unroll
            for (int i = 0; i < 32; ++i) { const int t = dir ? i : 255 - i; raw[i] = pf[(size_t)t * LDP]; }
#pragma unroll 1
            for (int tb = 0; tb < 8; ++tb) {
                if (tb < 7) {
#pragma unroll
                    for (int i = 0; i < 32; ++i) { const int t = dir ? (tb + 1) * 32 + i : 255 - ((tb + 1) * 32 + i); nxt[i] = pf[(size_t)t * LDP]; } }
#pragma unroll
                for (int i = 0; i < 32; ++i) { const int t = dir ? tb * 32 + i : 255 - (tb * 32 + i);
                    const float fraw = bf2f(raw[i]); const float f = lb + (1.f - lb) / (1.f + __expf(-fraw));
                    wT[x * LDT + t] = f2bf((1.f - f) * R); R *= f; }
#pragma unroll
                for (int i = 0; i < 32; ++i) raw[i] = nxt[i];
            }
            PD[(size_t)u * 128 + x] = R;
        } else if (grp < 3) {
            const bf16_t* pv = proj + (row0 + (size_t)(grp - 1) * 128) * LDP + 12288 + h * 128 + x; bf16_t* dst = vT + x * LDT + (grp - 1) * 128;
#pragma unroll 1
            for (int tb = 0; tb < 4; ++tb) { unsigned short raw[32];
#pragma unroll
                for (int i = 0; i < 32; ++i) raw[i] = pv[(size_t)(tb * 32 + i) * LDP];
#pragma unroll
                for (int i = 0; i < 32; i += 2) *(unsigned*)(dst + tb * 32 + i) = (unsigned)raw[i] | ((unsigned)raw[i + 1] << 16); }
        }
        __syncthreads();
        pg8::f32x4 acc[8];
#pragma unroll
        for (int jb = 0; jb < 8; ++jb) acc[jb] = (pg8::f32x4){0.f, 0.f, 0.f, 0.f};
#pragma unroll
        for (int ks = 0; ks < 8; ++ks) { const pg8::bf16x8 a = *(const pg8::bf16x8*)(wT + (wid * 16 + fr) * LDT + ks * 32 + fq * 8);
#pragma unroll
            for (int jb = 0; jb < 8; ++jb) { const pg8::bf16x8 b = *(const pg8::bf16x8*)(vT + (jb * 16 + fr) * LDT + ks * 32 + fq * 8);
                acc[jb] = __builtin_amdgcn_mfma_f32_16x16x32_bf16(a, b, acc[jb], 0, 0, 0); } }
        float* st = ST + (size_t)u * 16384;
#pragma unroll
        for (int jb = 0; jb < 8; ++jb)
#pragma unroll
            for (int i = 0; i < 4; ++i) st[(wid * 16 + fq * 4 + i) * 128 + jb * 16 + fr] = acc[jb][i];
        __syncthreads();
    }
}
__device__ __forceinline__ void hgrn_scan(float* ST, const float* PD, int nseq, int NSC, int bid, int nb) {
    const int nitems = nseq * 32 * 32; const int tid_ = ltid();
    for (int it = bid; it < nitems; it += nb) {
        const int eb = it & 31, hd = (it >> 5) & 31, s = it >> 10, dir = hd & 1;
        const int e = eb * 512 + tid_, k = e >> 7; float carry = 0.f;
        for (int cc = 0; cc < NSC; cc += 4) { float E[4], p[4]; size_t ui[4];
#pragma unroll
            for (int q = 0; q < 4; ++q) { const int c = dir ? NSC - 1 - (cc + q) : (cc + q); ui[q] = ((size_t)(s * NSC + c)) * 32 + hd; E[q] = ST[ui[q] * 16384 + e]; p[q] = PD[ui[q] * 128 + k]; }
#pragma unroll
            for (int q = 0; q < 4; ++q) { ST[ui[q] * 16384 + e] = carry; carry = fmaf(p[q], carry, E[q]); } }
    }
}

__device__ __forceinline__ void combine_phase(const bf16_t* OB, const bf16_t* proj, bf16_t* mix, const float* __restrict__ dl, const float* __restrict__ subln_w, const float* __restrict__ hnw, int rows, int bid, int nb) {
    const int tid_ = ltid(); const int lane = tid_ & 63, wid = tid_ >> 6;
    float a = dl[lane] * dl[128 + lane] + dl[64 + lane] * dl[192 + lane], b = dl[256 + lane] * dl[384 + lane] + dl[320 + lane] * dl[448 + lane];
#pragma unroll
    for (int o = 32; o >= 1; o >>= 1) { a += __shfl_xor(a, o); b += __shfl_xor(b, o); }
    const float lam = expf(a) - expf(b) + 0.2f;
    for (int r = bid * 8 + wid; r < rows; r += nb * 8) {
#pragma unroll
        for (int i = 0; i < 4; ++i) { const int head = i * 2 + (lane >> 5), e = (lane & 31) * 8;
            const bf16_t* o0 = OB + (size_t)r * DM + head * 512 + e; const u32x4 x0 = *(const u32x4*)o0, x1 = *(const u32x4*)(o0 + 256);
            float dv[8]; float ss = 0.f;
#pragma unroll
            for (int q = 0; q < 4; ++q) { dv[2 * q] = bflo(x0[q]) - lam * bflo(x1[q]); dv[2 * q + 1] = bfhi(x0[q]) - lam * bfhi(x1[q]); ss += dv[2 * q] * dv[2 * q] + dv[2 * q + 1] * dv[2 * q + 1]; }
#pragma unroll
            for (int o = 16; o >= 1; o >>= 1) ss += __shfl_xor(ss, o);
            const float rs = rsqrtf(ss * (1.0f / 256.0f) + EPS) * 0.8f;
            const f32x4 w0 = *(const f32x4*)(subln_w + e), w1 = *(const f32x4*)(subln_w + e + 4);
            u32x4 w; w.x = pk(dv[0] * rs * w0[0], dv[1] * rs * w0[1]); w.y = pk(dv[2] * rs * w0[2], dv[3] * rs * w0[3]); w.z = pk(dv[4] * rs * w1[0], dv[5] * rs * w1[1]); w.w = pk(dv[6] * rs * w1[2], dv[7] * rs * w1[3]);
            *(u32x4*)(mix + (size_t)r * DM + head * 256 + e) = w; }
#pragma unroll
        for (int i = 0; i < 4; ++i) { const int col = i * 512 + lane * 8, dd = col & 127;
            const bf16_t* pr = proj + (size_t)r * LDP + col; const u32x4 xf = *(const u32x4*)(pr + 8192), xb = *(const u32x4*)(pr + 10240), xg = *(const u32x4*)(pr + 14336);
            float ov[8], gv[8]; float ss = 0.f;
#pragma unroll
            for (int q = 0; q < 4; ++q) { ov[2 * q] = bflo(xf[q]) + bflo(xb[q]); ov[2 * q + 1] = bfhi(xf[q]) + bfhi(xb[q]); gv[2 * q] = bflo(xg[q]); gv[2 * q + 1] = bfhi(xg[q]); ss += ov[2 * q] * ov[2 * q] + ov[2 * q + 1] * ov[2 * q + 1]; }
#pragma unroll
            for (int o = 8; o >= 1; o >>= 1) ss += __shfl_xor(ss, o);
            const float rs = rsqrtf(ss * (1.0f / 128.0f) + EPS);
            const f32x4 w0 = *(const f32x4*)(hnw + dd), w1 = *(const f32x4*)(hnw + dd + 4);
            float y[8];
#pragma unroll
            for (int q = 0; q < 8; ++q) { const float wq = q < 4 ? w0[q & 3] : w1[q & 3]; y[q] = ov[q] * rs * wq * (gv[q] / (1.f + __expf(-gv[q]))); }
            u32x4 w; w.x = pk(y[0], y[1]); w.y = pk(y[2], y[3]); w.z = pk(y[4], y[5]); w.w = pk(y[6], y[7]);
            *(u32x4*)(mix + (size_t)r * DM + 2048 + col) = w; }
    }
}

__device__ __forceinline__ void attn_phase(const bf16_t* proj, bf16_t* OB, int nseq, int L, char* lds, int bid, int nb) {
    const int nqb = L / 256, nunits = nseq * 32 * nqb;
    for (int u = bid; u < nunits; u += nb) {
        const int qb = u % nqb, r = u / nqb, vh = r & 1, c = (r >> 1) & 1, h = (r >> 2) & 7, s = r >> 5;
        const size_t row0 = (size_t)s * L;
        att::attn_dense_body<att::bf16>(proj + (row0 + (size_t)qb * 256) * LDP + h * 256 + c * 128, proj + row0 * LDP + 2048 + h * 256 + c * 128,
                                        proj + row0 * LDP + 4096 + h * 256 + vh * 128, OB + (row0 + (size_t)qb * 256) * DM + h * 512 + c * 256 + vh * 128, L, lds);
        __syncthreads();
    }
}

struct Params { const float* in[13]; float* out; unsigned char* ws; };

__global__ void __launch_bounds__(512, 2) fwd(Params p) {
    extern __shared__ __attribute__((aligned(16))) unsigned char lds[];
    const int tid = threadIdx.x, bid = blockIdx.x, nb = gridDim.x;
    if (tid < 4) ((unsigned*)(lds + LDS_BAR_OFF))[tid] = 0u;
    __syncthreads();
    XcdBarrier bar = xcd_barrier_post((unsigned*)(p.ws + WS_CTL), (volatile LAS unsigned*)(lds + LDS_BAR_OFF));
    const float* attn_norm_w = p.in[2]; const float* w_in = p.in[3]; const float* diff_lambda = p.in[4]; const float* subln_w = p.in[5];
    const float* hgrn_lb = p.in[6]; const float* hgrn_norm_w = p.in[7]; const float* w_out = p.in[8]; const float* mlp_norm_w = p.in[9];
    const float* w_up = p.in[10]; const float* w_down = p.in[11]; const float* final_norm_w = p.in[12];
    bf16_t* WIN = (bf16_t*)(p.ws + WS_WIN); bf16_t* WOUT = (bf16_t*)(p.ws + WS_WOUT); bf16_t* WUP = (bf16_t*)(p.ws + WS_WUP); bf16_t* WDN = (bf16_t*)(p.ws + WS_WDN);
    bf16_t* HB = (bf16_t*)(p.ws + WS_HB); bf16_t* PROJ = (bf16_t*)(p.ws + WS_PROJ); bf16_t* OB = (bf16_t*)(p.ws + WS_OB);
    float* ST = (float*)(p.ws + WS_ST); float* PD = (float*)(p.ws + WS_PD);
    PG8_LAS unsigned char* ldsl = (PG8_LAS unsigned char*)lds;

#if PHM & 1
    transpose_cvt(w_in, WIN, DM, NPROJ, (float*)lds, bid, nb);
    transpose_cvt(w_out, WOUT, DM, DM, (float*)lds, bid, nb);
    transpose_cvt(w_up, WUP, DM, DFF, (float*)lds, bid, nb);
    transpose_cvt(w_down, WDN, DFF, DM, (float*)lds, bid, nb);
#endif

    for (int hf = 0; hf < 2; ++hf) {
        const float* x = hf ? p.in[1] : p.in[0]; const int nseq = hf ? 1 : 8, L = hf ? 16384 : 2048;
        float* outp = p.out + (size_t)hf * MH * DM;
        rmsnorm_rows<true>(x, attn_norm_w, HB, MH, bid, nb);
        xcd_barrier(bar);
#if PHM & 2
        { pg8::Gemm g{HB, WIN, MH, NPROJ, DM}; pg8::StaticOrder S; S.init(MH, NPROJ, nb, bid); EpiB<0> E{PROJ, LDP};
          pg8::gemm_phase<EpiB<0>, pg8::StaticOrder>(ldsl, g, S, E, nullptr); }
#endif
        xcd_barrier(bar);
        rope_phase(PROJ, MH, L, bid, nb);
#if PHM & 4
        hgrn_ends(PROJ, hgrn_lb, ST, PD, nseq, L, lds, bid, nb);
#endif
        xcd_barrier(bar);
        hgrn_scan(ST, PD, nseq, L / HT, bid, nb);
#if PHM & 8
        attn_phase(PROJ, OB, nseq, L, (char*)lds, bid, nb);
#endif
        xcd_barrier(bar);
#if PHM & 16
        hgrn_pass<true>(PROJ, hgrn_lb, ST, PD, nseq, L, (float*)lds, bid, nb);
#endif
        xcd_barrier(bar);
        combine_phase(OB, PROJ, HB, diff_lambda, subln_w, hgrn_norm_w, MH, bid, nb);
        xcd_barrier(bar);
#if PHM & 32
        { pg8::Gemm g{HB, WOUT, MH, DM, DM}; pg8::StaticOrder S; S.init(MH, DM, nb, bid); EpiRes E{x, outp, DM};
          pg8::gemm_phase<EpiRes, pg8::StaticOrder>(ldsl, g, S, E, nullptr); }
#endif
        xcd_barrier(bar);
        rmsnorm_rows<true>(outp, mlp_norm_w, HB, MH, bid, nb);
        xcd_barrier(bar);
        for (int ch = 0; ch < 2; ++ch) {
#if PHM & 64
            { pg8::Gemm g{HB + (size_t)ch * MC * DM, WUP, MC, DFF, DM}; pg8::StaticOrder S; S.init(MC, DFF, nb, bid); EpiB<1> E{PROJ, DFF};
              pg8::gemm_phase<EpiB<1>, pg8::StaticOrder>(ldsl, g, S, E, nullptr); }
#endif
            xcd_barrier(bar);
#if PHM & 128
            { float* oc = outp + (size_t)ch * MC * DM; pg8::Gemm g{PROJ, WDN, MC, DM, DFF}; pg8::StaticOrder S; S.init(MC, DM, nb, bid); EpiRes E{oc, oc, DM};
              pg8::gemm_phase<EpiRes, pg8::StaticOrder>(ldsl, g, S, E, nullptr); }
#endif
            xcd_barrier(bar);
        }
        rmsnorm_rows<false>(outp, final_norm_w, outp, MH, bid, nb);
    }
}
}

extern "C" void kernel_launch(void* const* d_in, const int* in_sizes, int n_in, void* d_out, int out_size, void* d_ws, size_t ws_size, hipStream_t stream) {
    static int grid = 0;
    if (grid == 0) {
        if (n_in != 13 || ws_size < mk::WS_END) { fprintf(stderr, "kernel_launch: n_in %d ws %zu (need %zu)\n", n_in, ws_size, (size_t)mk::WS_END); grid = -1; return; }
        int dev = 0, cus = 0, per_cu = 0;
        hipGetDevice(&dev); hipDeviceGetAttribute(&cus, hipDeviceAttributeMultiprocessorCount, dev);
        if (hipFuncSetAttribute((const void*)mk::fwd, hipFuncAttributeMaxDynamicSharedMemorySize, mk::LDS_BYTES) != hipSuccess) { fprintf(stderr, "kernel_launch: hipFuncSetAttribute failed\n"); grid = -1; return; }
        if (hipOccupancyMaxActiveBlocksPerMultiprocessor(&per_cu, (const void*)mk::fwd, 512, mk::LDS_BYTES) != hipSuccess || per_cu < 1) { fprintf(stderr, "kernel_launch: occupancy %d\n", per_cu); grid = -1; return; }
        (void)hipGetLastError();
        grid = cus;
    }
    if (grid < 0) return;
    hipMemsetAsync((char*)d_ws + mk::WS_CTL, 0, 65536, stream);
    mk::Params p{};
    for (int i = 0; i < 13; ++i) p.in[i] = (const float*)d_in[i];
    p.out = (float*)d_out; p.ws = (unsigned char*)d_ws;
    hipLaunchKernelGGL(mk::fwd, dim3(grid), dim3(512), mk::LDS_BYTES, stream, p);
}
```

```cpp
#include <hip/hip_runtime.h>
#include <cstdio>
#include <cstdint>
__device__ __forceinline__ int ltid() { int t = threadIdx.x; asm volatile("" : "+v"(t)); return t; }
__device__ __forceinline__ int lsg(int v) { asm volatile("" : "+s"(v)); return v; }
namespace pg8 {
#define PG8_LAS __attribute__((address_space(3)))
typedef unsigned short bf16_t;
typedef short bf16x8 __attribute__((ext_vector_type(8)));
typedef float f32x4 __attribute__((ext_vector_type(4)));
typedef unsigned u32x4 __attribute__((ext_vector_type(4)));
constexpr int BM = 256, BK = 64, HALF = 128, HTB = HALF * BK * 2  , STAGE_BYTES = 8 * HTB, NXCD = 8, WGM = 8;

__host__ __device__ __forceinline__ int lds_byte(int r, int c) { const int st = (r >> 4) * 2 + (c >> 5), rr = r & 15, cc = c & 31, ob = rr * 64 + cc * 2; return st * 1024 + (ob ^ (((ob >> 9) & 1) << 5)); }
__host__ __device__ __forceinline__ void stage_rc(int b, int& R, int& C) { const int st = b / 1024, sb = b % 1024, swz = sb ^ (((sb >> 9) & 1) << 5); R = (st >> 1) * 16 + swz / 64; C = (st & 1) * 32 + (swz % 64) / 2; }
__host__ __device__ __forceinline__ int perm32(int rho) { const int n = rho >> 4, i = rho & 15; return 8 * (i >> 2) + 4 * n + (i & 3); }

struct Unit { int pm, pn; };
struct Gemm { const bf16_t* A; const bf16_t* Bt; int M, N, K; };

struct StaticOrder {
    int nM, nN, nwg, G, c;
    __host__ __device__ void init(int M, int N, int G_, int c_) { nM = M / BM; nN = N / BM; nwg = nM * nN; G = G_; c = c_; }
    __host__ __device__ bool next(int i, Unit& u) const {
        const long L = (long)i * G + c; if (L >= nwg) return false;
        int wgid = (int)L; { const int q = nwg / NXCD, r = nwg % NXCD, xcd = wgid % NXCD, off = wgid / NXCD; wgid = (xcd < r ? xcd * (q + 1) : r * (q + 1) + (xcd - r) * q) + off; }
        const int nig = WGM * nN, gid = wgid / nig, fm = gid * WGM, gsz = (nM - fm) < WGM ? (nM - fm) : WGM;
        u.pm = fm + ((wgid % nig) % gsz); u.pn = (wgid % nig) / gsz; return true;
    }
    __device__ __forceinline__ void a_ready(const Unit&) const {}
    __device__ __forceinline__ void done(const Unit&) const {}
};
struct CountedOrder : StaticOrder {
    const unsigned* ready; unsigned need; unsigned* tmo;
    __device__ __forceinline__ void a_ready(const Unit& u) const {
        if (threadIdx.x < 64) {
            const unsigned long long t0 = __builtin_amdgcn_s_memrealtime(); unsigned polls = 0;
            while ((unsigned)__builtin_amdgcn_readfirstlane(__hip_atomic_load(ready + 64 * u.pm, __ATOMIC_RELAXED, __HIP_MEMORY_SCOPE_AGENT)) < need) {
                if ((++polls & 255u) == 0u && __builtin_amdgcn_readfirstlane(__hip_atomic_load(tmo, __ATOMIC_RELAXED, __HIP_MEMORY_SCOPE_AGENT)) != 0u) break;
                if (__builtin_amdgcn_s_memrealtime() - t0 > 2000000ull) {
                    if (threadIdx.x == 0) { unsigned expect = 0u; __hip_atomic_compare_exchange_strong(tmo + 1, &expect, 0x600u | (unsigned)(u.pm & 0xff), __ATOMIC_RELAXED, __ATOMIC_RELAXED, __HIP_MEMORY_SCOPE_AGENT); __hip_atomic_store(tmo, 1u, __ATOMIC_RELAXED, __HIP_MEMORY_SCOPE_AGENT); }
                    break; }
                __builtin_amdgcn_s_sleep(2); }
            __builtin_amdgcn_fence(__ATOMIC_ACQUIRE, "agent");
            asm volatile("s_waitcnt vmcnt(0)" ::: "memory");
        }
#if !defined(BROKEN_HOOK_NO_BARRIER)
        asm volatile("" ::: "memory"); __builtin_amdgcn_s_barrier(); asm volatile("" ::: "memory");
#endif
    }
};

__device__ __forceinline__ unsigned cvt_pk_bf16(float lo, float hi) { unsigned r; asm volatile("v_cvt_pk_bf16_f32 %0, %1, %2" : "=v"(r) : "v"(lo), "v"(hi)); return r; }
typedef float f32x2 __attribute__((ext_vector_type(2)));
__device__ __forceinline__ f32x2 gelu_pk(f32x2 v) {
    const f32x2 av = __builtin_elementwise_abs(v), d = av * 0.2316418882f + 1.0f;
    f32x2 t; t.x = __builtin_amdgcn_rcpf(d.x); t.y = __builtin_amdgcn_rcpf(d.y);
    f32x2 q = t * 0.5307027145f + (-0.7265760135f); q = q * t + 0.7107068705f; q = q * t + (-0.142248368f); q = q * t + 0.127414796f; q = q * t;
    const f32x2 s = (v * v) * (-0.72134752044f);
    f32x2 e; e.x = __builtin_amdgcn_exp2f(s.x); e.y = __builtin_amdgcn_exp2f(s.y);
    const f32x2 m = v * (q * e), r = v - m;
    f32x2 o; o.x = v.x < 0.f ? m.x : r.x; o.y = v.y < 0.f ? m.y : r.y; return o;
}

struct EpiF32 {
    static constexpr bool PERM = false, AFTER_DRAIN = false;
    float* C; int ldc; const float* bias;
    __device__ __forceinline__ void operator()(const f32x4 (&acc)[2][2][4][2], const Unit& u, int wr, int wc, int fr, int fq) const {
        const int row0 = u.pm * BM + wr * 64 + fr, col0 = u.pn * BM + wc * 32 + 4 * fq;
        f32x4 bv[2][2];
#pragma unroll
        for (int bj = 0; bj < 2; ++bj)
#pragma unroll
            for (int n = 0; n < 2; ++n) bv[bj][n] = bias ? *(const f32x4*)(bias + col0 + bj * HALF + n * 16) : (f32x4){0.f, 0.f, 0.f, 0.f};
#pragma unroll
        for (int ai = 0; ai < 2; ++ai)
#pragma unroll
            for (int m = 0; m < 4; ++m) { float* rowp = C + (size_t)(row0 + ai * HALF + m * 16) * ldc + col0;
#pragma unroll
                for (int bj = 0; bj < 2; ++bj)
#pragma unroll
                    for (int n = 0; n < 2; ++n) *(f32x4*)(rowp + bj * HALF + n * 16) = acc[ai][bj][m][n] + bv[bj][n]; }
    }
};
template <int ACT  > struct EpiBf16 {
    static constexpr bool PERM = true, AFTER_DRAIN = false;
    bf16_t* O; int ldc; const float* bias; int split_cols; size_t split_stride;
    __device__ __forceinline__ void operator()(const f32x4 (&acc)[2][2][4][2], const Unit& u, int wr, int wc, int fr, int fq) const {
        const int row0 = u.pm * BM + wr * 64 + fr; int colt = u.pn * BM; bf16_t* base = O;
        if (split_cols) { const int t = colt / split_cols; base += (size_t)t * split_stride; colt -= t * split_cols; }
        const int col0 = colt + wc * 32 + 8 * fq, bcol0 = u.pn * BM + wc * 32 + 8 * fq;
        f32x4 bv[2][2];
#pragma unroll
        for (int bj = 0; bj < 2; ++bj)
#pragma unroll
            for (int n = 0; n < 2; ++n) bv[bj][n] = bias ? *(const f32x4*)(bias + bcol0 + bj * HALF + 4 * n) : (f32x4){0.f, 0.f, 0.f, 0.f};
#pragma unroll
        for (int ai = 0; ai < 2; ++ai)
#pragma unroll
            for (int m = 0; m < 4; ++m) { bf16_t* rowp = base + (size_t)(row0 + ai * HALF + m * 16) * ldc + col0;
#pragma unroll
                for (int bj = 0; bj < 2; ++bj) { f32x4 v0 = acc[ai][bj][m][0] + bv[bj][0], v1 = acc[ai][bj][m][1] + bv[bj][1];
                    if (ACT == 1) { f32x2 a = gelu_pk((f32x2){v0[0], v0[1]}), b = gelu_pk((f32x2){v0[2], v0[3]}), c = gelu_pk((f32x2){v1[0], v1[1]}), d = gelu_pk((f32x2){v1[2], v1[3]});
                        v0 = (f32x4){a.x, a.y, b.x, b.y}; v1 = (f32x4){c.x, c.y, d.x, d.y}; }
                    if (ACT == 2) {
#pragma unroll
                        for (int j = 0; j < 4; ++j) { v0[j] = 0.5f * v0[j] * (1.0f + erff(v0[j] * 0.70710678f)); v1[j] = 0.5f * v1[j] * (1.0f + erff(v1[j] * 0.70710678f)); } }
                    u32x4 w; w.x = cvt_pk_bf16(v0[0], v0[1]); w.y = cvt_pk_bf16(v0[2], v0[3]); w.z = cvt_pk_bf16(v1[0], v1[1]); w.w = cvt_pk_bf16(v1[2], v1[3]);
                    *(u32x4*)(rowp + bj * HALF) = w; } }
    }
};
template <class Epi, class Sched, bool STAMP = false>
__device__ __forceinline__ void gemm_phase(PG8_LAS unsigned char* lds, const Gemm g, const Sched& S, const Epi& E, unsigned long long* stamps) {
    const int tid = ltid(), wid = __builtin_amdgcn_readfirstlane(tid >> 6), lane = tid & 63, wr = wid >> 2, wc = wid & 3, fr = lane & 15, fq = lane >> 4;
    const int K = g.K, nt = K / BK;
    int ts_lo = 0, ts_hi = 0, nts = 0; const unsigned long long rt_entry = STAMP ? (unsigned long long)wall_clock64() : 0ull;
#define PG8_STAMP() do { if (STAMP && wid == 0 && nts < 64) { const unsigned long long _c = (unsigned long long)clock64(); \
        ts_lo = (lane == nts) ? (int)(unsigned)_c : ts_lo; ts_hi = (lane == nts) ? (int)(unsigned)(_c >> 32) : ts_hi; ++nts; } } while (0)
    PG8_STAMP();
    unsigned voffA[2], voffB[2];
#pragma unroll
    for (int i = 0; i < 2; ++i) { int R, C; stage_rc(tid * 16 + i * 8192, R, C); const int Rb = Epi::PERM ? ((R & ~31) + perm32(R & 31)) : R;
        voffA[i] = (unsigned)(R * K + C) * 2u; voffB[i] = (unsigned)(Rb * K + C) * 2u; }
    const size_t kstep = (size_t)(BK * 2);
    const size_t hstep = (size_t)HALF * K * 2;
    const size_t tstep = 2 * hstep;
    const unsigned ldsw = (unsigned)wid * 1024u;
    const int aoff = lds_byte(wr * 64 + fr, fq * 8), boff = lds_byte(wc * 32 + fr, fq * 8);
#define PG8_SA(b, h) (((b) * 2 + (h)) * HTB)
#define PG8_SB(b, h) ((4 + (b) * 2 + (h)) * HTB)
#define PG8_STAGE(bufoff, gbase, voff) do { _Pragma("unroll") for (int _i = 0; _i < 2; ++_i) \
        __builtin_amdgcn_global_load_lds((const unsigned*)((const char*)(gbase) + (voff)[_i]), (PG8_LAS unsigned*)(lds + (bufoff) + ldsw + _i * 8192), 16, 0, 0); } while (0)
#define PG8_LDA(dst, b, h) do { _Pragma("unroll") for (int m = 0; m < 4; ++m) _Pragma("unroll") for (int k = 0; k < 2; ++k) dst[m][k] = *(const PG8_LAS bf16x8*)(lds + PG8_SA(b, h) + aoff + m * 2048 + k * 1024); } while (0)
#define PG8_LDB(dst, b, h) do { _Pragma("unroll") for (int n = 0; n < 2; ++n) _Pragma("unroll") for (int k = 0; k < 2; ++k) dst[n][k] = *(const PG8_LAS bf16x8*)(lds + PG8_SB(b, h) + boff + n * 2048 + k * 1024); } while (0)
#define PG8_MMA(ai, bj, At, Bt) do { __builtin_amdgcn_s_setprio(1); _Pragma("unroll") for (int m = 0; m < 4; ++m) _Pragma("unroll") for (int n = 0; n < 2; ++n) _Pragma("unroll") for (int k = 0; k < 2; ++k) \
        acc[ai][bj][m][n] = __builtin_amdgcn_mfma_f32_16x16x32_bf16(Bt[n][k], At[m][k], acc[ai][bj][m][n], 0, 0, 0); __builtin_amdgcn_s_setprio(0); } while (0)
#define PG8_WAIT_V(n) asm volatile("s_waitcnt vmcnt(" #n ")" ::: "memory")
#define PG8_WAIT_L(n) asm volatile("s_waitcnt lgkmcnt(" #n ")" ::: "memory")
#define PG8_BAR __builtin_amdgcn_s_barrier()
#define PG8_SCHED __builtin_amdgcn_sched_barrier(0)
    Unit cur, nxt; int ui = 0;
    if (!S.next(0, cur)) return;
    f32x4 acc[2][2][4][2];
#pragma unroll
    for (int a = 0; a < 2; ++a)
#pragma unroll
        for (int b = 0; b < 2; ++b)
#pragma unroll
            for (int m = 0; m < 4; ++m)
#pragma unroll
                for (int n = 0; n < 2; ++n) acc[a][b][m][n] = (f32x4){0.f, 0.f, 0.f, 0.f};
    bf16x8 At[4][2], B0[2][2], B1[2][2];
    const char* cA = (const char*)g.A + (size_t)cur.pm * tstep; const char* cB = (const char*)g.Bt + (size_t)cur.pn * tstep;
    S.a_ready(cur);
    PG8_STAGE(PG8_SB(0, 0), cB, voffB); PG8_STAGE(PG8_SA(0, 0), cA, voffA); PG8_STAGE(PG8_SB(0, 1), cB + hstep, voffB); PG8_STAGE(PG8_SA(0, 1), cA + hstep, voffA);
    if (wr == 1) PG8_BAR;
    PG8_WAIT_V(4); PG8_BAR;
    PG8_STAGE(PG8_SB(1, 0), cB + kstep, voffB); PG8_STAGE(PG8_SA(1, 0), cA + kstep, voffA); PG8_STAGE(PG8_SB(1, 1), cB + hstep + kstep, voffB);
    PG8_WAIT_V(6); PG8_BAR;
    PG8_STAMP();
    for (;;) {
        const bool has_next = S.next(ui + 1, nxt);
        const char* nA = has_next ? (const char*)g.A + (size_t)nxt.pm * tstep : cA; const char* nB = has_next ? (const char*)g.Bt + (size_t)nxt.pn * tstep : cB;
        for (int t = 0; t < nt; t += 2) {
            const bool last = (t == nt - 2);
            const char* a1 = cA + (size_t)(t + 1) * kstep;
            const char* a2 = last ? nA : cA + (size_t)(t + 2) * kstep; const char* b2 = last ? nB : cB + (size_t)(t + 2) * kstep;
            const char* a3 = a2 + kstep; const char* b3 = b2 + kstep;
            if (last && has_next) S.a_ready(nxt);
            PG8_LDB(B0, 0, 0); PG8_SCHED; PG8_LDA(At, 0, 0); PG8_STAGE(PG8_SA(1, 1), a1 + hstep, voffA);
            PG8_WAIT_L(8); PG8_BAR; PG8_WAIT_L(0); PG8_MMA(0, 0, At, B0); PG8_BAR; PG8_SCHED;
            PG8_LDB(B1, 0, 1); PG8_STAGE(PG8_SB(0, 0), b2, voffB);
            PG8_BAR; PG8_WAIT_L(0); PG8_MMA(0, 1, At, B1); PG8_BAR;
            PG8_LDA(At, 0, 1); PG8_STAGE(PG8_SA(0, 0), a2, voffA);
            PG8_BAR; PG8_WAIT_L(0); PG8_MMA(1, 0, At, B0); PG8_BAR; PG8_SCHED;
            PG8_STAGE(PG8_SB(0, 1), b2 + hstep, voffB);
            PG8_WAIT_V(6); PG8_BAR; PG8_MMA(1, 1, At, B1); PG8_BAR;
            PG8_LDB(B0, 1, 0); PG8_SCHED; PG8_LDA(At, 1, 0); PG8_STAGE(PG8_SA(0, 1), a2 + hstep, voffA);
            PG8_WAIT_L(8); PG8_BAR; PG8_WAIT_L(0); PG8_MMA(0, 0, At, B0); PG8_BAR; PG8_SCHED;
            PG8_LDB(B1, 1, 1); PG8_STAGE(PG8_SB(1, 0), b3, voffB);
            PG8_BAR; PG8_WAIT_L(0); PG8_MMA(0, 1, At, B1); PG8_BAR;
            PG8_LDA(At, 1, 1); PG8_STAGE(PG8_SA(1, 0), a3, voffA);
            PG8_BAR; PG8_WAIT_L(0); PG8_MMA(1, 0, At, B0); PG8_BAR; PG8_SCHED;
            PG8_STAGE(PG8_SB(1, 1), b3 + hstep, voffB);
            PG8_WAIT_V(6); PG8_BAR; PG8_MMA(1, 1, At, B1); PG8_BAR;
        }
        PG8_STAMP();
        if constexpr (!Epi::AFTER_DRAIN) { E(acc, cur, wr, wc, fr, fq); S.done(cur); }
        PG8_STAMP();
        if (!has_next) break;
#pragma unroll
        for (int a = 0; a < 2; ++a)
#pragma unroll
            for (int b = 0; b < 2; ++b)
#pragma unroll
                for (int m = 0; m < 4; ++m)
#pragma unroll
                    for (int n = 0; n < 2; ++n) acc[a][b][m][n] = (f32x4){0.f, 0.f, 0.f, 0.f};
        cur = nxt; cA = nA; cB = nB; ++ui;
    }
    PG8_WAIT_V(0);
    if (wr == 0) PG8_BAR;
    PG8_BAR;
    if constexpr (Epi::AFTER_DRAIN) { E.fused(acc, cur, wr, wc, fr, fq, lds, wid, lane); S.done(cur); }
    PG8_STAMP();
    if (STAMP && wid == 0) { stamps[lane] = lane < nts ? (((unsigned long long)(unsigned)ts_hi << 32) | (unsigned)ts_lo) : 0ull;
        if (lane == 62) stamps[62] = rt_entry; if (lane == 63) stamps[63] = (unsigned long long)wall_clock64(); }
#undef PG8_STAMP
#undef PG8_SA
#undef PG8_SB
#undef PG8_STAGE
#undef PG8_LDA
#undef PG8_LDB
#undef PG8_MMA
#undef PG8_WAIT_V
#undef PG8_WAIT_L
#undef PG8_BAR
#undef PG8_SCHED
}
}
#define XB_TMO      128
#define XB_XCNT(j)  (256  + 64 * (j))
#define XB_XSUB(j)  (1280 + 64 * (j))
#define XB_XGEN(j)  (2304 + 64 * (j))
#define XB_TOP      3328
#define XB_TOPGEN   3392
#define XCD_BAR_WORDS 3456
#define XB_SPIN_CAP (1u << 22)
#define LAS __attribute__((address_space(3)))

__device__ __forceinline__ unsigned xb_ld(unsigned* p)              { return __hip_atomic_load(p, __ATOMIC_RELAXED, __HIP_MEMORY_SCOPE_AGENT); }
__device__ __forceinline__ unsigned xb_add(unsigned* p, unsigned v) { return __hip_atomic_fetch_add(p, v, __ATOMIC_RELAXED, __HIP_MEMORY_SCOPE_AGENT); }
__device__ __forceinline__ unsigned xb_xcc_id() { return (unsigned)__builtin_amdgcn_s_getreg((3 << 11) | 20) & 0xFu; }
#define XB_SPIN(cond, bar) do { unsigned _sp = 0; while (cond) { __builtin_amdgcn_s_sleep(1); \
    if ((++_sp & 255u) == 0u) { if (xb_ld(&(bar)[XB_TMO])) break; if (_sp > XB_SPIN_CAP) { atomicAdd(&(bar)[XB_TMO], 1u); break; } } } } while (0)

struct XcdBarrier {
    unsigned* bar; unsigned x;
    volatile LAS unsigned* st;
};

__device__ __forceinline__ XcdBarrier xcd_barrier_post(unsigned* bar, volatile LAS unsigned* st) {
    XcdBarrier b; b.bar = bar; b.x = xb_xcc_id(); b.st = st;
    if (threadIdx.x == 0) (void)xb_add(&bar[XB_XCNT(b.x)], 1u);
    return b;
}
__device__ __forceinline__ void xcd_barrier_complete(unsigned* bar, unsigned x, unsigned& nloc, unsigned& nx) {
    const unsigned G = gridDim.x * gridDim.y * gridDim.z;
    unsigned sum, cnt, mine, sp = 0u;
    for (;;) {
        sum = 0u; cnt = 0u; mine = 0u;
#pragma unroll
        for (unsigned j = 0; j < 16; ++j) { const unsigned c = xb_ld(&bar[XB_XCNT(j)]); sum += c; cnt += (c > 0u) ? 1u : 0u; mine = (j == x) ? c : mine; }
        if (sum == G) break;
        __builtin_amdgcn_s_sleep(1);
        if ((++sp & 255u) == 0u) { if (xb_ld(&bar[XB_TMO])) break; if (sp > XB_SPIN_CAP) { atomicAdd(&bar[XB_TMO], 1u); break; } }
    }
    nloc = mine > 0u ? mine : 1u; nx = cnt > 0u ? cnt : 1u;
}

__device__ __forceinline__ void xcd_barrier(const XcdBarrier& b) {
    asm volatile("s_waitcnt vmcnt(0)" ::: "memory");
    __syncthreads();
    if (threadIdx.x == 0) {
        unsigned* bar = b.bar;
        __builtin_amdgcn_s_waitcnt(0);
        unsigned nloc = b.st[0], nx = b.st[1];
        if (nloc == 0u) { xcd_barrier_complete(bar, b.x, nloc, nx); b.st[0] = nloc; b.st[1] = nx; }
        const unsigned old = xb_add(&bar[XB_XSUB(b.x)], 1u);
        const unsigned gen = old / nloc;
        if (old + 1u == (gen + 1u) * nloc) {
            __builtin_amdgcn_fence(__ATOMIC_RELEASE, "agent");
            asm volatile("s_waitcnt vmcnt(0)" ::: "memory");
            const unsigned og = xb_add(&bar[XB_TOP], 1u);
            const unsigned tg = og / nx;
            if (og + 1u == (tg + 1u) * nx) xb_add(&bar[XB_TOPGEN], 1u);
            else XB_SPIN(xb_ld(&bar[XB_TOPGEN]) == tg, bar);
            __builtin_amdgcn_fence(__ATOMIC_ACQUIRE, "agent");
            xb_add(&bar[XB_XGEN(b.x)], 1u);
            asm volatile("s_waitcnt vmcnt(0)" ::: "memory");
        } else {
            XB_SPIN(xb_ld(&bar[XB_XGEN(b.x)]) == gen, bar);
            __builtin_amdgcn_fence(__ATOMIC_ACQUIRE, "agent");
            asm volatile("s_waitcnt vmcnt(0)" ::: "memory");
        }
    }
    __syncthreads();
}
namespace att {
using bf16 = unsigned short;
constexpr int   D = 128, NW = 8, QBLK = 32, KVBLK = 64;
constexpr float SCALE = 0.088388347648318440f;
constexpr float THR = 8.f;
constexpr int SDEPTH = 2;
constexpr int LDQ = 16512, LDK = 16512, LDO = 4096;
constexpr size_t SHM_V = KVBLK * D * 2, SHM_K = KVBLK * D * 2, SHM_ATTN = 2 * SHM_V + 2 * SHM_K + NW * 64 * 4;
using bf16x8 = __attribute__((ext_vector_type(8))) short;
using s16x4  = __attribute__((ext_vector_type(4))) short;
using f32x16 = __attribute__((ext_vector_type(16))) float;
using f32x8  = __attribute__((ext_vector_type(8))) float;
using u32x4  = __attribute__((ext_vector_type(4))) unsigned;
#define KSWZ(row, colB) ((row) * 256 + ((colB) ^ (((row) & 7) << 4)))
#define SBAR() __builtin_amdgcn_sched_barrier(0)
__device__ __forceinline__ int crow(int r, int hi) { return (r & 3) + 8 * (r >> 2) + 4 * hi; }
__device__ __forceinline__ unsigned cvtpk(float lo, float hi) {
  unsigned r; asm volatile("v_cvt_pk_bf16_f32 %0, %1, %2" : "=v"(r) : "v"(lo), "v"(hi)); return r;
}
template <typename TIn> struct Stage;
template <> struct Stage<bf16>  { using T = bf16x8;
  __device__ static __forceinline__ T ld8(const bf16* p) { return *reinterpret_cast<const bf16x8*>(p); }
  __device__ static __forceinline__ bf16x8 tobf(T x) { return x; } };
template <> struct Stage<float> { using T = f32x8;
  __device__ static __forceinline__ T ld8(const float* p) { return *reinterpret_cast<const f32x8*>(p); }
  __device__ static __forceinline__ bf16x8 tobf(T x) {
    u32x4 w = {cvtpk(x[0], x[1]), cvtpk(x[2], x[3]), cvtpk(x[4], x[5]), cvtpk(x[6], x[7])}; return *reinterpret_cast<bf16x8*>(&w); } };

__device__ __forceinline__ void partialSM(f32x16& p0, f32x16& p1, float& m_reg, float& mn, float& alpha) {
  constexpr float C = SCALE * 1.4426950408889634f;
  float pmax = p0[0]; for (int r = 1; r < 16; ++r) pmax = fmaxf(pmax, p0[r]); for (int r = 0; r < 16; ++r) pmax = fmaxf(pmax, p1[r]);
  { auto rr = __builtin_amdgcn_permlane32_swap(__float_as_uint(pmax), __float_as_uint(pmax), false, false);
    pmax = fmaxf(__uint_as_float(rr[0]), __uint_as_float(rr[1])); }
  if (__builtin_expect(__all(pmax - m_reg <= THR / SCALE), 1)) { mn = m_reg; alpha = 1.f; }
  else { mn = fmaxf(m_reg, pmax); alpha = __builtin_amdgcn_exp2f((m_reg - mn) * C); m_reg = mn; }
  float mnC = -mn * C;
  for (int r = 0; r < 16; ++r) p0[r] = fmaf(p0[r], C, mnC); for (int r = 0; r < 16; ++r) p1[r] = fmaf(p1[r], C, mnC);
  for (int r = 0; r < 16; ++r) p0[r] = __builtin_amdgcn_exp2f(p0[r]);
}
__device__ __forceinline__ void finishSM(f32x16& p0, f32x16& p1, float alpha, float& l_reg, bf16x8& pa0, bf16x8& pa1, bf16x8& pa2, bf16x8& pa3) {
  for (int r = 0; r < 16; ++r) p1[r] = __builtin_amdgcn_exp2f(p1[r]);
  float ps = 0; for (int r = 0; r < 16; ++r) ps += p0[r]; for (int r = 0; r < 16; ++r) ps += p1[r];
  { auto rr = __builtin_amdgcn_permlane32_swap(__float_as_uint(ps), __float_as_uint(ps), false, false);
    ps = __uint_as_float(rr[0]) + __uint_as_float(rr[1]); }
  l_reg = l_reg * alpha + ps;
#define PK4(P, BASE, OUT) do { unsigned a0 = cvtpk(P[BASE + 0], P[BASE + 1]), a1 = cvtpk(P[BASE + 2], P[BASE + 3]);   \
    unsigned b0 = cvtpk(P[BASE + 4], P[BASE + 5]), b1 = cvtpk(P[BASE + 6], P[BASE + 7]);                              \
    auto r0 = __builtin_amdgcn_permlane32_swap(a0, b0, false, false); auto r1 = __builtin_amdgcn_permlane32_swap(a1, b1, false, false); \
    u32x4 w = {r0[0], r1[0], r0[1], r1[1]}; OUT = *reinterpret_cast<bf16x8*>(&w); } while (0)
  PK4(p0, 0, pa0); PK4(p0, 8, pa1); PK4(p1, 0, pa2); PK4(p1, 8, pa3);
#undef PK4
}
__device__ __forceinline__ void qkt(f32x16& p0, f32x16& p1, const bf16* Ks, const bf16x8* qr, int r32, int hi) {
  p0 = f32x16{}; p1 = f32x16{};
  for (int d0 = 0; d0 < 8; ++d0) { int cb = (d0 * 16 + hi * 8) * 2;
    bf16x8 b0 = *reinterpret_cast<const bf16x8*>((const char*)Ks + KSWZ(r32, cb));
    bf16x8 b1 = *reinterpret_cast<const bf16x8*>((const char*)Ks + KSWZ(32 + r32, cb));
    p0 = __builtin_amdgcn_mfma_f32_32x32x16_bf16(b0, qr[d0], p0, 0, 0, 0);
    p1 = __builtin_amdgcn_mfma_f32_32x32x16_bf16(b1, qr[d0], p1, 0, 0, 0); }
}
__device__ __forceinline__ int v_st(int k, int c) { const int kk = (k & ~0xC) | ((k & 4) << 1) | ((k & 8) >> 1); return ((kk >> 3) * 4 + (c >> 5)) * 512 + ((kk & 7) * 32 + (c & 31)) * 2; }
__device__ __forceinline__ int v_rd_base(int lane) { return ((lane & 3) << 3) | (((lane >> 2) & 3) << 6) | (((lane >> 4) & 1) << 5) | (((lane >> 5) & 1) << 8); }
constexpr int v_rd_off(int d0, int ks, int half) { return d0 * 512 + ks * 4096 + half * 2048; }
template <int OFF> __device__ __forceinline__ s16x4 tr_read(int vb) {
  s16x4 r; asm volatile("ds_read_b64_tr_b16 %0, %1 offset:%2" : "=&v"(r) : "v"(vb), "i"(OFF) : "memory"); return r;
}
template <int D0> __device__ __forceinline__ void pv_one(f32x16& od, int vb, bf16x8 pa0, bf16x8 pa1, bf16x8 pa2, bf16x8 pa3) {
  const s16x4 l0 = tr_read<v_rd_off(D0, 0, 0)>(vb), h0 = tr_read<v_rd_off(D0, 0, 1)>(vb), l1 = tr_read<v_rd_off(D0, 1, 0)>(vb), h1 = tr_read<v_rd_off(D0, 1, 1)>(vb);
  const s16x4 l2 = tr_read<v_rd_off(D0, 2, 0)>(vb), h2 = tr_read<v_rd_off(D0, 2, 1)>(vb), l3 = tr_read<v_rd_off(D0, 3, 0)>(vb), h3 = tr_read<v_rd_off(D0, 3, 1)>(vb);
  asm volatile("s_waitcnt lgkmcnt(0)" ::: "memory"); SBAR();
#define PK(L, H) (bf16x8){L[0], L[1], L[2], L[3], H[0], H[1], H[2], H[3]}
  od = __builtin_amdgcn_mfma_f32_32x32x16_bf16(pa0, PK(l0, h0), od, 0, 0, 0);
  od = __builtin_amdgcn_mfma_f32_32x32x16_bf16(pa1, PK(l1, h1), od, 0, 0, 0);
  od = __builtin_amdgcn_mfma_f32_32x32x16_bf16(pa2, PK(l2, h2), od, 0, 0, 0);
  od = __builtin_amdgcn_mfma_f32_32x32x16_bf16(pa3, PK(l3, h3), od, 0, 0, 0);
#undef PK
}
__device__ __forceinline__ void pv_d0(f32x16* o, int vb, bf16x8 pa0, bf16x8 pa1, bf16x8 pa2, bf16x8 pa3) {
  pv_one<0>(o[0], vb, pa0, pa1, pa2, pa3); pv_one<1>(o[1], vb, pa0, pa1, pa2, pa3); pv_one<2>(o[2], vb, pa0, pa1, pa2, pa3); pv_one<3>(o[3], vb, pa0, pa1, pa2, pa3);
}

template <typename TQ>
__device__ __forceinline__ void attn_dense_body(const TQ* __restrict__ Qb, const bf16* __restrict__ Kh, const bf16* __restrict__ Vh,
                                                bf16* __restrict__ Ob, int seq, char* lds) {
  using St = Stage<bf16>; using SQ = Stage<TQ>;
  const int tid = ltid(), wid = tid >> 6, lane = tid & 63, r32 = lane & 31, hi = lane >> 5;
  bf16* V_lds = (bf16*)lds; bf16* K_lds = (bf16*)(lds + 2 * SHM_V);
  float* ws = (float*)(lds + 2 * SHM_V + 2 * SHM_K) + wid * 64; float* li_l = ws; float* al_l = ws + 32;
  float m_reg = -1e30f, l_reg = 0; f32x16 o[4] = {}; bf16x8 qr[8];
  const TQ* Qw = Qb + (long)(wid * QBLK + r32) * LDQ + hi * 8;
#pragma unroll
  for (int d0 = 0; d0 < 8; ++d0) qr[d0] = SQ::tobf(SQ::ld8(Qw + d0 * 16));
  const int sr = tid >> 4, sc = (tid & 15) * 8, vst0 = v_st(sr, sc), vst1 = v_st(32 + sr, sc);
  const int vb0 = (int)(uintptr_t)V_lds + v_rd_base(lane);
  struct { typename St::T vs0, vs1, ks0, ks1; } sr_[SDEPTH];
#define SLOAD(i, k0) do { sr_[i].vs0 = St::ld8(&Vh[(long)((k0) + sr) * LDK + sc]); sr_[i].vs1 = St::ld8(&Vh[(long)((k0) + 32 + sr) * LDK + sc]); \
    sr_[i].ks0 = St::ld8(&Kh[(long)((k0) + sr) * LDK + sc]); sr_[i].ks1 = St::ld8(&Kh[(long)((k0) + 32 + sr) * LDK + sc]); } while (0)
#define SWRITE(b, i) do { *(bf16x8*)((char*)V_lds + (b) * SHM_V + vst0) = St::tobf(sr_[i].vs0);          \
    *(bf16x8*)((char*)V_lds + (b) * SHM_V + vst1) = St::tobf(sr_[i].vs1); int kc = sc * 2;               \
    *(bf16x8*)((char*)K_lds + (b) * SHM_K + KSWZ(sr, kc)) = St::tobf(sr_[i].ks0);                       \
    *(bf16x8*)((char*)K_lds + (b) * SHM_K + KSWZ(32 + sr, kc)) = St::tobf(sr_[i].ks1); } while (0)
#define SWAIT() do { if constexpr (SDEPTH == 2) asm volatile("s_waitcnt vmcnt(4)" ::: "memory"); else asm volatile("s_waitcnt vmcnt(0)" ::: "memory"); } while (0)
#define RESC(a) do { if (__any((a) < 1.f)) { if (hi == 0) al_l[r32] = (a); asm volatile("s_waitcnt lgkmcnt(0)" ::: "memory"); \
    for (int d = 0; d < 4; ++d) for (int r = 0; r < 16; ++r) o[d][r] *= al_l[crow(r, hi)]; } } while (0)
  f32x16 pA0, pA1, pB0, pB1; float mnA, mnB, alA, alB; bf16x8 pa0, pa1, pa2, pa3; const int NT = seq / KVBLK;
  constexpr int SE = 0, SO = SDEPTH - 1;
  SLOAD(SE, 0); asm volatile("s_waitcnt vmcnt(0)" ::: "memory"); SWRITE(0, SE); __syncthreads();
  qkt(pA0, pA1, K_lds, qr, r32, hi); partialSM(pA0, pA1, m_reg, mnA, alA);
  SLOAD(SO, KVBLK); if constexpr (SDEPTH == 2) { if (2 < NT) SLOAD(SE, 2 * KVBLK); }
  SWAIT(); SWRITE(1, SO); __syncthreads();
  for (int j = 1; j + 1 < NT; j += 2) {
    SBAR(); qkt(pB0, pB1, (bf16*)((char*)K_lds + SHM_K), qr, r32, hi);
    finishSM(pA0, pA1, alA, l_reg, pa0, pa1, pa2, pa3); SBAR();
    SLOAD(SO, (j + SDEPTH) * KVBLK); SBAR();
    pv_d0(o, vb0, pa0, pa1, pa2, pa3); partialSM(pB0, pB1, m_reg, mnB, alB);
    __syncthreads(); SWAIT(); SWRITE(0, SE);
    RESC(alB); __syncthreads();
    SBAR(); qkt(pA0, pA1, K_lds, qr, r32, hi);
    finishSM(pB0, pB1, alB, l_reg, pa0, pa1, pa2, pa3); SBAR();
    if (SDEPTH == 1 || j + 3 < NT) SLOAD(SE, (j + 1 + SDEPTH) * KVBLK); SBAR();
    pv_d0(o, vb0 + (int)SHM_V, pa0, pa1, pa2, pa3); partialSM(pA0, pA1, m_reg, mnA, alA);
    __syncthreads(); SWAIT(); SWRITE(1, SO);
    RESC(alA); __syncthreads();
  }
  SBAR(); qkt(pB0, pB1, (bf16*)((char*)K_lds + SHM_K), qr, r32, hi);
  finishSM(pA0, pA1, alA, l_reg, pa0, pa1, pa2, pa3); SBAR();
  pv_d0(o, vb0, pa0, pa1, pa2, pa3); partialSM(pB0, pB1, m_reg, mnB, alB);
  __syncthreads(); RESC(alB);
  finishSM(pB0, pB1, alB, l_reg, pa0, pa1, pa2, pa3); SBAR();
  pv_d0(o, vb0 + (int)SHM_V, pa0, pa1, pa2, pa3);
  if (hi == 0) li_l[r32] = l_reg; asm volatile("s_waitcnt lgkmcnt(0)" ::: "memory");
  float rli[16];
#pragma unroll
  for (int r = 0; r < 16; ++r) rli[r] = __builtin_amdgcn_rcpf(li_l[crow(r, hi)]);
  bf16* Ow = Ob + (long)(wid * QBLK) * LDO;
#pragma unroll
  for (int r = 0; r < 16; ++r) { int orow = crow(r, hi);
    for (int d0 = 0; d0 < 4; ++d0) { const float ov = o[d0][r] * rli[r]; unsigned uu = __float_as_uint(ov); uu += 0x7FFFu + ((uu >> 16) & 1u); Ow[(long)orow * LDO + d0 * 32 + r32] = (bf16)(uu >> 16); } }
#undef SLOAD
#undef SWRITE
#undef SWAIT
#undef RESC
}
}

#ifndef PHM
#define PHM 255
#endif
namespace mk {
__device__ const double INVD[64] = {1,0.86596432336006535,0.74989420933245587,0.64938163157621132,0.56234132519034907,0.48696752516586311,0.42169650342858223,0.36517412725483772,0.31622776601683794,0.27384196342643613,0.23713737056616552,0.20535250264571461,0.17782794100389229,0.15399265260594919,0.1333521432163324,0.11547819846894582,0.10000000000000001,0.086596432336006529,0.074989420933245579,0.064938163157621132,0.056234132519034911,0.048696752516586311,0.042169650342858224,0.036517412725483769,0.031622776601683791,0.027384196342643614,0.023713737056616554,0.02053525026457146,0.017782794100389229,0.015399265260594919,0.013335214321633241,0.011547819846894581,0.01,0.0086596432336006543,0.0074989420933245579,0.006493816315762113,0.005623413251903491,0.004869675251658631,0.0042169650342858229,0.0036517412725483771,0.0031622776601683794,0.0027384196342643613,0.0023713737056616554,0.002053525026457146,0.0017782794100389228,0.001539926526059492,0.0013335214321633241,0.0011547819846894581,0.001,0.00086596432336006539,0.00074989420933245586,0.00064938163157621134,0.0005623413251903491,0.0004869675251658631,0.00042169650342858224,0.0003651741272548377,0.00031622776601683794,0.00027384196342643611,0.00023713737056616554,0.00020535250264571461,0.00017782794100389227,0.00015399265260594919,0.0001333521432163324,0.00011547819846894582};
typedef unsigned short bf16_t;
typedef float f32x4 __attribute__((ext_vector_type(4)));
typedef unsigned u32x4 __attribute__((ext_vector_type(4)));
typedef unsigned u32x2 __attribute__((ext_vector_type(2)));
typedef float f32x2 __attribute__((ext_vector_type(2)));
constexpr int DM = 4096, NPROJ = 16384, LDP = 16512  , DFF = 16384, MH = 16384, MC = 8192;
constexpr size_t MiB = 1ull << 20;
constexpr size_t WS_CTL = 0, WS_WIN = 1 * MiB, WS_WOUT = WS_WIN + 128 * MiB, WS_WUP = WS_WOUT + 32 * MiB, WS_WDN = WS_WUP + 128 * MiB,
                 WS_HB = WS_WDN + 128 * MiB, WS_PROJ = WS_HB + 128 * MiB, WS_OB = WS_PROJ + 520 * MiB, WS_ST = WS_OB + 128 * MiB,
                 WS_PD = WS_ST + 128 * MiB, WS_END = WS_PD + 1 * MiB;
constexpr int LDS_BAR_OFF = 135168, LDS_BYTES = 135168 + 64;
constexpr float EPS = 1e-6f;

__device__ __forceinline__ float bf2f(unsigned b) { return __uint_as_float(b << 16); }
__device__ __forceinline__ float bflo(unsigned w) { return __uint_as_float(w << 16); }
__device__ __forceinline__ float bfhi(unsigned w) { return __uint_as_float(w & 0xffff0000u); }
__device__ __forceinline__ unsigned short f2bf(float f) { unsigned u = __float_as_uint(f); u += 0x7FFFu + ((u >> 16) & 1u); return (unsigned short)(u >> 16); }
__device__ __forceinline__ unsigned pk(float lo, float hi) { return pg8::cvt_pk_bf16(lo, hi); }

template <int ACT> struct EpiB {
    static constexpr bool PERM = true, AFTER_DRAIN = false;
    bf16_t* O; int ldc;
    __device__ __forceinline__ void operator()(const pg8::f32x4 (&acc)[2][2][4][2], const pg8::Unit& u, int wr, int wc, int fr, int fq) const {
        const int row0 = u.pm * 256 + wr * 64 + fr, col0 = u.pn * 256 + wc * 32 + 8 * fq;
#pragma unroll
        for (int ai = 0; ai < 2; ++ai)
#pragma unroll
            for (int m = 0; m < 4; ++m) { bf16_t* rowp = O + (size_t)(row0 + ai * 128 + m * 16) * ldc + col0;
#pragma unroll
                for (int bj = 0; bj < 2; ++bj) { pg8::f32x4 v0 = acc[ai][bj][m][0], v1 = acc[ai][bj][m][1];
                    if (ACT == 1) {
#pragma unroll
                        for (int j = 0; j < 4; ++j) { const float a = fmaxf(v0[j], 0.f), b = fmaxf(v1[j], 0.f); v0[j] = a * a; v1[j] = b * b; } }
                    pg8::u32x4 w; w.x = pk(v0[0], v0[1]); w.y = pk(v0[2], v0[3]); w.z = pk(v1[0], v1[1]); w.w = pk(v1[2], v1[3]);
                    *(pg8::u32x4*)(rowp + bj * 128) = w; } }
    }
};
struct EpiRes {
    static constexpr bool PERM = false, AFTER_DRAIN = false;
    const float* base; float* C; int ldc;
    __device__ __forceinline__ void operator()(const pg8::f32x4 (&acc)[2][2][4][2], const pg8::Unit& u, int wr, int wc, int fr, int fq) const {
        const int row0 = u.pm * 256 + wr * 64 + fr, col0 = u.pn * 256 + wc * 32 + 4 * fq;
#pragma unroll
        for (int ai = 0; ai < 2; ++ai)
#pragma unroll
            for (int m = 0; m < 4; ++m) { const size_t off = (size_t)(row0 + ai * 128 + m * 16) * ldc + col0;
#pragma unroll
                for (int bj = 0; bj < 2; ++bj)
#pragma unroll
                    for (int n = 0; n < 2; ++n) { const pg8::f32x4 b = *(const pg8::f32x4*)(base + off + bj * 128 + n * 16);
                        *(pg8::f32x4*)(C + off + bj * 128 + n * 16) = acc[ai][bj][m][n] + b; } }
    }
};

__device__ __forceinline__ void transpose_cvt(const float* __restrict__ W, bf16_t* __restrict__ Wt, int K, int N, float* tile, int bid, int nb) {
    const int tid = ltid(); const int ntn = N / 64, nt = (K / 64) * ntn;
    f32x4 pv[2];
#define TLOAD(t_) do { const int tn_ = (t_) % ntn, tk_ = (t_) / ntn; const float* src_ = W + (size_t)(tk_ * 64) * N + tn_ * 64; \
        _Pragma("unroll") for (int i = 0; i < 2; ++i) pv[i] = *(const f32x4*)(src_ + (size_t)((tid >> 4) + i * 32) * N + (tid & 15) * 4); } while (0)
    if (bid < nt) TLOAD(bid);
    for (int t = bid; t < nt; t += nb) {
        const int tn = t % ntn, tk = t / ntn;
#pragma unroll
        for (int i = 0; i < 2; ++i) { const int r = (tid >> 4) + i * 32, c = (tid & 15) * 4;
            tile[r * 65 + c] = pv[i][0]; tile[r * 65 + c + 1] = pv[i][1]; tile[r * 65 + c + 2] = pv[i][2]; tile[r * 65 + c + 3] = pv[i][3]; }
        __syncthreads();
        if (t + nb < nt) TLOAD(t + nb);
        const int n = tid >> 3, k8 = (tid & 7) * 8; float v[8];
#pragma unroll
        for (int i = 0; i < 8; ++i) v[i] = tile[(k8 + i) * 65 + n];
        u32x4 w; w.x = pk(v[0], v[1]); w.y = pk(v[2], v[3]); w.z = pk(v[4], v[5]); w.w = pk(v[6], v[7]);
        *(u32x4*)(Wt + (size_t)(tn * 64 + n) * K + tk * 64 + k8) = w;
        __syncthreads();
    }
#undef TLOAD
}

template <bool OUT_BF16>
__device__ __forceinline__ void rmsnorm_rows(const float* X, const float* __restrict__ w, void* out, int rows, int bid, int nb) {
    const int tid_ = ltid(); const int lane = tid_ & 63, wid = tid_ >> 6;
    for (int r = bid * 8 + wid; r < rows; r += nb * 8) {
        const float* x = X + (size_t)r * DM; f32x4 v[16]; float ss = 0.f;
#pragma unroll
        for (int i = 0; i < 16; ++i) { v[i] = *(const f32x4*)(x + i * 256 + lane * 4); ss += v[i][0] * v[i][0] + v[i][1] * v[i][1] + v[i][2] * v[i][2] + v[i][3] * v[i][3]; }
#pragma unroll
        for (int o = 32; o >= 1; o >>= 1) ss += __shfl_xor(ss, o);
        const float rs = rsqrtf(ss * (1.0f / DM) + EPS);
#pragma unroll
        for (int i = 0; i < 16; ++i) { const f32x4 ww = *(const f32x4*)(w + i * 256 + lane * 4); const f32x4 y = v[i] * rs * ww;
            if (OUT_BF16) { u32x2 o2; o2.x = pk(y[0], y[1]); o2.y = pk(y[2], y[3]); *(u32x2*)((bf16_t*)out + (size_t)r * DM + i * 256 + lane * 4) = o2; }
            else *(f32x4*)((float*)out + (size_t)r * DM + i * 256 + lane * 4) = y; }
    }
}

__device__ __forceinline__ void rope_phase(bf16_t* proj, int rows, int L, int bid, int nb) {
    const int tid_ = ltid(); const int lane = tid_ & 63, wid = tid_ >> 6, sub = lane >> 5, d = (lane & 31) * 2;
    const double i2pi = 0.15915494309189533577;
    for (int rp = bid * 8 + wid; rp < rows / 2; rp += nb * 8) {
        const int r = rp * 2 + sub, pos = r & (L - 1);
        double a0 = (double)pos * INVD[d] * i2pi, a1 = (double)pos * INVD[d + 1] * i2pi;
        a0 -= __builtin_rint(a0); a1 -= __builtin_rint(a1);
        const float f0 = (float)a0, f1 = (float)a1;
        const float c0 = __builtin_amdgcn_cosf(f0), s0 = __builtin_amdgcn_sinf(f0), c1 = __builtin_amdgcn_cosf(f1), s1 = __builtin_amdgcn_sinf(f1);
        bf16_t* row = proj + (size_t)r * LDP + d;
#pragma unroll 8
        for (int vct = 0; vct < 32; ++vct) { unsigned* p1 = (unsigned*)(row + vct * 128); unsigned* p2 = (unsigned*)(row + vct * 128 + 64);
            const unsigned w1 = *p1, w2 = *p2; const float x10 = bflo(w1), x11 = bfhi(w1), x20 = bflo(w2), x21 = bfhi(w2);
            *p1 = pk(x10 * c0 - x20 * s0, x11 * c1 - x21 * s1); *p2 = pk(x20 * c0 + x10 * s0, x21 * c1 + x11 * s1); }
    }
}

constexpr int HT = 256, HTB = 16;
template <bool PASS3>
__device__ __forceinline__ void hgrn_pass(bf16_t* proj, const float* __restrict__ hgrn_lb, float* ST, float* PD, int nseq, int L, float* lds, int bid, int nb) {
    const int tid = ltid(), g = tid >> 7, j = tid & 127;
    float* qs = lds + g * (3 * HTB * 128); float* fs = qs + HTB * 128; float* vs = fs + HTB * 128;
    const int NSC = L / HT, nitems = nseq * NSC * 8;
    const int sr = j >> 4, c8 = (j & 15) * 8;
    for (int it = bid; it < nitems; it += nb) {
        const int u = it * 4 + g, dir = u & 1, h = (u >> 1) & 15, sc = (u >> 5) % NSC, s = (u >> 5) / NSC;
        const size_t row0 = (size_t)s * L + (size_t)sc * HT;
        const int colq = 6144 + h * 128, colf = (dir ? 10240 : 8192) + h * 128, colv = 12288 + h * 128;
        float lb[8];
#pragma unroll
        for (int e = 0; e < 8; ++e) { const float a0 = hgrn_lb[dir * 4096 + h * 128 + c8 + e], a1 = hgrn_lb[dir * 4096 + 2048 + h * 128 + c8 + e]; lb[e] = 1.0f / (1.0f + __expf(a1 - a0)); }
        float S[128];
#pragma unroll
        for (int k = 0; k < 128; ++k) S[k] = PASS3 ? ST[(size_t)u * 16384 + k * 128 + j] : 0.f;
        float P = 1.f;
        u32x4 rq[2], rf[2], rv[2];
#define HLOAD(b) do { const size_t rb_ = row0 + (dir ? (HT - HTB * ((b) + 1)) : HTB * (b)); _Pragma("unroll") for (int i = 0; i < 2; ++i) { const bf16_t* p_ = proj + (rb_ + sr + 8 * i) * LDP + c8; \
            if (PASS3) rq[i] = *(const u32x4*)(p_ + colq); rf[i] = *(const u32x4*)(p_ + colf); rv[i] = *(const u32x4*)(p_ + colv); } } while (0)
        HLOAD(0);
        for (int b = 0; b < HT / HTB; ++b) {
            __syncthreads();
#pragma unroll
            for (int i = 0; i < 2; ++i) { const int ro = (sr + 8 * i) * 128 + c8;
#pragma unroll
                for (int e = 0; e < 4; ++e) {
                    const unsigned wf = rf[i][e], wv = rv[i][e];
                    const float f0 = bflo(wf), f1 = bfhi(wf);
                    fs[ro + 2 * e] = lb[2 * e] + (1.f - lb[2 * e]) / (1.f + __expf(-f0)); fs[ro + 2 * e + 1] = lb[2 * e + 1] + (1.f - lb[2 * e + 1]) / (1.f + __expf(-f1));
                    vs[ro + 2 * e] = bflo(wv); vs[ro + 2 * e + 1] = bfhi(wv);
                    if (PASS3) { const unsigned wq = rq[i][e]; const float q0 = bflo(wq), q1 = bfhi(wq); qs[ro + 2 * e] = q0 / (1.f + __expf(-q0)); qs[ro + 2 * e + 1] = q1 / (1.f + __expf(-q1)); }
                } }
            __syncthreads();
            if (b + 1 < HT / HTB) HLOAD(b + 1);
            const size_t rb = row0 + (dir ? (HT - HTB * (b + 1)) : HTB * b);
#pragma unroll 1
            for (int tt = 0; tt < HTB; ++tt) {
                const int t = dir ? (HTB - 1 - tt) : tt;
                const float v = vs[t * 128 + j]; f32x2 o2 = {0.f, 0.f};
#pragma unroll
                for (int k4 = 0; k4 < 32; ++k4) { const f32x4 f4 = *(const f32x4*)(fs + t * 128 + k4 * 4);
#pragma unroll
                    for (int e = 0; e < 4; ++e) S[k4 * 4 + e] = fmaf(f4[e], S[k4 * 4 + e] - v, v);
                    if (PASS3) { const f32x4 q4 = *(const f32x4*)(qs + t * 128 + k4 * 4);
#pragma unroll
                        for (int e = 0; e < 4; e += 2) { const f32x2 qq = {q4[e], q4[e + 1]}, sv = {S[k4 * 4 + e], S[k4 * 4 + e + 1]}; o2 = __builtin_elementwise_fma(qq, sv, o2); } } }
                if (PASS3) proj[(rb + t) * LDP + colf + j] = f2bf(o2[0] + o2[1]);
                else P *= fs[t * 128 + j];
            }
        }
#undef HLOAD
        if (!PASS3) {
#pragma unroll
            for (int k = 0; k < 128; ++k) ST[(size_t)u * 16384 + k * 128 + j] = S[k];
            PD[(size_t)u * 128 + j] = P; }
        __syncthreads();
    }
}

constexpr int LDT = 264;
__device__ __forceinline__ void hgrn_ends(const bf16_t* proj, const float* __restrict__ hgrn_lb, float* ST, float* PD, int nseq, int L, unsigned char* lds, int bid, int nb) {
    const int tid = ltid(), grp = tid >> 7, x = tid & 127, wid = tid >> 6, lane = tid & 63, fr = lane & 15, fq = lane >> 4;
    bf16_t* wT = (bf16_t*)lds; bf16_t* vT = (bf16_t*)(lds + 128 * LDT * 2);
    const int NSC = L / HT, nunits = nseq * NSC * 32;
    for (int u = bid; u < nunits; u += nb) {
        const int dir = u & 1, h = (u >> 1) & 15, sc = (u >> 5) % NSC, s = (u >> 5) / NSC;
        const size_t row0 = (size_t)s * L + (size_t)sc * HT;
        if (grp == 0) {
            const bf16_t* pf = proj + row0 * LDP + (dir ? 10240 : 8192) + h * 128 + x;
            const float a0 = hgrn_lb[dir * 4096 + h * 128 + x], a1 = hgrn_lb[dir * 4096 + 2048 + h * 128 + x]; const float lb = 1.0f / (1.0f + __expf(a1 - a0));
            float R = 1.f; unsigned short raw[32], nxt[32];
#pragma unroll
            for (int i = 0; i < 32; ++i) { const int t = dir ? i : 255 - i; raw[i] = pf[(size_t)t * LDP]; }
#pragma unroll 1
            for (int tb = 0; tb < 8; ++tb) {
                if (tb < 7) {
#pragma unroll
                    for (int i = 0; i < 32; ++i) { const int t = dir ? (tb + 1) * 32 + i : 255 - ((tb + 1) * 32 + i); nxt[i] = pf[(size_t)t * LDP]; } }
#pragma unroll
                for (int i = 0; i < 32; ++i) { const int t = dir ? tb * 32 + i : 255 - (tb * 32 + i);
                    const float fraw = bf2f(raw[i]); const float f = lb + (1.f - lb) / (1.f + __expf(-fraw));
                    wT[x * LDT + t] = f2bf((1.f - f) * R); R *= f; }
#pragma unroll
                for (int i = 0; i < 32; ++i) raw[i] = nxt[i];
            }
            PD[(size_t)u * 128 + x] = R;
        } else if (grp < 3) {
            const bf16_t* pv = proj + (row0 + (size_t)(grp - 1) * 128) * LDP + 12288 + h * 128 + x; bf16_t* dst = vT + x * LDT + (grp - 1) * 128;
#pragma unroll 1
            for (int tb = 0; tb < 4; ++tb) { unsigned short raw[32];
#pragma unroll
                for (int i = 0; i < 32; ++i) raw[i] = pv[(size_t)(tb * 32 + i) * LDP];
#pragma unroll
                for (int i = 0; i < 32; i += 2) *(unsigned*)(dst + tb * 32 + i) = (unsigned)raw[i] | ((unsigned)raw[i + 1] << 16); }
        }
        __syncthreads();
        pg8::f32x4 acc[8];
#pragma unroll
        for (int jb = 0; jb < 8; ++jb) acc[jb] = (pg8::f32x4){0.f, 0.f, 0.f, 0.f};
#pragma unroll
        for (int ks = 0; ks < 8; ++ks) { const pg8::bf16x8 a = *(const pg8::bf16x8*)(wT + (wid * 16 + fr) * LDT + ks * 32 + fq * 8);
#pragma unroll
            for (int jb = 0; jb < 8; ++jb) { const pg8::bf16x8 b = *(const pg8::bf16x8*)(vT + (jb * 16 + fr) * LDT + ks * 32 + fq * 8);
                acc[jb] = __builtin_amdgcn_mfma_f32_16x16x32_bf16(a, b, acc[jb], 0, 0, 0); } }
        float* st = ST + (size_t)u * 16384;
#pragma unroll
        for (int jb = 0; jb < 8; ++jb)
#pragma unroll
            for (int i = 0; i < 4; ++i) st[(wid * 16 + fq * 4 + i) * 128 + jb * 16 + fr] = acc[jb][i];
        __syncthreads();
    }
}

__device__ __forceinline__ void hgrn_out(bf16_t* proj, const float* __restrict__ hgrn_lb, const float* ST, int nseq, int L, unsigned char* lds, int bid, int nb) {
    const int tid = ltid(), wid = tid >> 6, lane = tid & 63, fr = lane & 15, fq = lane >> 4, x = tid & 127, role = tid >> 7;
    bf16_t* QD = (bf16_t*)lds; bf16_t* KD = QD + 32 * 136; bf16_t* KE = KD + 32 * 136; bf16_t* VT = KE + 128 * 40; bf16_t* SB = VT + 128 * 40; bf16_t* AM = SB + 128 * 136; float* DC = (float*)(AM + 32 * 40);
    const int NSC = L / HT, nunits = nseq * NSC * 32;
    for (int u = bid; u < nunits; u += nb) {
        const int dir = u & 1, h = (u >> 1) & 15, sc = (u >> 5) % NSC, s = (u >> 5) / NSC;
        const size_t row0 = (size_t)s * L + (size_t)sc * HT;
        const int colq = 6144 + h * 128, colf = (dir ? 10240 : 8192) + h * 128, colv = 12288 + h * 128;
        pg8::f32x4 Sacc[8];
        { const float* st = ST + (size_t)u * 16384;
#pragma unroll
          for (int jb = 0; jb < 8; ++jb)
#pragma unroll
              for (int r = 0; r < 4; ++r) Sacc[jb][r] = st[(wid * 16 + fq * 4 + r) * 128 + jb * 16 + fr]; }
        float lb = 0.f;
        if (role == 0) { const float a0 = hgrn_lb[dir * 4096 + h * 128 + x], a1 = hgrn_lb[dir * 4096 + 2048 + h * 128 + x]; lb = 1.0f / (1.0f + __expf(a1 - a0)); }
        unsigned short ra[32], rb[32];
#define PLOAD(cc_) do { if (role == 0) { _Pragma("unroll") for (int i = 0; i < 32; ++i) { const int tt_ = (cc_) * 32 + i; const bf16_t* p_ = proj + (row0 + (dir ? 255 - tt_ : tt_)) * LDP + x; ra[i] = p_[colf]; rb[i] = p_[colq]; } } \
        else if (role == 1) { _Pragma("unroll") for (int i = 0; i < 32; ++i) { const int tt_ = (cc_) * 32 + i; ra[i] = proj[(row0 + (dir ? 255 - tt_ : tt_)) * LDP + colv + x]; } } } while (0)
        PLOAD(0);
#define SBWRITE() do { _Pragma("unroll") for (int jb = 0; jb < 8; ++jb) { u32x2 w_; w_.x = pk(Sacc[jb][0], Sacc[jb][1]); w_.y = pk(Sacc[jb][2], Sacc[jb][3]); *(u32x2*)(SB + (jb * 16 + fr) * 136 + wid * 16 + fq * 4) = w_; } } while (0)
        SBWRITE();
#pragma unroll 1
        for (int cc = 0; cc < 8; ++cc) {
            if (role == 0) { float D = 1.f; float kd[32];
#pragma unroll
                for (int i = 0; i < 32; ++i) { const float fraw = bf2f(ra[i]), qraw = bf2f(rb[i]); const float f = lb + (1.f - lb) / (1.f + __expf(-fraw)); const float q = qraw / (1.f + __expf(-qraw));
                    D *= f; QD[i * 136 + x] = f2bf(q * D); kd[i] = (1.f - f) / D; KD[i * 136 + x] = f2bf(kd[i]); }
                DC[x] = D;
#pragma unroll
                for (int i = 0; i < 32; i += 2) *(unsigned*)(KE + x * 40 + i) = pk(kd[i] * D, kd[i + 1] * D);
            } else if (role == 1) {
#pragma unroll
                for (int i = 0; i < 32; i += 2) *(unsigned*)(VT + x * 40 + i) = (unsigned)ra[i] | ((unsigned)ra[i + 1] << 16);
            }
            if (cc < 7) PLOAD(cc + 1);
            __syncthreads();
            if (wid < 4) { const int mb = wid >> 1, nbk = wid & 1; pg8::f32x4 acc = {0.f, 0.f, 0.f, 0.f};
#pragma unroll
                for (int ks = 0; ks < 4; ++ks) { const pg8::bf16x8 a = *(const pg8::bf16x8*)(QD + (mb * 16 + fr) * 136 + ks * 32 + fq * 8), b = *(const pg8::bf16x8*)(KD + (nbk * 16 + fr) * 136 + ks * 32 + fq * 8);
                    acc = __builtin_amdgcn_mfma_f32_16x16x32_bf16(a, b, acc, 0, 0, 0); }
#pragma unroll
                for (int r = 0; r < 4; ++r) { const int i = mb * 16 + fq * 4 + r, ip = nbk * 16 + fr; AM[i * 40 + ip] = (ip <= i) ? f2bf(acc[r]) : (unsigned short)0; } }
            __syncthreads();
            { const int mb = wid >> 2;
#pragma unroll
              for (int q2 = 0; q2 < 2; ++q2) { const int jb = (wid & 3) * 2 + q2; pg8::f32x4 acc = {0.f, 0.f, 0.f, 0.f};
                  { const pg8::bf16x8 a = *(const pg8::bf16x8*)(AM + (mb * 16 + fr) * 40 + fq * 8), b = *(const pg8::bf16x8*)(VT + (jb * 16 + fr) * 40 + fq * 8); acc = __builtin_amdgcn_mfma_f32_16x16x32_bf16(a, b, acc, 0, 0, 0); }
#pragma unroll
                  for (int ks = 0; ks < 4; ++ks) { const pg8::bf16x8 a = *(const pg8::bf16x8*)(QD + (mb * 16 + fr) * 136 + ks * 32 + fq * 8), b = *(const pg8::bf16x8*)(SB + (jb * 16 + fr) * 136 + ks * 32 + fq * 8);
                      acc = __builtin_amdgcn_mfma_f32_16x16x32_bf16(a, b, acc, 0, 0, 0); }
#pragma unroll
                  for (int r = 0; r < 4; ++r) { const int tt = cc * 32 + mb * 16 + fq * 4 + r; proj[(row0 + (dir ? 255 - tt : tt)) * LDP + colf + jb * 16 + fr] = f2bf(acc[r]); } } }
            { const pg8::f32x4 dc = *(const pg8::f32x4*)(DC + wid * 16 + fq * 4); const pg8::bf16x8 a = *(const pg8::bf16x8*)(KE + (wid * 16 + fr) * 40 + fq * 8);
#pragma unroll
              for (int jb = 0; jb < 8; ++jb) { const pg8::bf16x8 b = *(const pg8::bf16x8*)(VT + (jb * 16 + fr) * 40 + fq * 8); Sacc[jb] = Sacc[jb] * dc; Sacc[jb] = __builtin_amdgcn_mfma_f32_16x16x32_bf16(a, b, Sacc[jb], 0, 0, 0); } }
            __syncthreads();
            if (cc < 7) SBWRITE();
        }
#undef PLOAD
#undef SBWRITE
    }
}
__device__ __forceinline__ void hgrn_scan(float* ST, const float* PD, int nseq, int NSC, int bid, int nb) {
    const int nitems = nseq * 32 * 32; const int tid_ = ltid();
    for (int it = bid; it < nitems; it += nb) {
        const int eb = it & 31, hd = (it >> 5) & 31, s = it >> 10, dir = hd & 1;
        const int e = eb * 512 + tid_, k = e >> 7; float carry = 0.f;
        for (int cc = 0; cc < NSC; cc += 4) { float E[4], p[4]; size_t ui[4];
#pragma unroll
            for (int q = 0; q < 4; ++q) { const int c = dir ? NSC - 1 - (cc + q) : (cc + q); ui[q] = ((size_t)(s * NSC + c)) * 32 + hd; E[q] = ST[ui[q] * 16384 + e]; p[q] = PD[ui[q] * 128 + k]; }
#pragma unroll
            for (int q = 0; q < 4; ++q) { ST[ui[q] * 16384 + e] = carry; carry = fmaf(p[q], carry, E[q]); } }
    }
}

__device__ __forceinline__ void combine_phase(const bf16_t* OB, const bf16_t* proj, bf16_t* mix, const float* __restrict__ dl, const float* __restrict__ subln_w, const float* __restrict__ hnw, int rows, int bid, int nb) {
    const int tid_ = ltid(); const int lane = tid_ & 63, wid = tid_ >> 6;
    float a = dl[lane] * dl[128 + lane] + dl[64 + lane] * dl[192 + lane], b = dl[256 + lane] * dl[384 + lane] + dl[320 + lane] * dl[448 + lane];
#pragma unroll
    for (int o = 32; o >= 1; o >>= 1) { a += __shfl_xor(a, o); b += __shfl_xor(b, o); }
    const float lam = expf(a) - expf(b) + 0.2f;
    for (int r = bid * 8 + wid; r < rows; r += nb * 8) {
#pragma unroll
        for (int i = 0; i < 4; ++i) { const int head = i * 2 + (lane >> 5), e = (lane & 31) * 8;
            const bf16_t* o0 = OB + (size_t)r * DM + head * 512 + e; const u32x4 x0 = *(const u32x4*)o0, x1 = *(const u32x4*)(o0 + 256);
            float dv[8]; float ss = 0.f;
#pragma unroll
            for (int q = 0; q < 4; ++q) { dv[2 * q] = bflo(x0[q]) - lam * bflo(x1[q]); dv[2 * q + 1] = bfhi(x0[q]) - lam * bfhi(x1[q]); ss += dv[2 * q] * dv[2 * q] + dv[2 * q + 1] * dv[2 * q + 1]; }
#pragma unroll
            for (int o = 16; o >= 1; o >>= 1) ss += __shfl_xor(ss, o);
            const float rs = rsqrtf(ss * (1.0f / 256.0f) + EPS) * 0.8f;
            const f32x4 w0 = *(const f32x4*)(subln_w + e), w1 = *(const f32x4*)(subln_w + e + 4);
            u32x4 w; w.x = pk(dv[0] * rs * w0[0], dv[1] * rs * w0[1]); w.y = pk(dv[2] * rs * w0[2], dv[3] * rs * w0[3]); w.z = pk(dv[4] * rs * w1[0], dv[5] * rs * w1[1]); w.w = pk(dv[6] * rs * w1[2], dv[7] * rs * w1[3]);
            *(u32x4*)(mix + (size_t)r * DM + head * 256 + e) = w; }
#pragma unroll
        for (int i = 0; i < 4; ++i) { const int col = i * 512 + lane * 8, dd = col & 127;
            const bf16_t* pr = proj + (size_t)r * LDP + col; const u32x4 xf = *(const u32x4*)(pr + 8192), xb = *(const u32x4*)(pr + 10240), xg = *(const u32x4*)(pr + 14336);
            float ov[8], gv[8]; float ss = 0.f;
#pragma unroll
            for (int q = 0; q < 4; ++q) { ov[2 * q] = bflo(xf[q]) + bflo(xb[q]); ov[2 * q + 1] = bfhi(xf[q]) + bfhi(xb[q]); gv[2 * q] = bflo(xg[q]); gv[2 * q + 1] = bfhi(xg[q]); ss += ov[2 * q] * ov[2 * q] + ov[2 * q + 1] * ov[2 * q + 1]; }
#pragma unroll
            for (int o = 8; o >= 1; o >>= 1) ss += __shfl_xor(ss, o);
            const float rs = rsqrtf(ss * (1.0f / 128.0f) + EPS);
            const f32x4 w0 = *(const f32x4*)(hnw + dd), w1 = *(const f32x4*)(hnw + dd + 4);
            float y[8];
#pragma unroll
            for (int q = 0; q < 8; ++q) { const float wq = q < 4 ? w0[q & 3] : w1[q & 3]; y[q] = ov[q] * rs * wq * (gv[q] / (1.f + __expf(-gv[q]))); }
            u32x4 w; w.x = pk(y[0], y[1]); w.y = pk(y[2], y[3]); w.z = pk(y[4], y[5]); w.w = pk(y[6], y[7]);
            *(u32x4*)(mix + (size_t)r * DM + 2048 + col) = w; }
    }
}

__device__ __forceinline__ void attn_phase(const bf16_t* proj, bf16_t* OB, int nseq, int L, char* lds, int bid, int nb) {
    const int nqb = L / 256, nunits = nseq * 32 * nqb;
    for (int u = bid; u < nunits; u += nb) {
        const int qb = u % nqb, r = u / nqb, vh = r & 1, c = (r >> 1) & 1, h = (r >> 2) & 7, s = r >> 5;
        const size_t row0 = (size_t)s * L;
        att::attn_dense_body<att::bf16>(proj + (row0 + (size_t)qb * 256) * LDP + h * 256 + c * 128, proj + row0 * LDP + 2048 + h * 256 + c * 128,
                                        proj + row0 * LDP + 4096 + h * 256 + vh * 128, OB + (row0 + (size_t)qb * 256) * DM + h * 512 + c * 256 + vh * 128, L, lds);
        __syncthreads();
    }
}

struct Params { const float* in[13]; float* out; unsigned char* ws; };

__global__ void __launch_bounds__(512, 2) fwd(Params p) {
    extern __shared__ __attribute__((aligned(16))) unsigned char lds[];
    const int tid = threadIdx.x, bid = blockIdx.x, nb = gridDim.x;
    if (tid < 4) ((unsigned*)(lds + LDS_BAR_OFF))[tid] = 0u;
    __syncthreads();
    XcdBarrier bar = xcd_barrier_post((unsigned*)(p.ws + WS_CTL), (volatile LAS unsigned*)(lds + LDS_BAR_OFF));
    const float* attn_norm_w = p.in[2]; const float* w_in = p.in[3]; const float* diff_lambda = p.in[4]; const float* subln_w = p.in[5];
    const float* hgrn_lb = p.in[6]; const float* hgrn_norm_w = p.in[7]; const float* w_out = p.in[8]; const float* mlp_norm_w = p.in[9];
    const float* w_up = p.in[10]; const float* w_down = p.in[11]; const float* final_norm_w = p.in[12];
    bf16_t* WIN = (bf16_t*)(p.ws + WS_WIN); bf16_t* WOUT = (bf16_t*)(p.ws + WS_WOUT); bf16_t* WUP = (bf16_t*)(p.ws + WS_WUP); bf16_t* WDN = (bf16_t*)(p.ws + WS_WDN);
    bf16_t* HB = (bf16_t*)(p.ws + WS_HB); bf16_t* PROJ = (bf16_t*)(p.ws + WS_PROJ); bf16_t* OB = (bf16_t*)(p.ws + WS_OB);
    float* ST = (float*)(p.ws + WS_ST); float* PD = (float*)(p.ws + WS_PD);
    PG8_LAS unsigned char* ldsl = (PG8_LAS unsigned char*)lds;

#if PHM & 1
    transpose_cvt(w_in, WIN, DM, NPROJ, (float*)lds, bid, nb);
    transpose_cvt(w_out, WOUT, DM, DM, (float*)lds, bid, nb);
    transpose_cvt(w_up, WUP, DM, DFF, (float*)lds, bid, nb);
    transpose_cvt(w_down, WDN, DFF, DM, (float*)lds, bid, nb);
#endif

    for (int hf = 0; hf < 2; ++hf) {
        const float* x = hf ? p.in[1] : p.in[0]; const int nseq = hf ? 1 : 8, L = hf ? 16384 : 2048;
        float* outp = p.out + (size_t)hf * MH * DM;
        rmsnorm_rows<true>(x, attn_norm_w, HB, MH, bid, nb);
        xcd_barrier(bar);
#if PHM & 2
        { pg8::Gemm g{HB, WIN, MH, NPROJ, DM}; pg8::StaticOrder S; S.init(MH, NPROJ, nb, bid); EpiB<0> E{PROJ, LDP};
          pg8::gemm_phase<EpiB<0>, pg8::StaticOrder>(ldsl, g, S, E, nullptr); }
#endif
        xcd_barrier(bar);
        rope_phase(PROJ, MH, L, bid, nb);
#if PHM & 4
        hgrn_ends(PROJ, hgrn_lb, ST, PD, nseq, L, lds, bid, nb);
#endif
        xcd_barrier(bar);
        hgrn_scan(ST, PD, nseq, L / HT, bid, nb);
#if PHM & 8
        attn_phase(PROJ, OB, nseq, L, (char*)lds, bid, nb);
#endif
        xcd_barrier(bar);
#if PHM & 16
        hgrn_out(PROJ, hgrn_lb, ST, nseq, L, lds, bid, nb);
#endif
        xcd_barrier(bar);
        combine_phase(OB, PROJ, HB, diff_lambda, subln_w, hgrn_norm_w, MH, bid, nb);
        xcd_barrier(bar);
#if PHM & 32
        { pg8::Gemm g{HB, WOUT, MH, DM, DM}; pg8::StaticOrder S; S.init(MH, DM, nb, bid); EpiRes E{x, outp, DM};
          pg8::gemm_phase<EpiRes, pg8::StaticOrder>(ldsl, g, S, E, nullptr); }
#endif
        xcd_barrier(bar);
        rmsnorm_rows<true>(outp, mlp_norm_w, HB, MH, bid, nb);
        xcd_barrier(bar);
        for (int ch = 0; ch < 2; ++ch) {
#if PHM & 64
            { pg8::Gemm g{HB + (size_t)ch * MC * DM, WUP, MC, DFF, DM}; pg8::StaticOrder S; S.init(MC, DFF, nb, bid); EpiB<1> E{PROJ, DFF};
              pg8::gemm_phase<EpiB<1>, pg8::StaticOrder>(ldsl, g, S, E, nullptr); }
#endif
            xcd_barrier(bar);
#if PHM & 128
            { float* oc = outp + (size_t)ch * MC * DM; pg8::Gemm g{PROJ, WDN, MC, DM, DFF}; pg8::StaticOrder S; S.init(MC, DM, nb, bid); EpiRes E{oc, oc, DM};
              pg8::gemm_phase<EpiRes, pg8::StaticOrder>(ldsl, g, S, E, nullptr); }
#endif
            xcd_barrier(bar);
        }
        rmsnorm_rows<false>(outp, final_norm_w, outp, MH, bid, nb);
    }
}
}

extern "C" void kernel_launch(void* const* d_in, const int* in_sizes, int n_in, void* d_out, int out_size, void* d_ws, size_t ws_size, hipStream_t stream) {
    static int grid = 0;
    if (grid == 0) {
        if (n_in != 13 || ws_size < mk::WS_END) { fprintf(stderr, "kernel_launch: n_in %d ws %zu (need %zu)\n", n_in, ws_size, (size_t)mk::WS_END); grid = -1; return; }
        int dev = 0, cus = 0, per_cu = 0;
        hipGetDevice(&dev); hipDeviceGetAttribute(&cus, hipDeviceAttributeMultiprocessorCount, dev);
        if (hipFuncSetAttribute((const void*)mk::fwd, hipFuncAttributeMaxDynamicSharedMemorySize, mk::LDS_BYTES) != hipSuccess) { fprintf(stderr, "kernel_launch: hipFuncSetAttribute failed\n"); grid = -1; return; }
        if (hipOccupancyMaxActiveBlocksPerMultiprocessor(&per_cu, (const void*)mk::fwd, 512, mk::LDS_BYTES) != hipSuccess || per_cu < 1) { fprintf(stderr, "kernel_launch: occupancy %d\n", per_cu); grid = -1; return; }
        (void)hipGetLastError();
        grid = cus;
    }
    if (grid < 0) return;
    hipMemsetAsync((char*)d_ws + mk::WS_CTL, 0, 65536, stream);
    mk::Params p{};
    for (int i = 0; i < 13; ++i) p.in[i] = (const float*)d_in[i];
    p.out = (float*)d_out; p.ws = (unsigned char*)d_ws;
    hipLaunchKernelGGL(mk::fwd, dim3(grid), dim3(512), mk::LDS_BYTES, stream, p);
}
```

```cpp
#include <hip/hip_runtime.h>
#include <cstdio>
#include <cstdint>
__device__ __forceinline__ int ltid() { int t = threadIdx.x; asm volatile("" : "+v"(t)); return t; }
__device__ __forceinline__ int lsg(int v) { asm volatile("" : "+s"(v)); return v; }
namespace pg8 {
#define PG8_LAS __attribute__((address_space(3)))
typedef unsigned short bf16_t;
typedef short bf16x8 __attribute__((ext_vector_type(8)));
typedef float f32x4 __attribute__((ext_vector_type(4)));
typedef unsigned u32x4 __attribute__((ext_vector_type(4)));
constexpr int BM = 256, BK = 64, HALF = 128, HTB = HALF * BK * 2  , STAGE_BYTES = 8 * HTB, NXCD = 8, WGM = 8;

__host__ __device__ __forceinline__ int lds_byte(int r, int c) { const int st = (r >> 4) * 2 + (c >> 5), rr = r & 15, cc = c & 31, ob = rr * 64 + cc * 2; return st * 1024 + (ob ^ (((ob >> 9) & 1) << 5)); }
__host__ __device__ __forceinline__ void stage_rc(int b, int& R, int& C) { const int st = b / 1024, sb = b % 1024, swz = sb ^ (((sb >> 9) & 1) << 5); R = (st >> 1) * 16 + swz / 64; C = (st & 1) * 32 + (swz % 64) / 2; }
__host__ __device__ __forceinline__ int perm32(int rho) { const int n = rho >> 4, i = rho & 15; return 8 * (i >> 2) + 4 * n + (i & 3); }

struct Unit { int pm, pn; };
struct Gemm { const bf16_t* A; const bf16_t* Bt; int M, N, K; };

struct StaticOrder {
    int nM, nN, nwg, G, c;
    __host__ __device__ void init(int M, int N, int G_, int c_) { nM = M / BM; nN = N / BM; nwg = nM * nN; G = G_; c = c_; }
    __host__ __device__ bool next(int i, Unit& u) const {
        const long L = (long)i * G + c; if (L >= nwg) return false;
        int wgid = (int)L; { const int q = nwg / NXCD, r = nwg % NXCD, xcd = wgid % NXCD, off = wgid / NXCD; wgid = (xcd < r ? xcd * (q + 1) : r * (q + 1) + (xcd - r) * q) + off; }
        const int nig = WGM * nN, gid = wgid / nig, fm = gid * WGM, gsz = (nM - fm) < WGM ? (nM - fm) : WGM;
        u.pm = fm + ((wgid % nig) % gsz); u.pn = (wgid % nig) / gsz; return true;
    }
    __device__ __forceinline__ void a_ready(const Unit&) const {}
    __device__ __forceinline__ void done(const Unit&) const {}
};
struct CountedOrder : StaticOrder {
    const unsigned* ready; unsigned need; unsigned* tmo;
    __device__ __forceinline__ void a_ready(const Unit& u) const {
        if (threadIdx.x < 64) {
            const unsigned long long t0 = __builtin_amdgcn_s_memrealtime(); unsigned polls = 0;
            while ((unsigned)__builtin_amdgcn_readfirstlane(__hip_atomic_load(ready + 64 * u.pm, __ATOMIC_RELAXED, __HIP_MEMORY_SCOPE_AGENT)) < need) {
                if ((++polls & 255u) == 0u && __builtin_amdgcn_readfirstlane(__hip_atomic_load(tmo, __ATOMIC_RELAXED, __HIP_MEMORY_SCOPE_AGENT)) != 0u) break;
                if (__builtin_amdgcn_s_memrealtime() - t0 > 2000000ull) {
                    if (threadIdx.x == 0) { unsigned expect = 0u; __hip_atomic_compare_exchange_strong(tmo + 1, &expect, 0x600u | (unsigned)(u.pm & 0xff), __ATOMIC_RELAXED, __ATOMIC_RELAXED, __HIP_MEMORY_SCOPE_AGENT); __hip_atomic_store(tmo, 1u, __ATOMIC_RELAXED, __HIP_MEMORY_SCOPE_AGENT); }
                    break; }
                __builtin_amdgcn_s_sleep(2); }
            __builtin_amdgcn_fence(__ATOMIC_ACQUIRE, "agent");
            asm volatile("s_waitcnt vmcnt(0)" ::: "memory");
        }
#if !defined(BROKEN_HOOK_NO_BARRIER)
        asm volatile("" ::: "memory"); __builtin_amdgcn_s_barrier(); asm volatile("" ::: "memory");
#endif
    }
};

__device__ __forceinline__ unsigned cvt_pk_bf16(float lo, float hi) { unsigned r; asm volatile("v_cvt_pk_bf16_f32 %0, %1, %2" : "=v"(r) : "v"(lo), "v"(hi)); return r; }
typedef float f32x2 __attribute__((ext_vector_type(2)));
__device__ __forceinline__ f32x2 gelu_pk(f32x2 v) {
    const f32x2 av = __builtin_elementwise_abs(v), d = av * 0.2316418882f + 1.0f;
    f32x2 t; t.x = __builtin_amdgcn_rcpf(d.x); t.y = __builtin_amdgcn_rcpf(d.y);
    f32x2 q = t * 0.5307027145f + (-0.7265760135f); q = q * t + 0.7107068705f; q = q * t + (-0.142248368f); q = q * t + 0.127414796f; q = q * t;
    const f32x2 s = (v * v) * (-0.72134752044f);
    f32x2 e; e.x = __builtin_amdgcn_exp2f(s.x); e.y = __builtin_amdgcn_exp2f(s.y);
    const f32x2 m = v * (q * e), r = v - m;
    f32x2 o; o.x = v.x < 0.f ? m.x : r.x; o.y = v.y < 0.f ? m.y : r.y; return o;
}

struct EpiF32 {
    static constexpr bool PERM = false, AFTER_DRAIN = false;
    float* C; int ldc; const float* bias;
    __device__ __forceinline__ void operator()(const f32x4 (&acc)[2][2][4][2], const Unit& u, int wr, int wc, int fr, int fq) const {
        const int row0 = u.pm * BM + wr * 64 + fr, col0 = u.pn * BM + wc * 32 + 4 * fq;
        f32x4 bv[2][2];
#pragma unroll
        for (int bj = 0; bj < 2; ++bj)
#pragma unroll
            for (int n = 0; n < 2; ++n) bv[bj][n] = bias ? *(const f32x4*)(bias + col0 + bj * HALF + n * 16) : (f32x4){0.f, 0.f, 0.f, 0.f};
#pragma unroll
        for (int ai = 0; ai < 2; ++ai)
#pragma unroll
            for (int m = 0; m < 4; ++m) { float* rowp = C + (size_t)(row0 + ai * HALF + m * 16) * ldc + col0;
#pragma unroll
                for (int bj = 0; bj < 2; ++bj)
#pragma unroll
                    for (int n = 0; n < 2; ++n) *(f32x4*)(rowp + bj * HALF + n * 16) = acc[ai][bj][m][n] + bv[bj][n]; }
    }
};
template <int ACT  > struct EpiBf16 {
    static constexpr bool PERM = true, AFTER_DRAIN = false;
    bf16_t* O; int ldc; const float* bias; int split_cols; size_t split_stride;
    __device__ __forceinline__ void operator()(const f32x4 (&acc)[2][2][4][2], const Unit& u, int wr, int wc, int fr, int fq) const {
        const int row0 = u.pm * BM + wr * 64 + fr; int colt = u.pn * BM; bf16_t* base = O;
        if (split_cols) { const int t = colt / split_cols; base += (size_t)t * split_stride; colt -= t * split_cols; }
        const int col0 = colt + wc * 32 + 8 * fq, bcol0 = u.pn * BM + wc * 32 + 8 * fq;
        f32x4 bv[2][2];
#pragma unroll
        for (int bj = 0; bj < 2; ++bj)
#pragma unroll
            for (int n = 0; n < 2; ++n) bv[bj][n] = bias ? *(const f32x4*)(bias + bcol0 + bj * HALF + 4 * n) : (f32x4){0.f, 0.f, 0.f, 0.f};
#pragma unroll
        for (int ai = 0; ai < 2; ++ai)
#pragma unroll
            for (int m = 0; m < 4; ++m) { bf16_t* rowp = base + (size_t)(row0 + ai * HALF + m * 16) * ldc + col0;
#pragma unroll
                for (int bj = 0; bj < 2; ++bj) { f32x4 v0 = acc[ai][bj][m][0] + bv[bj][0], v1 = acc[ai][bj][m][1] + bv[bj][1];
                    if (ACT == 1) { f32x2 a = gelu_pk((f32x2){v0[0], v0[1]}), b = gelu_pk((f32x2){v0[2], v0[3]}), c = gelu_pk((f32x2){v1[0], v1[1]}), d = gelu_pk((f32x2){v1[2], v1[3]});
                        v0 = (f32x4){a.x, a.y, b.x, b.y}; v1 = (f32x4){c.x, c.y, d.x, d.y}; }
                    if (ACT == 2) {
#pragma unroll
                        for (int j = 0; j < 4; ++j) { v0[j] = 0.5f * v0[j] * (1.0f + erff(v0[j] * 0.70710678f)); v1[j] = 0.5f * v1[j] * (1.0f + erff(v1[j] * 0.70710678f)); } }
                    u32x4 w; w.x = cvt_pk_bf16(v0[0], v0[1]); w.y = cvt_pk_bf16(v0[2], v0[3]); w.z = cvt_pk_bf16(v1[0], v1[1]); w.w = cvt_pk_bf16(v1[2], v1[3]);
                    *(u32x4*)(rowp + bj * HALF) = w; } }
    }
};
template <class Epi, class Sched, bool STAMP = false>
__device__ __forceinline__ void gemm_phase(PG8_LAS unsigned char* lds, const Gemm g, const Sched& S, const Epi& E, unsigned long long* stamps) {
    const int tid = ltid(), wid = __builtin_amdgcn_readfirstlane(tid >> 6), lane = tid & 63, wr = wid >> 2, wc = wid & 3, fr = lane & 15, fq = lane >> 4;
    const int K = g.K, nt = K / BK;
    int ts_lo = 0, ts_hi = 0, nts = 0; const unsigned long long rt_entry = STAMP ? (unsigned long long)wall_clock64() : 0ull;
#define PG8_STAMP() do { if (STAMP && wid == 0 && nts < 64) { const unsigned long long _c = (unsigned long long)clock64(); \
        ts_lo = (lane == nts) ? (int)(unsigned)_c : ts_lo; ts_hi = (lane == nts) ? (int)(unsigned)(_c >> 32) : ts_hi; ++nts; } } while (0)
    PG8_STAMP();
    unsigned voffA[2], voffB[2];
#pragma unroll
    for (int i = 0; i < 2; ++i) { int R, C; stage_rc(tid * 16 + i * 8192, R, C); const int Rb = Epi::PERM ? ((R & ~31) + perm32(R & 31)) : R;
        voffA[i] = (unsigned)(R * K + C) * 2u; voffB[i] = (unsigned)(Rb * K + C) * 2u; }
    const size_t kstep = (size_t)(BK * 2);
    const size_t hstep = (size_t)HALF * K * 2;
    const size_t tstep = 2 * hstep;
    const unsigned ldsw = (unsigned)wid * 1024u;
    const int aoff = lds_byte(wr * 64 + fr, fq * 8), boff = lds_byte(wc * 32 + fr, fq * 8);
#define PG8_SA(b, h) (((b) * 2 + (h)) * HTB)
#define PG8_SB(b, h) ((4 + (b) * 2 + (h)) * HTB)
#define PG8_STAGE(bufoff, gbase, voff) do { _Pragma("unroll") for (int _i = 0; _i < 2; ++_i) \
        __builtin_amdgcn_global_load_lds((const unsigned*)((const char*)(gbase) + (voff)[_i]), (PG8_LAS unsigned*)(lds + (bufoff) + ldsw + _i * 8192), 16, 0, 0); } while (0)
#define PG8_LDA(dst, b, h) do { _Pragma("unroll") for (int m = 0; m < 4; ++m) _Pragma("unroll") for (int k = 0; k < 2; ++k) dst[m][k] = *(const PG8_LAS bf16x8*)(lds + PG8_SA(b, h) + aoff + m * 2048 + k * 1024); } while (0)
#define PG8_LDB(dst, b, h) do { _Pragma("unroll") for (int n = 0; n < 2; ++n) _Pragma("unroll") for (int k = 0; k < 2; ++k) dst[n][k] = *(const PG8_LAS bf16x8*)(lds + PG8_SB(b, h) + boff + n * 2048 + k * 1024); } while (0)
#define PG8_MMA(ai, bj, At, Bt) do { __builtin_amdgcn_s_setprio(1); _Pragma("unroll") for (int m = 0; m < 4; ++m) _Pragma("unroll") for (int n = 0; n < 2; ++n) _Pragma("unroll") for (int k = 0; k < 2; ++k) \
        acc[ai][bj][m][n] = __builtin_amdgcn_mfma_f32_16x16x32_bf16(Bt[n][k], At[m][k], acc[ai][bj][m][n], 0, 0, 0); __builtin_amdgcn_s_setprio(0); } while (0)
#define PG8_WAIT_V(n) asm volatile("s_waitcnt vmcnt(" #n ")" ::: "memory")
#define PG8_WAIT_L(n) asm volatile("s_waitcnt lgkmcnt(" #n ")" ::: "memory")
#define PG8_BAR __builtin_amdgcn_s_barrier()
#define PG8_SCHED __builtin_amdgcn_sched_barrier(0)
    Unit cur, nxt; int ui = 0;
    if (!S.next(0, cur)) return;
    f32x4 acc[2][2][4][2];
#pragma unroll
    for (int a = 0; a < 2; ++a)
#pragma unroll
        for (int b = 0; b < 2; ++b)
#pragma unroll
            for (int m = 0; m < 4; ++m)
#pragma unroll
                for (int n = 0; n < 2; ++n) acc[a][b][m][n] = (f32x4){0.f, 0.f, 0.f, 0.f};
    bf16x8 At[4][2], B0[2][2], B1[2][2];
    const char* cA = (const char*)g.A + (size_t)cur.pm * tstep; const char* cB = (const char*)g.Bt + (size_t)cur.pn * tstep;
    S.a_ready(cur);
    PG8_STAGE(PG8_SB(0, 0), cB, voffB); PG8_STAGE(PG8_SA(0, 0), cA, voffA); PG8_STAGE(PG8_SB(0, 1), cB + hstep, voffB); PG8_STAGE(PG8_SA(0, 1), cA + hstep, voffA);
    if (wr == 1) PG8_BAR;
    PG8_WAIT_V(4); PG8_BAR;
    PG8_STAGE(PG8_SB(1, 0), cB + kstep, voffB); PG8_STAGE(PG8_SA(1, 0), cA + kstep, voffA); PG8_STAGE(PG8_SB(1, 1), cB + hstep + kstep, voffB);
    PG8_WAIT_V(6); PG8_BAR;
    PG8_STAMP();
    for (;;) {
        const bool has_next = S.next(ui + 1, nxt);
        const char* nA = has_next ? (const char*)g.A + (size_t)nxt.pm * tstep : cA; const char* nB = has_next ? (const char*)g.Bt + (size_t)nxt.pn * tstep : cB;
        for (int t = 0; t < nt; t += 2) {
            const bool last = (t == nt - 2);
            const char* a1 = cA + (size_t)(t + 1) * kstep;
            const char* a2 = last ? nA : cA + (size_t)(t + 2) * kstep; const char* b2 = last ? nB : cB + (size_t)(t + 2) * kstep;
            const char* a3 = a2 + kstep; const char* b3 = b2 + kstep;
            if (last && has_next) S.a_ready(nxt);
            PG8_LDB(B0, 0, 0); PG8_SCHED; PG8_LDA(At, 0, 0); PG8_STAGE(PG8_SA(1, 1), a1 + hstep, voffA);
            PG8_WAIT_L(8); PG8_BAR; PG8_WAIT_L(0); PG8_MMA(0, 0, At, B0); PG8_BAR; PG8_SCHED;
            PG8_LDB(B1, 0, 1); PG8_STAGE(PG8_SB(0, 0), b2, voffB);
            PG8_BAR; PG8_WAIT_L(0); PG8_MMA(0, 1, At, B1); PG8_BAR;
            PG8_LDA(At, 0, 1); PG8_STAGE(PG8_SA(0, 0), a2, voffA);
            PG8_BAR; PG8_WAIT_L(0); PG8_MMA(1, 0, At, B0); PG8_BAR; PG8_SCHED;
            PG8_STAGE(PG8_SB(0, 1), b2 + hstep, voffB);
            PG8_WAIT_V(6); PG8_BAR; PG8_MMA(1, 1, At, B1); PG8_BAR;
            PG8_LDB(B0, 1, 0); PG8_SCHED; PG8_LDA(At, 1, 0); PG8_STAGE(PG8_SA(0, 1), a2 + hstep, voffA);
            PG8_WAIT_L(8); PG8_BAR; PG8_WAIT_L(0); PG8_MMA(0, 0, At, B0); PG8_BAR; PG8_SCHED;
            PG8_LDB(B1, 1, 1); PG8_STAGE(PG8_SB(1, 0), b3, voffB);
            PG8_BAR; PG8_WAIT_L(0); PG8_MMA(0, 1, At, B1); PG8_BAR;
            PG8_LDA(At, 1, 1); PG8_STAGE(PG8_SA(1, 0), a3, voffA);
            PG8_BAR; PG8_WAIT_L(0); PG8_MMA(1, 0, At, B0); PG8_BAR; PG8_SCHED;
            PG8_STAGE(PG8_SB(1, 1), b3 + hstep, voffB);
            PG8_WAIT_V(6); PG8_BAR; PG8_MMA(1, 1, At, B1); PG8_BAR;
        }
        PG8_STAMP();
        if constexpr (!Epi::AFTER_DRAIN) { E(acc, cur, wr, wc, fr, fq); S.done(cur); }
        PG8_STAMP();
        if (!has_next) break;
#pragma unroll
        for (int a = 0; a < 2; ++a)
#pragma unroll
            for (int b = 0; b < 2; ++b)
#pragma unroll
                for (int m = 0; m < 4; ++m)
#pragma unroll
                    for (int n = 0; n < 2; ++n) acc[a][b][m][n] = (f32x4){0.f, 0.f, 0.f, 0.f};
        cur = nxt; cA = nA; cB = nB; ++ui;
    }
    PG8_WAIT_V(0);
    if (wr == 0) PG8_BAR;
    PG8_BAR;
    if constexpr (Epi::AFTER_DRAIN) { E.fused(acc, cur, wr, wc, fr, fq, lds, wid, lane); S.done(cur); }
    PG8_STAMP();
    if (STAMP && wid == 0) { stamps[lane] = lane < nts ? (((unsigned long long)(unsigned)ts_hi << 32) | (unsigned)ts_lo) : 0ull;
        if (lane == 62) stamps[62] = rt_entry; if (lane == 63) stamps[63] = (unsigned long long)wall_clock64(); }
#undef PG8_STAMP
#undef PG8_SA
#undef PG8_SB
#undef PG8_STAGE
#undef PG8_LDA
#undef PG8_LDB
#undef PG8_MMA
#undef PG8_WAIT_V
#undef PG8_WAIT_L
#undef PG8_BAR
#undef PG8_SCHED
}
}
#define XB_TMO      128
#define XB_XCNT(j)  (256  + 64 * (j))
#define XB_XSUB(j)  (1280 + 64 * (j))
#define XB_XGEN(j)  (2304 + 64 * (j))
#define XB_TOP      3328
#define XB_TOPGEN   3392
#define XCD_BAR_WORDS 3456
#define XB_SPIN_CAP (1u << 22)
#define LAS __attribute__((address_space(3)))

__device__ __forceinline__ unsigned xb_ld(unsigned* p)              { return __hip_atomic_load(p, __ATOMIC_RELAXED, __HIP_MEMORY_SCOPE_AGENT); }
__device__ __forceinline__ unsigned xb_add(unsigned* p, unsigned v) { return __hip_atomic_fetch_add(p, v, __ATOMIC_RELAXED, __HIP_MEMORY_SCOPE_AGENT); }
__device__ __forceinline__ unsigned xb_xcc_id() { return (unsigned)__builtin_amdgcn_s_getreg((3 << 11) | 20) & 0xFu; }
#define XB_SPIN(cond, bar) do { unsigned _sp = 0; while (cond) { __builtin_amdgcn_s_sleep(1); \
    if ((++_sp & 255u) == 0u) { if (xb_ld(&(bar)[XB_TMO])) break; if (_sp > XB_SPIN_CAP) { atomicAdd(&(bar)[XB_TMO], 1u); break; } } } } while (0)

struct XcdBarrier {
    unsigned* bar; unsigned x;
    volatile LAS unsigned* st;
};

__device__ __forceinline__ XcdBarrier xcd_barrier_post(unsigned* bar, volatile LAS unsigned* st) {
    XcdBarrier b; b.bar = bar; b.x = xb_xcc_id(); b.st = st;
    if (threadIdx.x == 0) (void)xb_add(&bar[XB_XCNT(b.x)], 1u);
    return b;
}
__device__ __forceinline__ void xcd_barrier_complete(unsigned* bar, unsigned x, unsigned& nloc, unsigned& nx) {
    const unsigned G = gridDim.x * gridDim.y * gridDim.z;
    unsigned sum, cnt, mine, sp = 0u;
    for (;;) {
        sum = 0u; cnt = 0u; mine = 0u;
#pragma unroll
        for (unsigned j = 0; j < 16; ++j) { const unsigned c = xb_ld(&bar[XB_XCNT(j)]); sum += c; cnt += (c > 0u) ? 1u : 0u; mine = (j == x) ? c : mine; }
        if (sum == G) break;
        __builtin_amdgcn_s_sleep(1);
        if ((++sp & 255u) == 0u) { if (xb_ld(&bar[XB_TMO])) break; if (sp > XB_SPIN_CAP) { atomicAdd(&bar[XB_TMO], 1u); break; } }
    }
    nloc = mine > 0u ? mine : 1u; nx = cnt > 0u ? cnt : 1u;
}

__device__ __forceinline__ void xcd_barrier(const XcdBarrier& b) {
    asm volatile("s_waitcnt vmcnt(0)" ::: "memory");
    __syncthreads();
    if (threadIdx.x == 0) {
        unsigned* bar = b.bar;
        __builtin_amdgcn_s_waitcnt(0);
        unsigned nloc = b.st[0], nx = b.st[1];
        if (nloc == 0u) { xcd_barrier_complete(bar, b.x, nloc, nx); b.st[0] = nloc; b.st[1] = nx; }
        const unsigned old = xb_add(&bar[XB_XSUB(b.x)], 1u);
        const unsigned gen = old / nloc;
        if (old + 1u == (gen + 1u) * nloc) {
            __builtin_amdgcn_fence(__ATOMIC_RELEASE, "agent");
            asm volatile("s_waitcnt vmcnt(0)" ::: "memory");
            const unsigned og = xb_add(&bar[XB_TOP], 1u);
            const unsigned tg = og / nx;
            if (og + 1u == (tg + 1u) * nx) xb_add(&bar[XB_TOPGEN], 1u);
            else XB_SPIN(xb_ld(&bar[XB_TOPGEN]) == tg, bar);
            __builtin_amdgcn_fence(__ATOMIC_ACQUIRE, "agent");
            xb_add(&bar[XB_XGEN(b.x)], 1u);
            asm volatile("s_waitcnt vmcnt(0)" ::: "memory");
        } else {
            XB_SPIN(xb_ld(&bar[XB_XGEN(b.x)]) == gen, bar);
            __builtin_amdgcn_fence(__ATOMIC_ACQUIRE, "agent");
            asm volatile("s_waitcnt vmcnt(0)" ::: "memory");
        }
    }
    __syncthreads();
}
namespace att {
using bf16 = unsigned short;
constexpr int   D = 128, NW = 8, QBLK = 32, KVBLK = 64;
constexpr float SCALE = 0.088388347648318440f;
constexpr float THR = 8.f;
constexpr int SDEPTH = 2;
constexpr int LDQ = 16512, LDK = 16512, LDO = 4096;
constexpr size_t SHM_V = KVBLK * D * 2, SHM_K = KVBLK * D * 2, SHM_ATTN = 2 * SHM_V + 2 * SHM_K + NW * 64 * 4;
using bf16x8 = __attribute__((ext_vector_type(8))) short;
using s16x4  = __attribute__((ext_vector_type(4))) short;
using f32x16 = __attribute__((ext_vector_type(16))) float;
using f32x8  = __attribute__((ext_vector_type(8))) float;
using u32x4  = __attribute__((ext_vector_type(4))) unsigned;
#define KSWZ(row, colB) ((row) * 256 + ((colB) ^ (((row) & 7) << 4)))
#define SBAR() __builtin_amdgcn_sched_barrier(0)
__device__ __forceinline__ int crow(int r, int hi) { return (r & 3) + 8 * (r >> 2) + 4 * hi; }
__device__ __forceinline__ unsigned cvtpk(float lo, float hi) {
  unsigned r; asm volatile("v_cvt_pk_bf16_f32 %0, %1, %2" : "=v"(r) : "v"(lo), "v"(hi)); return r;
}
template <typename TIn> struct Stage;
template <> struct Stage<bf16>  { using T = bf16x8;
  __device__ static __forceinline__ T ld8(const bf16* p) { return *reinterpret_cast<const bf16x8*>(p); }
  __device__ static __forceinline__ bf16x8 tobf(T x) { return x; } };
template <> struct Stage<float> { using T = f32x8;
  __device__ static __forceinline__ T ld8(const float* p) { return *reinterpret_cast<const f32x8*>(p); }
  __device__ static __forceinline__ bf16x8 tobf(T x) {
    u32x4 w = {cvtpk(x[0], x[1]), cvtpk(x[2], x[3]), cvtpk(x[4], x[5]), cvtpk(x[6], x[7])}; return *reinterpret_cast<bf16x8*>(&w); } };

__device__ __forceinline__ void partialSM(f32x16& p0, f32x16& p1, float& m_reg, float& mn, float& alpha) {
  constexpr float C = SCALE * 1.4426950408889634f;
  float pmax = p0[0]; for (int r = 1; r < 16; ++r) pmax = fmaxf(pmax, p0[r]); for (int r = 0; r < 16; ++r) pmax = fmaxf(pmax, p1[r]);
  { auto rr = __builtin_amdgcn_permlane32_swap(__float_as_uint(pmax), __float_as_uint(pmax), false, false);
    pmax = fmaxf(__uint_as_float(rr[0]), __uint_as_float(rr[1])); }
  if (__builtin_expect(__all(pmax - m_reg <= THR / SCALE), 1)) { mn = m_reg; alpha = 1.f; }
  else { mn = fmaxf(m_reg, pmax); alpha = __builtin_amdgcn_exp2f((m_reg - mn) * C); m_reg = mn; }
  float mnC = -mn * C;
  for (int r = 0; r < 16; ++r) p0[r] = fmaf(p0[r], C, mnC); for (int r = 0; r < 16; ++r) p1[r] = fmaf(p1[r], C, mnC);
  for (int r = 0; r < 16; ++r) p0[r] = __builtin_amdgcn_exp2f(p0[r]);
}
__device__ __forceinline__ void finishSM(f32x16& p0, f32x16& p1, float alpha, float& l_reg, bf16x8& pa0, bf16x8& pa1, bf16x8& pa2, bf16x8& pa3) {
  for (int r = 0; r < 16; ++r) p1[r] = __builtin_amdgcn_exp2f(p1[r]);
  float ps = 0; for (int r = 0; r < 16; ++r) ps += p0[r]; for (int r = 0; r < 16; ++r) ps += p1[r];
  { auto rr = __builtin_amdgcn_permlane32_swap(__float_as_uint(ps), __float_as_uint(ps), false, false);
    ps = __uint_as_float(rr[0]) + __uint_as_float(rr[1]); }
  l_reg = l_reg * alpha + ps;
#define PK4(P, BASE, OUT) do { unsigned a0 = cvtpk(P[BASE + 0], P[BASE + 1]), a1 = cvtpk(P[BASE + 2], P[BASE + 3]);   \
    unsigned b0 = cvtpk(P[BASE + 4], P[BASE + 5]), b1 = cvtpk(P[BASE + 6], P[BASE + 7]);                              \
    auto r0 = __builtin_amdgcn_permlane32_swap(a0, b0, false, false); auto r1 = __builtin_amdgcn_permlane32_swap(a1, b1, false, false); \
    u32x4 w = {r0[0], r1[0], r0[1], r1[1]}; OUT = *reinterpret_cast<bf16x8*>(&w); } while (0)
  PK4(p0, 0, pa0); PK4(p0, 8, pa1); PK4(p1, 0, pa2); PK4(p1, 8, pa3);
#undef PK4
}
__device__ __forceinline__ void qkt(f32x16& p0, f32x16& p1, const bf16* Ks, const bf16x8* qr, int r32, int hi) {
  p0 = f32x16{}; p1 = f32x16{};
  for (int d0 = 0; d0 < 8; ++d0) { int cb = (d0 * 16 + hi * 8) * 2;
    bf16x8 b0 = *reinterpret_cast<const bf16x8*>((const char*)Ks + KSWZ(r32, cb));
    bf16x8 b1 = *reinterpret_cast<const bf16x8*>((const char*)Ks + KSWZ(32 + r32, cb));
    p0 = __builtin_amdgcn_mfma_f32_32x32x16_bf16(b0, qr[d0], p0, 0, 0, 0);
    p1 = __builtin_amdgcn_mfma_f32_32x32x16_bf16(b1, qr[d0], p1, 0, 0, 0); }
}
__device__ __forceinline__ int v_st(int k, int c) { const int kk = (k & ~0xC) | ((k & 4) << 1) | ((k & 8) >> 1); return ((kk >> 3) * 4 + (c >> 5)) * 512 + ((kk & 7) * 32 + (c & 31)) * 2; }
__device__ __forceinline__ int v_rd_base(int lane) { return ((lane & 3) << 3) | (((lane >> 2) & 3) << 6) | (((lane >> 4) & 1) << 5) | (((lane >> 5) & 1) << 8); }
constexpr int v_rd_off(int d0, int ks, int half) { return d0 * 512 + ks * 4096 + half * 2048; }
template <int OFF> __device__ __forceinline__ s16x4 tr_read(int vb) {
  s16x4 r; asm volatile("ds_read_b64_tr_b16 %0, %1 offset:%2" : "=&v"(r) : "v"(vb), "i"(OFF) : "memory"); return r;
}
template <int D0> __device__ __forceinline__ void pv_one(f32x16& od, int vb, bf16x8 pa0, bf16x8 pa1, bf16x8 pa2, bf16x8 pa3) {
  const s16x4 l0 = tr_read<v_rd_off(D0, 0, 0)>(vb), h0 = tr_read<v_rd_off(D0, 0, 1)>(vb), l1 = tr_read<v_rd_off(D0, 1, 0)>(vb), h1 = tr_read<v_rd_off(D0, 1, 1)>(vb);
  const s16x4 l2 = tr_read<v_rd_off(D0, 2, 0)>(vb), h2 = tr_read<v_rd_off(D0, 2, 1)>(vb), l3 = tr_read<v_rd_off(D0, 3, 0)>(vb), h3 = tr_read<v_rd_off(D0, 3, 1)>(vb);
  asm volatile("s_waitcnt lgkmcnt(0)" ::: "memory"); SBAR();
#define PK(L, H) (bf16x8){L[0], L[1], L[2], L[3], H[0], H[1], H[2], H[3]}
  od = __builtin_amdgcn_mfma_f32_32x32x16_bf16(pa0, PK(l0, h0), od, 0, 0, 0);
  od = __builtin_amdgcn_mfma_f32_32x32x16_bf16(pa1, PK(l1, h1), od, 0, 0, 0);
  od = __builtin_amdgcn_mfma_f32_32x32x16_bf16(pa2, PK(l2, h2), od, 0, 0, 0);
  od = __builtin_amdgcn_mfma_f32_32x32x16_bf16(pa3, PK(l3, h3), od, 0, 0, 0);
#undef PK
}
__device__ __forceinline__ void pv_d0(f32x16* o, int vb, bf16x8 pa0, bf16x8 pa1, bf16x8 pa2, bf16x8 pa3) {
  pv_one<0>(o[0], vb, pa0, pa1, pa2, pa3); pv_one<1>(o[1], vb, pa0, pa1, pa2, pa3); pv_one<2>(o[2], vb, pa0, pa1, pa2, pa3); pv_one<3>(o[3], vb, pa0, pa1, pa2, pa3);
}

template <typename TQ>
__device__ __forceinline__ void attn_dense_body(const TQ* __restrict__ Qb, const bf16* __restrict__ Kh, const bf16* __restrict__ Vh,
                                                bf16* __restrict__ Ob, int seq, char* lds) {
  using St = Stage<bf16>; using SQ = Stage<TQ>;
  const int tid = ltid(), wid = tid >> 6, lane = tid & 63, r32 = lane & 31, hi = lane >> 5;
  bf16* V_lds = (bf16*)lds; bf16* K_lds = (bf16*)(lds + 2 * SHM_V);
  float* ws = (float*)(lds + 2 * SHM_V + 2 * SHM_K) + wid * 64; float* li_l = ws; float* al_l = ws + 32;
  float m_reg = -1e30f, l_reg = 0; f32x16 o[4] = {}; bf16x8 qr[8];
  const TQ* Qw = Qb + (long)(wid * QBLK + r32) * LDQ + hi * 8;
#pragma unroll
  for (int d0 = 0; d0 < 8; ++d0) qr[d0] = SQ::tobf(SQ::ld8(Qw + d0 * 16));
  const int sr = tid >> 4, sc = (tid & 15) * 8, vst0 = v_st(sr, sc), vst1 = v_st(32 + sr, sc);
  const int vb0 = (int)(uintptr_t)V_lds + v_rd_base(lane);
  struct { typename St::T vs0, vs1, ks0, ks1; } sr_[SDEPTH];
#define SLOAD(i, k0) do { sr_[i].vs0 = St::ld8(&Vh[(long)((k0) + sr) * LDK + sc]); sr_[i].vs1 = St::ld8(&Vh[(long)((k0) + 32 + sr) * LDK + sc]); \
    sr_[i].ks0 = St::ld8(&Kh[(long)((k0) + sr) * LDK + sc]); sr_[i].ks1 = St::ld8(&Kh[(long)((k0) + 32 + sr) * LDK + sc]); } while (0)
#define SWRITE(b, i) do { *(bf16x8*)((char*)V_lds + (b) * SHM_V + vst0) = St::tobf(sr_[i].vs0);          \
    *(bf16x8*)((char*)V_lds + (b) * SHM_V + vst1) = St::tobf(sr_[i].vs1); int kc = sc * 2;               \
    *(bf16x8*)((char*)K_lds + (b) * SHM_K + KSWZ(sr, kc)) = St::tobf(sr_[i].ks0);                       \
    *(bf16x8*)((char*)K_lds + (b) * SHM_K + KSWZ(32 + sr, kc)) = St::tobf(sr_[i].ks1); } while (0)
#define SWAIT() do { if constexpr (SDEPTH == 2) asm volatile("s_waitcnt vmcnt(4)" ::: "memory"); else asm volatile("s_waitcnt vmcnt(0)" ::: "memory"); } while (0)
#define RESC(a) do { if (__any((a) < 1.f)) { if (hi == 0) al_l[r32] = (a); asm volatile("s_waitcnt lgkmcnt(0)" ::: "memory"); \
    for (int d = 0; d < 4; ++d) for (int r = 0; r < 16; ++r) o[d][r] *= al_l[crow(r, hi)]; } } while (0)
  f32x16 pA0, pA1, pB0, pB1; float mnA, mnB, alA, alB; bf16x8 pa0, pa1, pa2, pa3; const int NT = seq / KVBLK;
  constexpr int SE = 0, SO = SDEPTH - 1;
  SLOAD(SE, 0); asm volatile("s_waitcnt vmcnt(0)" ::: "memory"); SWRITE(0, SE); __syncthreads();
  qkt(pA0, pA1, K_lds, qr, r32, hi); partialSM(pA0, pA1, m_reg, mnA, alA);
  SLOAD(SO, KVBLK); if constexpr (SDEPTH == 2) { if (2 < NT) SLOAD(SE, 2 * KVBLK); }
  SWAIT(); SWRITE(1, SO); __syncthreads();
  for (int j = 1; j + 1 < NT; j += 2) {
    SBAR(); qkt(pB0, pB1, (bf16*)((char*)K_lds + SHM_K), qr, r32, hi);
    finishSM(pA0, pA1, alA, l_reg, pa0, pa1, pa2, pa3); SBAR();
    SLOAD(SO, (j + SDEPTH) * KVBLK); SBAR();
    pv_d0(o, vb0, pa0, pa1, pa2, pa3); partialSM(pB0, pB1, m_reg, mnB, alB);
    __syncthreads(); SWAIT(); SWRITE(0, SE);
    RESC(alB); __syncthreads();
    SBAR(); qkt(pA0, pA1, K_lds, qr, r32, hi);
    finishSM(pB0, pB1, alB, l_reg, pa0, pa1, pa2, pa3); SBAR();
    if (SDEPTH == 1 || j + 3 < NT) SLOAD(SE, (j + 1 + SDEPTH) * KVBLK); SBAR();
    pv_d0(o, vb0 + (int)SHM_V, pa0, pa1, pa2, pa3); partialSM(pA0, pA1, m_reg, mnA, alA);
    __syncthreads(); SWAIT(); SWRITE(1, SO);
    RESC(alA); __syncthreads();
  }
  SBAR(); qkt(pB0, pB1, (bf16*)((char*)K_lds + SHM_K), qr, r32, hi);
  finishSM(pA0, pA1, alA, l_reg, pa0, pa1, pa2, pa3); SBAR();
  pv_d0(o, vb0, pa0, pa1, pa2, pa3); partialSM(pB0, pB1, m_reg, mnB, alB);
  __syncthreads(); RESC(alB);
  finishSM(pB0, pB1, alB, l_reg, pa0, pa1, pa2, pa3); SBAR();
  pv_d0(o, vb0 + (int)SHM_V, pa0, pa1, pa2, pa3);
  if (hi == 0) li_l[r32] = l_reg; asm volatile("s_waitcnt lgkmcnt(0)" ::: "memory");
  float rli[16];
#pragma unroll
  for (int r = 0; r < 16; ++r) rli[r] = __builtin_amdgcn_rcpf(li_l[crow(r, hi)]);
  bf16* Ow = Ob + (long)(wid * QBLK) * LDO;
#pragma unroll
  for (int r = 0; r < 16; ++r) { int orow = crow(r, hi);
    for (int d0 = 0; d0 < 4; ++d0) { const float ov = o[d0][r] * rli[r]; unsigned uu = __float_as_uint(ov); uu += 0x7FFFu + ((uu >> 16) & 1u); Ow[(long)orow * LDO + d0 * 32 + r32] = (bf16)(uu >> 16); } }
#undef SLOAD
#undef SWRITE
#undef SWAIT
#undef RESC
}
}

#ifndef PHM
#define PHM 255
#endif
namespace mk {
__device__ const double INVD[64] = {1,0.86596432336006535,0.74989420933245587,0.64938163157621132,0.56234132519034907,0.48696752516586311,0.42169650342858223,0.36517412725483772,0.31622776601683794,0.27384196342643613,0.23713737056616552,0.20535250264571461,0.17782794100389229,0.15399265260594919,0.1333521432163324,0.11547819846894582,0.10000000000000001,0.086596432336006529,0.074989420933245579,0.064938163157621132,0.056234132519034911,0.048696752516586311,0.042169650342858224,0.036517412725483769,0.031622776601683791,0.027384196342643614,0.023713737056616554,0.02053525026457146,0.017782794100389229,0.015399265260594919,0.013335214321633241,0.011547819846894581,0.01,0.0086596432336006543,0.0074989420933245579,0.006493816315762113,0.005623413251903491,0.004869675251658631,0.0042169650342858229,0.0036517412725483771,0.0031622776601683794,0.0027384196342643613,0.0023713737056616554,0.002053525026457146,0.0017782794100389228,0.001539926526059492,0.0013335214321633241,0.0011547819846894581,0.001,0.00086596432336006539,0.00074989420933245586,0.00064938163157621134,0.0005623413251903491,0.0004869675251658631,0.00042169650342858224,0.0003651741272548377,0.00031622776601683794,0.00027384196342643611,0.00023713737056616554,0.00020535250264571461,0.00017782794100389227,0.00015399265260594919,0.0001333521432163324,0.00011547819846894582};
typedef unsigned short bf16_t;
typedef float f32x4 __attribute__((ext_vector_type(4)));
typedef unsigned u32x4 __attribute__((ext_vector_type(4)));
typedef unsigned u32x2 __attribute__((ext_vector_type(2)));
typedef float f32x2 __attribute__((ext_vector_type(2)));
constexpr int DM = 4096, NPROJ = 16384, LDP = 16512  , DFF = 16384, MH = 16384, MC = 16384;
constexpr size_t MiB = 1ull << 20;
constexpr size_t WS_CTL = 0, WS_WIN = 1 * MiB, WS_WOUT = WS_WIN + 128 * MiB, WS_WUP = WS_WOUT + 32 * MiB, WS_WDN = WS_WUP + 128 * MiB,
                 WS_HB = WS_WDN + 128 * MiB, WS_PROJ = WS_HB + 128 * MiB, WS_OB = WS_PROJ + 520 * MiB, WS_ST = WS_OB + 128 * MiB,
                 WS_PD = WS_ST + 128 * MiB, WS_END = WS_PD + 1 * MiB;
constexpr int LDS_BAR_OFF = 135168, LDS_BYTES = 135168 + 64;
constexpr float EPS = 1e-6f;

__device__ __forceinline__ float bf2f(unsigned b) { return __uint_as_float(b << 16); }
__device__ __forceinline__ float bflo(unsigned w) { return __uint_as_float(w << 16); }
__device__ __forceinline__ float bfhi(unsigned w) { return __uint_as_float(w & 0xffff0000u); }
__device__ __forceinline__ unsigned short f2bf(float f) { unsigned u = __float_as_uint(f); u += 0x7FFFu + ((u >> 16) & 1u); return (unsigned short)(u >> 16); }
__device__ __forceinline__ unsigned pk(float lo, float hi) { return pg8::cvt_pk_bf16(lo, hi); }

template <int ACT> struct EpiB {
    static constexpr bool PERM = true, AFTER_DRAIN = false;
    bf16_t* O; int ldc;
    __device__ __forceinline__ void operator()(const pg8::f32x4 (&acc)[2][2][4][2], const pg8::Unit& u, int wr, int wc, int fr, int fq) const {
        const int row0 = u.pm * 256 + wr * 64 + fr, col0 = u.pn * 256 + wc * 32 + 8 * fq;
#pragma unroll
        for (int ai = 0; ai < 2; ++ai)
#pragma unroll
            for (int m = 0; m < 4; ++m) { bf16_t* rowp = O + (size_t)(row0 + ai * 128 + m * 16) * ldc + col0;
#pragma unroll
                for (int bj = 0; bj < 2; ++bj) { pg8::f32x4 v0 = acc[ai][bj][m][0], v1 = acc[ai][bj][m][1];
                    if (ACT == 1) {
#pragma unroll
                        for (int j = 0; j < 4; ++j) { const float a = fmaxf(v0[j], 0.f), b = fmaxf(v1[j], 0.f); v0[j] = a * a; v1[j] = b * b; } }
                    pg8::u32x4 w; w.x = pk(v0[0], v0[1]); w.y = pk(v0[2], v0[3]); w.z = pk(v1[0], v1[1]); w.w = pk(v1[2], v1[3]);
                    *(pg8::u32x4*)(rowp + bj * 128) = w; } }
    }
};
struct EpiRes {
    static constexpr bool PERM = false, AFTER_DRAIN = false;
    const float* base; float* C; int ldc;
    __device__ __forceinline__ void operator()(const pg8::f32x4 (&acc)[2][2][4][2], const pg8::Unit& u, int wr, int wc, int fr, int fq) const {
        const int row0 = u.pm * 256 + wr * 64 + fr, col0 = u.pn * 256 + wc * 32 + 4 * fq;
#pragma unroll
        for (int ai = 0; ai < 2; ++ai)
#pragma unroll
            for (int m = 0; m < 4; ++m) { const size_t off = (size_t)(row0 + ai * 128 + m * 16) * ldc + col0;
#pragma unroll
                for (int bj = 0; bj < 2; ++bj)
#pragma unroll
                    for (int n = 0; n < 2; ++n) { const pg8::f32x4 b = *(const pg8::f32x4*)(base + off + bj * 128 + n * 16);
                        *(pg8::f32x4*)(C + off + bj * 128 + n * 16) = acc[ai][bj][m][n] + b; } }
    }
};

__device__ __forceinline__ void transpose_cvt(const float* __restrict__ W, bf16_t* __restrict__ Wt, int K, int N, float* tile, int bid, int nb) {
    const int tid = ltid(); const int ntn = N / 64, nt = (K / 64) * ntn;
    f32x4 pv[2];
#define TLOAD(t_) do { const int tn_ = (t_) % ntn, tk_ = (t_) / ntn; const float* src_ = W + (size_t)(tk_ * 64) * N + tn_ * 64; \
        _Pragma("unroll") for (int i = 0; i < 2; ++i) pv[i] = *(const f32x4*)(src_ + (size_t)((tid >> 4) + i * 32) * N + (tid & 15) * 4); } while (0)
    if (bid < nt) TLOAD(bid);
    for (int t = bid; t < nt; t += nb) {
        const int tn = t % ntn, tk = t / ntn;
#pragma unroll
        for (int i = 0; i < 2; ++i) { const int r = (tid >> 4) + i * 32, c = (tid & 15) * 4;
            tile[r * 65 + c] = pv[i][0]; tile[r * 65 + c + 1] = pv[i][1]; tile[r * 65 + c + 2] = pv[i][2]; tile[r * 65 + c + 3] = pv[i][3]; }
        __syncthreads();
        if (t + nb < nt) TLOAD(t + nb);
        const int n = tid >> 3, k8 = (tid & 7) * 8; float v[8];
#pragma unroll
        for (int i = 0; i < 8; ++i) v[i] = tile[(k8 + i) * 65 + n];
        u32x4 w; w.x = pk(v[0], v[1]); w.y = pk(v[2], v[3]); w.z = pk(v[4], v[5]); w.w = pk(v[6], v[7]);
        *(u32x4*)(Wt + (size_t)(tn * 64 + n) * K + tk * 64 + k8) = w;
        __syncthreads();
    }
#undef TLOAD
}

template <bool OUT_BF16>
__device__ __forceinline__ void rmsnorm_rows(const float* X, const float* __restrict__ w, void* out, int rows, int bid, int nb) {
    const int tid_ = ltid(); const int lane = tid_ & 63, wid = tid_ >> 6;
    for (int r = bid * 8 + wid; r < rows; r += nb * 8) {
        const float* x = X + (size_t)r * DM; f32x4 v[16]; float ss = 0.f;
#pragma unroll
        for (int i = 0; i < 16; ++i) { v[i] = *(const f32x4*)(x + i * 256 + lane * 4); ss += v[i][0] * v[i][0] + v[i][1] * v[i][1] + v[i][2] * v[i][2] + v[i][3] * v[i][3]; }
#pragma unroll
        for (int o = 32; o >= 1; o >>= 1) ss += __shfl_xor(ss, o);
        const float rs = rsqrtf(ss * (1.0f / DM) + EPS);
#pragma unroll
        for (int i = 0; i < 16; ++i) { const f32x4 ww = *(const f32x4*)(w + i * 256 + lane * 4); const f32x4 y = v[i] * rs * ww;
            if (OUT_BF16) { u32x2 o2; o2.x = pk(y[0], y[1]); o2.y = pk(y[2], y[3]); *(u32x2*)((bf16_t*)out + (size_t)r * DM + i * 256 + lane * 4) = o2; }
            else *(f32x4*)((float*)out + (size_t)r * DM + i * 256 + lane * 4) = y; }
    }
}

__device__ __forceinline__ void rope_phase(bf16_t* proj, int rows, int L, int bid, int nb) {
    const int tid_ = ltid(); const int lane = tid_ & 63, wid = tid_ >> 6, sub = lane >> 5, d = (lane & 31) * 2;
    const double i2pi = 0.15915494309189533577;
    for (int rp = bid * 8 + wid; rp < rows / 2; rp += nb * 8) {
        const int r = rp * 2 + sub, pos = r & (L - 1);
        double a0 = (double)pos * INVD[d] * i2pi, a1 = (double)pos * INVD[d + 1] * i2pi;
        a0 -= __builtin_rint(a0); a1 -= __builtin_rint(a1);
        const float f0 = (float)a0, f1 = (float)a1;
        const float c0 = __builtin_amdgcn_cosf(f0), s0 = __builtin_amdgcn_sinf(f0), c1 = __builtin_amdgcn_cosf(f1), s1 = __builtin_amdgcn_sinf(f1);
        bf16_t* row = proj + (size_t)r * LDP + d;
#pragma unroll 8
        for (int vct = 0; vct < 32; ++vct) { unsigned* p1 = (unsigned*)(row + vct * 128); unsigned* p2 = (unsigned*)(row + vct * 128 + 64);
            const unsigned w1 = *p1, w2 = *p2; const float x10 = bflo(w1), x11 = bfhi(w1), x20 = bflo(w2), x21 = bfhi(w2);
            *p1 = pk(x10 * c0 - x20 * s0, x11 * c1 - x21 * s1); *p2 = pk(x20 * c0 + x10 * s0, x21 * c1 + x11 * s1); }
    }
}

constexpr int HT = 256, HTB = 16;
template <bool PASS3>
__device__ __forceinline__ void hgrn_pass(bf16_t* proj, const float* __restrict__ hgrn_lb, float* ST, float* PD, int nseq, int L, float* lds, int bid, int nb) {
    const int tid = ltid(), g = tid >> 7, j = tid & 127;
    float* qs = lds + g * (3 * HTB * 128); float* fs = qs + HTB * 128; float* vs = fs + HTB * 128;
    const int NSC = L / HT, nitems = nseq * NSC * 8;
    const int sr = j >> 4, c8 = (j & 15) * 8;
    for (int it = bid; it < nitems; it += nb) {
        const int u = it * 4 + g, dir = u & 1, h = (u >> 1) & 15, sc = (u >> 5) % NSC, s = (u >> 5) / NSC;
        const size_t row0 = (size_t)s * L + (size_t)sc * HT;
        const int colq = 6144 + h * 128, colf = (dir ? 10240 : 8192) + h * 128, colv = 12288 + h * 128;
        float lb[8];
#pragma unroll
        for (int e = 0; e < 8; ++e) { const float a0 = hgrn_lb[dir * 4096 + h * 128 + c8 + e], a1 = hgrn_lb[dir * 4096 + 2048 + h * 128 + c8 + e]; lb[e] = 1.0f / (1.0f + __expf(a1 - a0)); }
        float S[128];
#pragma unroll
        for (int k = 0; k < 128; ++k) S[k] = PASS3 ? ST[(size_t)u * 16384 + k * 128 + j] : 0.f;
        float P = 1.f;
        u32x4 rq[2], rf[2], rv[2];
#define HLOAD(b) do { const size_t rb_ = row0 + (dir ? (HT - HTB * ((b) + 1)) : HTB * (b)); _Pragma("unroll") for (int i = 0; i < 2; ++i) { const bf16_t* p_ = proj + (rb_ + sr + 8 * i) * LDP + c8; \
            if (PASS3) rq[i] = *(const u32x4*)(p_ + colq); rf[i] = *(const u32x4*)(p_ + colf); rv[i] = *(const u32x4*)(p_ + colv); } } while (0)
        HLOAD(0);
        for (int b = 0; b < HT / HTB; ++b) {
            __syncthreads();
#pragma unroll
            for (int i = 0; i < 2; ++i) { const int ro = (sr + 8 * i) * 128 + c8;
#pragma unroll
                for (int e = 0; e < 4; ++e) {
                    const unsigned wf = rf[i][e], wv = rv[i][e];
                    const float f0 = bflo(wf), f1 = bfhi(wf);
                    fs[ro + 2 * e] = lb[2 * e] + (1.f - lb[2 * e]) / (1.f + __expf(-f0)); fs[ro + 2 * e + 1] = lb[2 * e + 1] + (1.f - lb[2 * e + 1]) / (1.f + __expf(-f1));
                    vs[ro + 2 * e] = bflo(wv); vs[ro + 2 * e + 1] = bfhi(wv);
                    if (PASS3) { const unsigned wq = rq[i][e]; const float q0 = bflo(wq), q1 = bfhi(wq); qs[ro + 2 * e] = q0 / (1.f + __expf(-q0)); qs[ro + 2 * e + 1] = q1 / (1.f + __expf(-q1)); }
                } }
            __syncthreads();
            if (b + 1 < HT / HTB) HLOAD(b + 1);
            const size_t rb = row0 + (dir ? (HT - HTB * (b + 1)) : HTB * b);
#pragma unroll 1
            for (int tt = 0; tt < HTB; ++tt) {
                const int t = dir ? (HTB - 1 - tt) : tt;
                const float v = vs[t * 128 + j]; f32x2 o2 = {0.f, 0.f};
#pragma unroll
                for (int k4 = 0; k4 < 32; ++k4) { const f32x4 f4 = *(const f32x4*)(fs + t * 128 + k4 * 4);
#pragma unroll
                    for (int e = 0; e < 4; ++e) S[k4 * 4 + e] = fmaf(f4[e], S[k4 * 4 + e] - v, v);
                    if (PASS3) { const f32x4 q4 = *(const f32x4*)(qs + t * 128 + k4 * 4);
#pragma unroll
                        for (int e = 0; e < 4; e += 2) { const f32x2 qq = {q4[e], q4[e + 1]}, sv = {S[k4 * 4 + e], S[k4 * 4 + e + 1]}; o2 = __builtin_elementwise_fma(qq, sv, o2); } } }
                if (PASS3) proj[(rb + t) * LDP + colf + j] = f2bf(o2[0] + o2[1]);
                else P *= fs[t * 128 + j];
            }
        }
#undef HLOAD
        if (!PASS3) {
#pragma unroll
            for (int k = 0; k < 128; ++k) ST[(size_t)u * 16384 + k * 128 + j] = S[k];
            PD[(size_t)u * 128 + j] = P; }
        __syncthreads();
    }
}

constexpr int LDT = 264;
__device__ __forceinline__ void hgrn_ends(const bf16_t* proj, const float* __restrict__ hgrn_lb, float* ST, float* PD, int nseq, int L, unsigned char* lds, int bid, int nb) {
    const int tid = ltid(), grp = tid >> 7, x = tid & 127, wid = tid >> 6, lane = tid & 63, fr = lane & 15, fq = lane >> 4;
    bf16_t* wT = (bf16_t*)lds; bf16_t* vT = (bf16_t*)(lds + 128 * LDT * 2);
    const int NSC = L / HT, nunits = nseq * NSC * 32;
    for (int u = bid; u < nunits; u += nb) {
        const int dir = u & 1, h = (u >> 1) & 15, sc = (u >> 5) % NSC, s = (u >> 5) / NSC;
        const size_t row0 = (size_t)s * L + (size_t)sc * HT;
        if (grp == 0) {
            const bf16_t* pf = proj + row0 * LDP + (dir ? 10240 : 8192) + h * 128 + x;
            const float a0 = hgrn_lb[dir * 4096 + h * 128 + x], a1 = hgrn_lb[dir * 4096 + 2048 + h * 128 + x]; const float lb = __builtin_amdgcn_rcpf(1.0f + __expf(a1 - a0));
            float R = 1.f; unsigned short raw[32], nxt[32];
#pragma unroll
            for (int i = 0; i < 32; ++i) { const int t = dir ? i : 255 - i; raw[i] = pf[(size_t)t * LDP]; }
#pragma unroll 1
            for (int tb = 0; tb < 8; ++tb) {
                if (tb < 7) {
#pragma unroll
                    for (int i = 0; i < 32; ++i) { const int t = dir ? (tb + 1) * 32 + i : 255 - ((tb + 1) * 32 + i); nxt[i] = pf[(size_t)t * LDP]; } }
#pragma unroll
                for (int i = 0; i < 32; ++i) { const int t = dir ? tb * 32 + i : 255 - (tb * 32 + i);
                    const float fraw = bf2f(raw[i]); const float f = lb + (1.f - lb) * __builtin_amdgcn_rcpf(1.f + __expf(-fraw));
                    wT[x * LDT + t] = f2bf((1.f - f) * R); R *= f; }
#pragma unroll
                for (int i = 0; i < 32; ++i) raw[i] = nxt[i];
            }
            PD[(size_t)u * 128 + x] = R;
        } else if (grp < 3) {
            const bf16_t* pv = proj + (row0 + (size_t)(grp - 1) * 128) * LDP + 12288 + h * 128 + x; bf16_t* dst = vT + x * LDT + (grp - 1) * 128;
#pragma unroll 1
            for (int tb = 0; tb < 4; ++tb) { unsigned short raw[32];
#pragma unroll
                for (int i = 0; i < 32; ++i) raw[i] = pv[(size_t)(tb * 32 + i) * LDP];
#pragma unroll
                for (int i = 0; i < 32; i += 2) *(unsigned*)(dst + tb * 32 + i) = (unsigned)raw[i] | ((unsigned)raw[i + 1] << 16); }
        }
        __syncthreads();
        pg8::f32x4 acc[8];
#pragma unroll
        for (int jb = 0; jb < 8; ++jb) acc[jb] = (pg8::f32x4){0.f, 0.f, 0.f, 0.f};
#pragma unroll
        for (int ks = 0; ks < 8; ++ks) { const pg8::bf16x8 a = *(const pg8::bf16x8*)(wT + (wid * 16 + fr) * LDT + ks * 32 + fq * 8);
#pragma unroll
            for (int jb = 0; jb < 8; ++jb) { const pg8::bf16x8 b = *(const pg8::bf16x8*)(vT + (jb * 16 + fr) * LDT + ks * 32 + fq * 8);
                acc[jb] = __builtin_amdgcn_mfma_f32_16x16x32_bf16(a, b, acc[jb], 0, 0, 0); } }
        float* st = ST + (size_t)u * 16384;
#pragma unroll
        for (int jb = 0; jb < 8; ++jb)
#pragma unroll
            for (int i = 0; i < 4; ++i) st[(wid * 16 + fq * 4 + i) * 128 + jb * 16 + fr] = acc[jb][i];
        __syncthreads();
    }
}

__device__ __forceinline__ void hgrn_out(bf16_t* proj, const float* __restrict__ hgrn_lb, const float* ST, int nseq, int L, unsigned char* lds, int bid, int nb) {
    const int tid = ltid(), wid = tid >> 6, lane = tid & 63, fr = lane & 15, fq = lane >> 4, x = tid & 127, role = tid >> 7;
    bf16_t* QD = (bf16_t*)lds; bf16_t* KD = QD + 32 * 136; bf16_t* KE = KD + 32 * 136; bf16_t* VT = KE + 128 * 40; bf16_t* SB = VT + 128 * 40; bf16_t* AM = SB + 128 * 136; float* DC = (float*)(AM + 32 * 40);
    const int NSC = L / HT, nunits = nseq * NSC * 32;
    for (int u = bid; u < nunits; u += nb) {
        const int dir = u & 1, h = (u >> 1) & 15, sc = (u >> 5) % NSC, s = (u >> 5) / NSC;
        const size_t row0 = (size_t)s * L + (size_t)sc * HT;
        const int colq = 6144 + h * 128, colf = (dir ? 10240 : 8192) + h * 128, colv = 12288 + h * 128;
        pg8::f32x4 Sacc[8];
        { const float* st = ST + (size_t)u * 16384;
#pragma unroll
          for (int jb = 0; jb < 8; ++jb)
#pragma unroll
              for (int r = 0; r < 4; ++r) Sacc[jb][r] = st[(wid * 16 + fq * 4 + r) * 128 + jb * 16 + fr]; }
        float lb = 0.f;
        if (role == 0) { const float a0 = hgrn_lb[dir * 4096 + h * 128 + x], a1 = hgrn_lb[dir * 4096 + 2048 + h * 128 + x]; lb = __builtin_amdgcn_rcpf(1.0f + __expf(a1 - a0)); }
        unsigned short ra[32], rb[32];
#define PLOAD(cc_) do { if (role == 0) { _Pragma("unroll") for (int i = 0; i < 32; ++i) { const int tt_ = (cc_) * 32 + i; const bf16_t* p_ = proj + (row0 + (dir ? 255 - tt_ : tt_)) * LDP + x; ra[i] = p_[colf]; rb[i] = p_[colq]; } } \
        else if (role == 1) { _Pragma("unroll") for (int i = 0; i < 32; ++i) { const int tt_ = (cc_) * 32 + i; ra[i] = proj[(row0 + (dir ? 255 - tt_ : tt_)) * LDP + colv + x]; } } } while (0)
        PLOAD(0);
#define SBWRITE() do { _Pragma("unroll") for (int jb = 0; jb < 8; ++jb) { u32x2 w_; w_.x = pk(Sacc[jb][0], Sacc[jb][1]); w_.y = pk(Sacc[jb][2], Sacc[jb][3]); *(u32x2*)(SB + (jb * 16 + fr) * 136 + wid * 16 + fq * 4) = w_; } } while (0)
        SBWRITE();
#pragma unroll 1
        for (int cc = 0; cc < 8; ++cc) {
            if (role == 0) { float D = 1.f; float kd[32];
#pragma unroll
                for (int i = 0; i < 32; ++i) { const float fraw = bf2f(ra[i]), qraw = bf2f(rb[i]); const float f = lb + (1.f - lb) * __builtin_amdgcn_rcpf(1.f + __expf(-fraw)); const float q = qraw * __builtin_amdgcn_rcpf(1.f + __expf(-qraw));
                    D *= f; QD[i * 136 + x] = f2bf(q * D); kd[i] = (1.f - f) * __builtin_amdgcn_rcpf(D); KD[i * 136 + x] = f2bf(kd[i]); }
                DC[x] = D;
#pragma unroll
                for (int i = 0; i < 32; i += 2) *(unsigned*)(KE + x * 40 + i) = pk(kd[i] * D, kd[i + 1] * D);
            } else if (role == 1) {
#pragma unroll
                for (int i = 0; i < 32; i += 2) *(unsigned*)(VT + x * 40 + i) = (unsigned)ra[i] | ((unsigned)ra[i + 1] << 16);
            }
            if (cc < 7) PLOAD(cc + 1);
            __syncthreads();
            if (wid < 4) { const int mb = wid >> 1, nbk = wid & 1; pg8::f32x4 acc = {0.f, 0.f, 0.f, 0.f};
#pragma unroll
                for (int ks = 0; ks < 4; ++ks) { const pg8::bf16x8 a = *(const pg8::bf16x8*)(QD + (mb * 16 + fr) * 136 + ks * 32 + fq * 8), b = *(const pg8::bf16x8*)(KD + (nbk * 16 + fr) * 136 + ks * 32 + fq * 8);
                    acc = __builtin_amdgcn_mfma_f32_16x16x32_bf16(a, b, acc, 0, 0, 0); }
#pragma unroll
                for (int r = 0; r < 4; ++r) { const int i = mb * 16 + fq * 4 + r, ip = nbk * 16 + fr; AM[i * 40 + ip] = (ip <= i) ? f2bf(acc[r]) : (unsigned short)0; } }
            __syncthreads();
            { const int mb = wid >> 2;
#pragma unroll
              for (int q2 = 0; q2 < 2; ++q2) { const int jb = (wid & 3) * 2 + q2; pg8::f32x4 acc = {0.f, 0.f, 0.f, 0.f};
                  { const pg8::bf16x8 a = *(const pg8::bf16x8*)(AM + (mb * 16 + fr) * 40 + fq * 8), b = *(const pg8::bf16x8*)(VT + (jb * 16 + fr) * 40 + fq * 8); acc = __builtin_amdgcn_mfma_f32_16x16x32_bf16(a, b, acc, 0, 0, 0); }
#pragma unroll
                  for (int ks = 0; ks < 4; ++ks) { const pg8::bf16x8 a = *(const pg8::bf16x8*)(QD + (mb * 16 + fr) * 136 + ks * 32 + fq * 8), b = *(const pg8::bf16x8*)(SB + (jb * 16 + fr) * 136 + ks * 32 + fq * 8);
                      acc = __builtin_amdgcn_mfma_f32_16x16x32_bf16(a, b, acc, 0, 0, 0); }
#pragma unroll
                  for (int r = 0; r < 4; ++r) { const int tt = cc * 32 + mb * 16 + fq * 4 + r; proj[(row0 + (dir ? 255 - tt : tt)) * LDP + colf + jb * 16 + fr] = f2bf(acc[r]); } } }
            { const pg8::f32x4 dc = *(const pg8::f32x4*)(DC + wid * 16 + fq * 4); const pg8::bf16x8 a = *(const pg8::bf16x8*)(KE + (wid * 16 + fr) * 40 + fq * 8);
#pragma unroll
              for (int jb = 0; jb < 8; ++jb) { const pg8::bf16x8 b = *(const pg8::bf16x8*)(VT + (jb * 16 + fr) * 40 + fq * 8); Sacc[jb] = Sacc[jb] * dc; Sacc[jb] = __builtin_amdgcn_mfma_f32_16x16x32_bf16(a, b, Sacc[jb], 0, 0, 0); } }
            __syncthreads();
            if (cc < 7) SBWRITE();
        }
#undef PLOAD
#undef SBWRITE
    }
}
__device__ __forceinline__ void hgrn_scan(float* ST, const float* PD, int nseq, int NSC, int bid, int nb) {
    const int nitems = nseq * 32 * 32; const int tid_ = ltid();
    for (int it = bid; it < nitems; it += nb) {
        const int eb = it & 31, hd = (it >> 5) & 31, s = it >> 10, dir = hd & 1;
        const int e = eb * 512 + tid_, k = e >> 7; float carry = 0.f;
        for (int cc = 0; cc < NSC; cc += 8) { float E[8], p[8]; size_t ui[8];
#pragma unroll
            for (int q = 0; q < 8; ++q) { const int c = dir ? NSC - 1 - (cc + q) : (cc + q); ui[q] = ((size_t)(s * NSC + c)) * 32 + hd; E[q] = ST[ui[q] * 16384 + e]; p[q] = PD[ui[q] * 128 + k]; }
#pragma unroll
            for (int q = 0; q < 8; ++q) { ST[ui[q] * 16384 + e] = carry; carry = fmaf(p[q], carry, E[q]); } }
    }
}

__device__ __forceinline__ void combine_phase(const bf16_t* OB, const bf16_t* proj, bf16_t* mix, const float* __restrict__ dl, const float* __restrict__ subln_w, const float* __restrict__ hnw, int rows, int bid, int nb) {
    const int tid_ = ltid(); const int lane = tid_ & 63, wid = tid_ >> 6;
    float a = dl[lane] * dl[128 + lane] + dl[64 + lane] * dl[192 + lane], b = dl[256 + lane] * dl[384 + lane] + dl[320 + lane] * dl[448 + lane];
#pragma unroll
    for (int o = 32; o >= 1; o >>= 1) { a += __shfl_xor(a, o); b += __shfl_xor(b, o); }
    const float lam = expf(a) - expf(b) + 0.2f;
    for (int r = bid * 8 + wid; r < rows; r += nb * 8) {
#pragma unroll
        for (int i = 0; i < 4; ++i) { const int head = i * 2 + (lane >> 5), e = (lane & 31) * 8;
            const bf16_t* o0 = OB + (size_t)r * DM + head * 512 + e; const u32x4 x0 = *(const u32x4*)o0, x1 = *(const u32x4*)(o0 + 256);
            float dv[8]; float ss = 0.f;
#pragma unroll
            for (int q = 0; q < 4; ++q) { dv[2 * q] = bflo(x0[q]) - lam * bflo(x1[q]); dv[2 * q + 1] = bfhi(x0[q]) - lam * bfhi(x1[q]); ss += dv[2 * q] * dv[2 * q] + dv[2 * q + 1] * dv[2 * q + 1]; }
#pragma unroll
            for (int o = 16; o >= 1; o >>= 1) ss += __shfl_xor(ss, o);
            const float rs = rsqrtf(ss * (1.0f / 256.0f) + EPS) * 0.8f;
            const f32x4 w0 = *(const f32x4*)(subln_w + e), w1 = *(const f32x4*)(subln_w + e + 4);
            u32x4 w; w.x = pk(dv[0] * rs * w0[0], dv[1] * rs * w0[1]); w.y = pk(dv[2] * rs * w0[2], dv[3] * rs * w0[3]); w.z = pk(dv[4] * rs * w1[0], dv[5] * rs * w1[1]); w.w = pk(dv[6] * rs * w1[2], dv[7] * rs * w1[3]);
            *(u32x4*)(mix + (size_t)r * DM + head * 256 + e) = w; }
#pragma unroll
        for (int i = 0; i < 4; ++i) { const int col = i * 512 + lane * 8, dd = col & 127;
            const bf16_t* pr = proj + (size_t)r * LDP + col; const u32x4 xf = *(const u32x4*)(pr + 8192), xb = *(const u32x4*)(pr + 10240), xg = *(const u32x4*)(pr + 14336);
            float ov[8], gv[8]; float ss = 0.f;
#pragma unroll
            for (int q = 0; q < 4; ++q) { ov[2 * q] = bflo(xf[q]) + bflo(xb[q]); ov[2 * q + 1] = bfhi(xf[q]) + bfhi(xb[q]); gv[2 * q] = bflo(xg[q]); gv[2 * q + 1] = bfhi(xg[q]); ss += ov[2 * q] * ov[2 * q] + ov[2 * q + 1] * ov[2 * q + 1]; }
#pragma unroll
            for (int o = 8; o >= 1; o >>= 1) ss += __shfl_xor(ss, o);
            const float rs = rsqrtf(ss * (1.0f / 128.0f) + EPS);
            const f32x4 w0 = *(const f32x4*)(hnw + dd), w1 = *(const f32x4*)(hnw + dd + 4);
            float y[8];
#pragma unroll
            for (int q = 0; q < 8; ++q) { const float wq = q < 4 ? w0[q & 3] : w1[q & 3]; y[q] = ov[q] * rs * wq * (gv[q] * __builtin_amdgcn_rcpf(1.f + __expf(-gv[q]))); }
            u32x4 w; w.x = pk(y[0], y[1]); w.y = pk(y[2], y[3]); w.z = pk(y[4], y[5]); w.w = pk(y[6], y[7]);
            *(u32x4*)(mix + (size_t)r * DM + 2048 + col) = w; }
    }
}

__device__ __forceinline__ void attn_phase(const bf16_t* proj, bf16_t* OB, int nseq, int L, char* lds, int bid, int nb) {
    const int nqb = L / 256, nunits = nseq * 32 * nqb;
    for (int u = bid; u < nunits; u += nb) {
        const int qb = u % nqb, r = u / nqb, vh = r & 1, c = (r >> 1) & 1, h = (r >> 2) & 7, s = r >> 5;
        const size_t row0 = (size_t)s * L;
        att::attn_dense_body<att::bf16>(proj + (row0 + (size_t)qb * 256) * LDP + h * 256 + c * 128, proj + row0 * LDP + 2048 + h * 256 + c * 128,
                                        proj + row0 * LDP + 4096 + h * 256 + vh * 128, OB + (row0 + (size_t)qb * 256) * DM + h * 512 + c * 256 + vh * 128, L, lds);
        __syncthreads();
    }
}

struct Params { const float* in[13]; float* out; unsigned char* ws; };

__global__ void __launch_bounds__(512, 2) fwd(Params p) {
    extern __shared__ __attribute__((aligned(16))) unsigned char lds[];
    const int tid = threadIdx.x, bid = blockIdx.x, nb = gridDim.x;
    if (tid < 4) ((unsigned*)(lds + LDS_BAR_OFF))[tid] = 0u;
    __syncthreads();
    XcdBarrier bar = xcd_barrier_post((unsigned*)(p.ws + WS_CTL), (volatile LAS unsigned*)(lds + LDS_BAR_OFF));
    const float* attn_norm_w = p.in[2]; const float* w_in = p.in[3]; const float* diff_lambda = p.in[4]; const float* subln_w = p.in[5];
    const float* hgrn_lb = p.in[6]; const float* hgrn_norm_w = p.in[7]; const float* w_out = p.in[8]; const float* mlp_norm_w = p.in[9];
    const float* w_up = p.in[10]; const float* w_down = p.in[11]; const float* final_norm_w = p.in[12];
    bf16_t* WIN = (bf16_t*)(p.ws + WS_WIN); bf16_t* WOUT = (bf16_t*)(p.ws + WS_WOUT); bf16_t* WUP = (bf16_t*)(p.ws + WS_WUP); bf16_t* WDN = (bf16_t*)(p.ws + WS_WDN);
    bf16_t* HB = (bf16_t*)(p.ws + WS_HB); bf16_t* PROJ = (bf16_t*)(p.ws + WS_PROJ); bf16_t* OB = (bf16_t*)(p.ws + WS_OB);
    float* ST = (float*)(p.ws + WS_ST); float* PD = (float*)(p.ws + WS_PD);
    PG8_LAS unsigned char* ldsl = (PG8_LAS unsigned char*)lds;

#if PHM & 1
    transpose_cvt(w_in, WIN, DM, NPROJ, (float*)lds, bid, nb);
    transpose_cvt(w_out, WOUT, DM, DM, (float*)lds, bid, nb);
    transpose_cvt(w_up, WUP, DM, DFF, (float*)lds, bid, nb);
    transpose_cvt(w_down, WDN, DFF, DM, (float*)lds, bid, nb);
#endif

    for (int hf = 0; hf < 2; ++hf) {
        const float* x = hf ? p.in[1] : p.in[0]; const int nseq = hf ? 1 : 8, L = hf ? 16384 : 2048;
        float* outp = p.out + (size_t)hf * MH * DM;
        rmsnorm_rows<true>(x, attn_norm_w, HB, MH, bid, nb);
        xcd_barrier(bar);
#if PHM & 2
        { pg8::Gemm g{HB, WIN, MH, NPROJ, DM}; pg8::StaticOrder S; S.init(MH, NPROJ, nb, bid); EpiB<0> E{PROJ, LDP};
          pg8::gemm_phase<EpiB<0>, pg8::StaticOrder>(ldsl, g, S, E, nullptr); }
#endif
        xcd_barrier(bar);
        rope_phase(PROJ, MH, L, bid, nb);
#if PHM & 4
        hgrn_ends(PROJ, hgrn_lb, ST, PD, nseq, L, lds, bid, nb);
#endif
        xcd_barrier(bar);
        hgrn_scan(ST, PD, nseq, L / HT, bid, nb);
#if PHM & 8
        attn_phase(PROJ, OB, nseq, L, (char*)lds, bid, nb);
#endif
        xcd_barrier(bar);
#if PHM & 16
        hgrn_out(PROJ, hgrn_lb, ST, nseq, L, lds, bid, nb);
#endif
        xcd_barrier(bar);
        combine_phase(OB, PROJ, HB, diff_lambda, subln_w, hgrn_norm_w, MH, bid, nb);
        xcd_barrier(bar);
#if PHM & 32
        { pg8::Gemm g{HB, WOUT, MH, DM, DM}; pg8::StaticOrder S; S.init(MH, DM, nb, bid); EpiRes E{x, outp, DM};
          pg8::gemm_phase<EpiRes, pg8::StaticOrder>(ldsl, g, S, E, nullptr); }
#endif
        xcd_barrier(bar);
        rmsnorm_rows<true>(outp, mlp_norm_w, HB, MH, bid, nb);
        xcd_barrier(bar);
        for (int ch = 0; ch < MH / MC; ++ch) {
#if PHM & 64
            { pg8::Gemm g{HB + (size_t)ch * MC * DM, WUP, MC, DFF, DM}; pg8::StaticOrder S; S.init(MC, DFF, nb, bid); EpiB<1> E{PROJ, DFF};
              pg8::gemm_phase<EpiB<1>, pg8::StaticOrder>(ldsl, g, S, E, nullptr); }
#endif
            xcd_barrier(bar);
#if PHM & 128
            { float* oc = outp + (size_t)ch * MC * DM; pg8::Gemm g{PROJ, WDN, MC, DM, DFF}; pg8::StaticOrder S; S.init(MC, DM, nb, bid); EpiRes E{oc, oc, DM};
              pg8::gemm_phase<EpiRes, pg8::StaticOrder>(ldsl, g, S, E, nullptr); }
#endif
            xcd_barrier(bar);
        }
        rmsnorm_rows<false>(outp, final_norm_w, outp, MH, bid, nb);
    }
}
}

extern "C" void kernel_launch(void* const* d_in, const int* in_sizes, int n_in, void* d_out, int out_size, void* d_ws, size_t ws_size, hipStream_t stream) {
    static int grid = 0;
    if (grid == 0) {
        if (n_in != 13 || ws_size < mk::WS_END) { fprintf(stderr, "kernel_launch: n_in %d ws %zu (need %zu)\n", n_in, ws_size, (size_t)mk::WS_END); grid = -1; return; }
        int dev = 0, cus = 0, per_cu = 0;
        hipGetDevice(&dev); hipDeviceGetAttribute(&cus, hipDeviceAttributeMultiprocessorCount, dev);
        if (hipFuncSetAttribute((const void*)mk::fwd, hipFuncAttributeMaxDynamicSharedMemorySize, mk::LDS_BYTES) != hipSuccess) { fprintf(stderr, "kernel_launch: hipFuncSetAttribute failed\n"); grid = -1; return; }
        if (hipOccupancyMaxActiveBlocksPerMultiprocessor(&per_cu, (const void*)mk::fwd, 512, mk::LDS_BYTES) != hipSuccess || per_cu < 1) { fprintf(stderr, "kernel_launch: occupancy %d\n", per_cu); grid = -1; return; }
        (void)hipGetLastError();
        grid = cus;
    }
    if (grid < 0) return;
    hipMemsetAsync((char*)d_ws + mk::WS_CTL, 0, 65536, stream);
    mk::Params p{};
    for (int i = 0; i < 13; ++i) p.in[i] = (const float*)d_in[i];
    p.out = (float*)d_out; p.ws = (unsigned char*)d_ws;
    hipLaunchKernelGGL(mk::fwd, dim3(grid), dim3(512), mk::LDS_BYTES, stream, p);
}
```

```cpp
#include <hip/hip_runtime.h>
#include <cstdio>
#include <cstdint>
__device__ __forceinline__ int ltid() { int t = threadIdx.x; asm volatile("" : "+v"(t)); return t; }
__device__ __forceinline__ int lsg(int v) { asm volatile("" : "+s"(v)); return v; }
namespace pg8 {
#define PG8_LAS __attribute__((address_space(3)))
typedef unsigned short bf16_t;
typedef short bf16x8 __attribute__((ext_vector_type(8)));
typedef float f32x4 __attribute__((ext_vector_type(4)));
typedef unsigned u32x4 __attribute__((ext_vector_type(4)));
constexpr int BM = 256, BK = 64, HALF = 128, HTB = HALF * BK * 2  , STAGE_BYTES = 8 * HTB, NXCD = 8, WGM = 8;

__host__ __device__ __forceinline__ int lds_byte(int r, int c) { const int st = (r >> 4) * 2 + (c >> 5), rr = r & 15, cc = c & 31, ob = rr * 64 + cc * 2; return st * 1024 + (ob ^ (((ob >> 9) & 1) << 5)); }
__host__ __device__ __forceinline__ void stage_rc(int b, int& R, int& C) { const int st = b / 1024, sb = b % 1024, swz = sb ^ (((sb >> 9) & 1) << 5); R = (st >> 1) * 16 + swz / 64; C = (st & 1) * 32 + (swz % 64) / 2; }
__host__ __device__ __forceinline__ int perm32(int rho) { const int n = rho >> 4, i = rho & 15; return 8 * (i >> 2) + 4 * n + (i & 3); }

struct Unit { int pm, pn; };
struct Gemm { const bf16_t* A; const bf16_t* Bt; int M, N, K; };

struct StaticOrder {
    int nM, nN, nwg, G, c;
    __host__ __device__ void init(int M, int N, int G_, int c_) { nM = M / BM; nN = N / BM; nwg = nM * nN; G = G_; c = c_; }
    __host__ __device__ bool next(int i, Unit& u) const {
        const long L = (long)i * G + c; if (L >= nwg) return false;
        int wgid = (int)L; { const int q = nwg / NXCD, r = nwg % NXCD, xcd = wgid % NXCD, off = wgid / NXCD; wgid = (xcd < r ? xcd * (q + 1) : r * (q + 1) + (xcd - r) * q) + off; }
        const int nig = WGM * nN, gid = wgid / nig, fm = gid * WGM, gsz = (nM - fm) < WGM ? (nM - fm) : WGM;
        u.pm = fm + ((wgid % nig) % gsz); u.pn = (wgid % nig) / gsz; return true;
    }
    __device__ __forceinline__ void a_ready(const Unit&) const {}
    __device__ __forceinline__ void done(const Unit&) const {}
};
struct CountedOrder : StaticOrder {
    const unsigned* ready; unsigned need; unsigned* tmo;
    __device__ __forceinline__ void a_ready(const Unit& u) const {
        if (threadIdx.x < 64) {
            const unsigned long long t0 = __builtin_amdgcn_s_memrealtime(); unsigned polls = 0;
            while ((unsigned)__builtin_amdgcn_readfirstlane(__hip_atomic_load(ready + 64 * u.pm, __ATOMIC_RELAXED, __HIP_MEMORY_SCOPE_AGENT)) < need) {
                if ((++polls & 255u) == 0u && __builtin_amdgcn_readfirstlane(__hip_atomic_load(tmo, __ATOMIC_RELAXED, __HIP_MEMORY_SCOPE_AGENT)) != 0u) break;
                if (__builtin_amdgcn_s_memrealtime() - t0 > 2000000ull) {
                    if (threadIdx.x == 0) { unsigned expect = 0u; __hip_atomic_compare_exchange_strong(tmo + 1, &expect, 0x600u | (unsigned)(u.pm & 0xff), __ATOMIC_RELAXED, __ATOMIC_RELAXED, __HIP_MEMORY_SCOPE_AGENT); __hip_atomic_store(tmo, 1u, __ATOMIC_RELAXED, __HIP_MEMORY_SCOPE_AGENT); }
                    break; }
                __builtin_amdgcn_s_sleep(2); }
            __builtin_amdgcn_fence(__ATOMIC_ACQUIRE, "agent");
            asm volatile("s_waitcnt vmcnt(0)" ::: "memory");
        }
#if !defined(BROKEN_HOOK_NO_BARRIER)
        asm volatile("" ::: "memory"); __builtin_amdgcn_s_barrier(); asm volatile("" ::: "memory");
#endif
    }
};

__device__ __forceinline__ unsigned cvt_pk_bf16(float lo, float hi) { unsigned r; asm volatile("v_cvt_pk_bf16_f32 %0, %1, %2" : "=v"(r) : "v"(lo), "v"(hi)); return r; }
typedef float f32x2 __attribute__((ext_vector_type(2)));
__device__ __forceinline__ f32x2 gelu_pk(f32x2 v) {
    const f32x2 av = __builtin_elementwise_abs(v), d = av * 0.2316418882f + 1.0f;
    f32x2 t; t.x = __builtin_amdgcn_rcpf(d.x); t.y = __builtin_amdgcn_rcpf(d.y);
    f32x2 q = t * 0.5307027145f + (-0.7265760135f); q = q * t + 0.7107068705f; q = q * t + (-0.142248368f); q = q * t + 0.127414796f; q = q * t;
    const f32x2 s = (v * v) * (-0.72134752044f);
    f32x2 e; e.x = __builtin_amdgcn_exp2f(s.x); e.y = __builtin_amdgcn_exp2f(s.y);
    const f32x2 m = v * (q * e), r = v - m;
    f32x2 o; o.x = v.x < 0.f ? m.x : r.x; o.y = v.y < 0.f ? m.y : r.y; return o;
}

struct EpiF32 {
    static constexpr bool PERM = false, AFTER_DRAIN = false;
    float* C; int ldc; const float* bias;
    __device__ __forceinline__ void operator()(const f32x4 (&acc)[2][2][4][2], const Unit& u, int wr, int wc, int fr, int fq) const {
        const int row0 = u.pm * BM + wr * 64 + fr, col0 = u.pn * BM + wc * 32 + 4 * fq;
        f32x4 bv[2][2];
#pragma unroll
        for (int bj = 0; bj < 2; ++bj)
#pragma unroll
            for (int n = 0; n < 2; ++n) bv[bj][n] = bias ? *(const f32x4*)(bias + col0 + bj * HALF + n * 16) : (f32x4){0.f, 0.f, 0.f, 0.f};
#pragma unroll
        for (int ai = 0; ai < 2; ++ai)
#pragma unroll
            for (int m = 0; m < 4; ++m) { float* rowp = C + (size_t)(row0 + ai * HALF + m * 16) * ldc + col0;
#pragma unroll
                for (int bj = 0; bj < 2; ++bj)
#pragma unroll
                    for (int n = 0; n < 2; ++n) *(f32x4*)(rowp + bj * HALF + n * 16) = acc[ai][bj][m][n] + bv[bj][n]; }
    }
};
template <int ACT  > struct EpiBf16 {
    static constexpr bool PERM = true, AFTER_DRAIN = false;
    bf16_t* O; int ldc; const float* bias; int split_cols; size_t split_stride;
    __device__ __forceinline__ void operator()(const f32x4 (&acc)[2][2][4][2], const Unit& u, int wr, int wc, int fr, int fq) const {
        const int row0 = u.pm * BM + wr * 64 + fr; int colt = u.pn * BM; bf16_t* base = O;
        if (split_cols) { const int t = colt / split_cols; base += (size_t)t * split_stride; colt -= t * split_cols; }
        const int col0 = colt + wc * 32 + 8 * fq, bcol0 = u.pn * BM + wc * 32 + 8 * fq;
        f32x4 bv[2][2];
#pragma unroll
        for (int bj = 0; bj < 2; ++bj)
#pragma unroll
            for (int n = 0; n < 2; ++n) bv[bj][n] = bias ? *(const f32x4*)(bias + bcol0 + bj * HALF + 4 * n) : (f32x4){0.f, 0.f, 0.f, 0.f};
#pragma unroll
        for (int ai = 0; ai < 2; ++ai)
#pragma unroll
            for (int m = 0; m < 4; ++m) { bf16_t* rowp = base + (size_t)(row0 + ai * HALF + m * 16) * ldc + col0;
#pragma unroll
                for (int bj = 0; bj < 2; ++bj) { f32x4 v0 = acc[ai][bj][m][0] + bv[bj][0], v1 = acc[ai][bj][m][1] + bv[bj][1];
                    if (ACT == 1) { f32x2 a = gelu_pk((f32x2){v0[0], v0[1]}), b = gelu_pk((f32x2){v0[2], v0[3]}), c = gelu_pk((f32x2){v1[0], v1[1]}), d = gelu_pk((f32x2){v1[2], v1[3]});
                        v0 = (f32x4){a.x, a.y, b.x, b.y}; v1 = (f32x4){c.x, c.y, d.x, d.y}; }
                    if (ACT == 2) {
#pragma unroll
                        for (int j = 0; j < 4; ++j) { v0[j] = 0.5f * v0[j] * (1.0f + erff(v0[j] * 0.70710678f)); v1[j] = 0.5f * v1[j] * (1.0f + erff(v1[j] * 0.70710678f)); } }
                    u32x4 w; w.x = cvt_pk_bf16(v0[0], v0[1]); w.y = cvt_pk_bf16(v0[2], v0[3]); w.z = cvt_pk_bf16(v1[0], v1[1]); w.w = cvt_pk_bf16(v1[2], v1[3]);
                    *(u32x4*)(rowp + bj * HALF) = w; } }
    }
};
template <class Epi, class Sched, bool STAMP = false>
__device__ __forceinline__ void gemm_phase(PG8_LAS unsigned char* lds, const Gemm g, const Sched& S, const Epi& E, unsigned long long* stamps) {
    const int tid = ltid(), wid = __builtin_amdgcn_readfirstlane(tid >> 6), lane = tid & 63, wr = wid >> 2, wc = wid & 3, fr = lane & 15, fq = lane >> 4;
    const int K = g.K, nt = K / BK;
    int ts_lo = 0, ts_hi = 0, nts = 0; const unsigned long long rt_entry = STAMP ? (unsigned long long)wall_clock64() : 0ull;
#define PG8_STAMP() do { if (STAMP && wid == 0 && nts < 64) { const unsigned long long _c = (unsigned long long)clock64(); \
        ts_lo = (lane == nts) ? (int)(unsigned)_c : ts_lo; ts_hi = (lane == nts) ? (int)(unsigned)(_c >> 32) : ts_hi; ++nts; } } while (0)
    PG8_STAMP();
    unsigned voffA[2], voffB[2];
#pragma unroll
    for (int i = 0; i < 2; ++i) { int R, C; stage_rc(tid * 16 + i * 8192, R, C); const int Rb = Epi::PERM ? ((R & ~31) + perm32(R & 31)) : R;
        voffA[i] = (unsigned)(R * K + C) * 2u; voffB[i] = (unsigned)(Rb * K + C) * 2u; }
    const size_t kstep = (size_t)(BK * 2);
    const size_t hstep = (size_t)HALF * K * 2;
    const size_t tstep = 2 * hstep;
    const unsigned ldsw = (unsigned)wid * 1024u;
    const int aoff = lds_byte(wr * 64 + fr, fq * 8), boff = lds_byte(wc * 32 + fr, fq * 8);
#define PG8_SA(b, h) (((b) * 2 + (h)) * HTB)
#define PG8_SB(b, h) ((4 + (b) * 2 + (h)) * HTB)
#define PG8_STAGE(bufoff, gbase, voff) do { _Pragma("unroll") for (int _i = 0; _i < 2; ++_i) \
        __builtin_amdgcn_global_load_lds((const unsigned*)((const char*)(gbase) + (voff)[_i]), (PG8_LAS unsigned*)(lds + (bufoff) + ldsw + _i * 8192), 16, 0, 0); } while (0)
#define PG8_LDA(dst, b, h) do { _Pragma("unroll") for (int m = 0; m < 4; ++m) _Pragma("unroll") for (int k = 0; k < 2; ++k) dst[m][k] = *(const PG8_LAS bf16x8*)(lds + PG8_SA(b, h) + aoff + m * 2048 + k * 1024); } while (0)
#define PG8_LDB(dst, b, h) do { _Pragma("unroll") for (int n = 0; n < 2; ++n) _Pragma("unroll") for (int k = 0; k < 2; ++k) dst[n][k] = *(const PG8_LAS bf16x8*)(lds + PG8_SB(b, h) + boff + n * 2048 + k * 1024); } while (0)
#define PG8_MMA(ai, bj, At, Bt) do { __builtin_amdgcn_s_setprio(1); _Pragma("unroll") for (int m = 0; m < 4; ++m) _Pragma("unroll") for (int n = 0; n < 2; ++n) _Pragma("unroll") for (int k = 0; k < 2; ++k) \
        acc[ai][bj][m][n] = __builtin_amdgcn_mfma_f32_16x16x32_bf16(Bt[n][k], At[m][k], acc[ai][bj][m][n], 0, 0, 0); __builtin_amdgcn_s_setprio(0); } while (0)
#define PG8_WAIT_V(n) asm volatile("s_waitcnt vmcnt(" #n ")" ::: "memory")
#define PG8_WAIT_L(n) asm volatile("s_waitcnt lgkmcnt(" #n ")" ::: "memory")
#define PG8_BAR __builtin_amdgcn_s_barrier()
#define PG8_SCHED __builtin_amdgcn_sched_barrier(0)
    Unit cur, nxt; int ui = 0;
    if (!S.next(0, cur)) return;
    f32x4 acc[2][2][4][2];
#pragma unroll
    for (int a = 0; a < 2; ++a)
#pragma unroll
        for (int b = 0; b < 2; ++b)
#pragma unroll
            for (int m = 0; m < 4; ++m)
#pragma unroll
                for (int n = 0; n < 2; ++n) acc[a][b][m][n] = (f32x4){0.f, 0.f, 0.f, 0.f};
    bf16x8 At[4][2], B0[2][2], B1[2][2];
    const char* cA = (const char*)g.A + (size_t)cur.pm * tstep; const char* cB = (const char*)g.Bt + (size_t)cur.pn * tstep;
    S.a_ready(cur);
    PG8_STAGE(PG8_SB(0, 0), cB, voffB); PG8_STAGE(PG8_SA(0, 0), cA, voffA); PG8_STAGE(PG8_SB(0, 1), cB + hstep, voffB); PG8_STAGE(PG8_SA(0, 1), cA + hstep, voffA);
    if (wr == 1) PG8_BAR;
    PG8_WAIT_V(4); PG8_BAR;
    PG8_STAGE(PG8_SB(1, 0), cB + kstep, voffB); PG8_STAGE(PG8_SA(1, 0), cA + kstep, voffA); PG8_STAGE(PG8_SB(1, 1), cB + hstep + kstep, voffB);
    PG8_WAIT_V(6); PG8_BAR;
    PG8_STAMP();
    for (;;) {
        const bool has_next = S.next(ui + 1, nxt);
        const char* nA = has_next ? (const char*)g.A + (size_t)nxt.pm * tstep : cA; const char* nB = has_next ? (const char*)g.Bt + (size_t)nxt.pn * tstep : cB;
        for (int t = 0; t < nt; t += 2) {
            const bool last = (t == nt - 2);
            const char* a1 = cA + (size_t)(t + 1) * kstep;
            const char* a2 = last ? nA : cA + (size_t)(t + 2) * kstep; const char* b2 = last ? nB : cB + (size_t)(t + 2) * kstep;
            const char* a3 = a2 + kstep; const char* b3 = b2 + kstep;
            if (last && has_next) S.a_ready(nxt);
            PG8_LDB(B0, 0, 0); PG8_SCHED; PG8_LDA(At, 0, 0); PG8_STAGE(PG8_SA(1, 1), a1 + hstep, voffA);
            PG8_WAIT_L(8); PG8_BAR; PG8_WAIT_L(0); PG8_MMA(0, 0, At, B0); PG8_BAR; PG8_SCHED;
            PG8_LDB(B1, 0, 1); PG8_STAGE(PG8_SB(0, 0), b2, voffB);
            PG8_BAR; PG8_WAIT_L(0); PG8_MMA(0, 1, At, B1); PG8_BAR;
            PG8_LDA(At, 0, 1); PG8_STAGE(PG8_SA(0, 0), a2, voffA);
            PG8_BAR; PG8_WAIT_L(0); PG8_MMA(1, 0, At, B0); PG8_BAR; PG8_SCHED;
            PG8_STAGE(PG8_SB(0, 1), b2 + hstep, voffB);
            PG8_WAIT_V(6); PG8_BAR; PG8_MMA(1, 1, At, B1); PG8_BAR;
            PG8_LDB(B0, 1, 0); PG8_SCHED; PG8_LDA(At, 1, 0); PG8_STAGE(PG8_SA(0, 1), a2 + hstep, voffA);
            PG8_WAIT_L(8); PG8_BAR; PG8_WAIT_L(0); PG8_MMA(0, 0, At, B0); PG8_BAR; PG8_SCHED;
            PG8_LDB(B1, 1, 1); PG8_STAGE(PG8_SB(1, 0), b3, voffB);
            PG8_BAR; PG8_WAIT_L(0); PG8_MMA(0, 1, At, B1); PG8_BAR;
            PG8_LDA(At, 1, 1); PG8_STAGE(PG8_SA(1, 0), a3, voffA);
            PG8_BAR; PG8_WAIT_L(0); PG8_MMA(1, 0, At, B0); PG8_BAR; PG8_SCHED;
            PG8_STAGE(PG8_SB(1, 1), b3 + hstep, voffB);
            PG8_WAIT_V(6); PG8_BAR; PG8_MMA(1, 1, At, B1); PG8_BAR;
        }
        PG8_STAMP();
        if constexpr (!Epi::AFTER_DRAIN) { E(acc, cur, wr, wc, fr, fq); S.done(cur); }
        PG8_STAMP();
        if (!has_next) break;
#pragma unroll
        for (int a = 0; a < 2; ++a)
#pragma unroll
            for (int b = 0; b < 2; ++b)
#pragma unroll
                for (int m = 0; m < 4; ++m)
#pragma unroll
                    for (int n = 0; n < 2; ++n) acc[a][b][m][n] = (f32x4){0.f, 0.f, 0.f, 0.f};
        cur = nxt; cA = nA; cB = nB; ++ui;
    }
    PG8_WAIT_V(0);
    if (wr == 0) PG8_BAR;
    PG8_BAR;
    if constexpr (Epi::AFTER_DRAIN) { E.fused(acc, cur, wr, wc, fr, fq, lds, wid, lane); S.done(cur); }
    PG8_STAMP();
    if (STAMP && wid == 0) { stamps[lane] = lane < nts ? (((unsigned long long)(unsigned)ts_hi << 32) | (unsigned)ts_lo) : 0ull;
        if (lane == 62) stamps[62] = rt_entry; if (lane == 63) stamps[63] = (unsigned long long)wall_clock64(); }
#undef PG8_STAMP
#undef PG8_SA
#undef PG8_SB
#undef PG8_STAGE
#undef PG8_LDA
#undef PG8_LDB
#undef PG8_MMA
#undef PG8_WAIT_V
#undef PG8_WAIT_L
#undef PG8_BAR
#undef PG8_SCHED
}
}
#define XB_TMO      128
#define XB_XCNT(j)  (256  + 64 * (j))
#define XB_XSUB(j)  (1280 + 64 * (j))
#define XB_XGEN(j)  (2304 + 64 * (j))
#define XB_TOP      3328
#define XB_TOPGEN   3392
#define XCD_BAR_WORDS 3456
#define XB_SPIN_CAP (1u << 22)
#define LAS __attribute__((address_space(3)))

__device__ __forceinline__ unsigned xb_ld(unsigned* p)              { return __hip_atomic_load(p, __ATOMIC_RELAXED, __HIP_MEMORY_SCOPE_AGENT); }
__device__ __forceinline__ unsigned xb_add(unsigned* p, unsigned v) { return __hip_atomic_fetch_add(p, v, __ATOMIC_RELAXED, __HIP_MEMORY_SCOPE_AGENT); }
__device__ __forceinline__ unsigned xb_xcc_id() { return (unsigned)__builtin_amdgcn_s_getreg((3 << 11) | 20) & 0xFu; }
#define XB_SPIN(cond, bar) do { unsigned _sp = 0; while (cond) { __builtin_amdgcn_s_sleep(1); \
    if ((++_sp & 255u) == 0u) { if (xb_ld(&(bar)[XB_TMO])) break; if (_sp > XB_SPIN_CAP) { atomicAdd(&(bar)[XB_TMO], 1u); break; } } } } while (0)

struct XcdBarrier {
    unsigned* bar; unsigned x;
    volatile LAS unsigned* st;
};

__device__ __forceinline__ XcdBarrier xcd_barrier_post(unsigned* bar, volatile LAS unsigned* st) {
    XcdBarrier b; b.bar = bar; b.x = xb_xcc_id(); b.st = st;
    if (threadIdx.x == 0) (void)xb_add(&bar[XB_XCNT(b.x)], 1u);
    return b;
}
__device__ __forceinline__ void xcd_barrier_complete(unsigned* bar, unsigned x, unsigned& nloc, unsigned& nx) {
    const unsigned G = gridDim.x * gridDim.y * gridDim.z;
    unsigned sum, cnt, mine, sp = 0u;
    for (;;) {
        sum = 0u; cnt = 0u; mine = 0u;
#pragma unroll
        for (unsigned j = 0; j < 16; ++j) { const unsigned c = xb_ld(&bar[XB_XCNT(j)]); sum += c; cnt += (c > 0u) ? 1u : 0u; mine = (j == x) ? c : mine; }
        if (sum == G) break;
        __builtin_amdgcn_s_sleep(1);
        if ((++sp & 255u) == 0u) { if (xb_ld(&bar[XB_TMO])) break; if (sp > XB_SPIN_CAP) { atomicAdd(&bar[XB_TMO], 1u); break; } }
    }
    nloc = mine > 0u ? mine : 1u; nx = cnt > 0u ? cnt : 1u;
}

__device__ __forceinline__ void xcd_barrier(const XcdBarrier& b) {
    asm volatile("s_waitcnt vmcnt(0)" ::: "memory");
    __syncthreads();
    if (threadIdx.x == 0) {
        unsigned* bar = b.bar;
        __builtin_amdgcn_s_waitcnt(0);
        unsigned nloc = b.st[0], nx = b.st[1];
        if (nloc == 0u) { xcd_barrier_complete(bar, b.x, nloc, nx); b.st[0] = nloc; b.st[1] = nx; }
        const unsigned old = xb_add(&bar[XB_XSUB(b.x)], 1u);
        const unsigned gen = old / nloc;
        if (old + 1u == (gen + 1u) * nloc) {
            __builtin_amdgcn_fence(__ATOMIC_RELEASE, "agent");
            asm volatile("s_waitcnt vmcnt(0)" ::: "memory");
            const unsigned og = xb_add(&bar[XB_TOP], 1u);
            const unsigned tg = og / nx;
            if (og + 1u == (tg + 1u) * nx) xb_add(&bar[XB_TOPGEN], 1u);
            else XB_SPIN(xb_ld(&bar[XB_TOPGEN]) == tg, bar);
            __builtin_amdgcn_fence(__ATOMIC_ACQUIRE, "agent");
            xb_add(&bar[XB_XGEN(b.x)], 1u);
            asm volatile("s_waitcnt vmcnt(0)" ::: "memory");
        } else {
            XB_SPIN(xb_ld(&bar[XB_XGEN(b.x)]) == gen, bar);
            __builtin_amdgcn_fence(__ATOMIC_ACQUIRE, "agent");
            asm volatile("s_waitcnt vmcnt(0)" ::: "memory");
        }
    }
    __syncthreads();
}
namespace att {
using bf16 = unsigned short;
constexpr int   D = 128, NW = 8, QBLK = 32, KVBLK = 64;
constexpr float SCALE = 0.088388347648318440f;
constexpr float THR = 8.f;
constexpr int SDEPTH = 2;
constexpr int LDQ = 16512, LDK = 16512, LDO = 4096;
constexpr size_t SHM_V = KVBLK * D * 2, SHM_K = KVBLK * D * 2, SHM_ATTN = 2 * SHM_V + 2 * SHM_K + NW * 64 * 4;
using bf16x8 = __attribute__((ext_vector_type(8))) short;
using s16x4  = __attribute__((ext_vector_type(4))) short;
using f32x16 = __attribute__((ext_vector_type(16))) float;
using f32x8  = __attribute__((ext_vector_type(8))) float;
using u32x4  = __attribute__((ext_vector_type(4))) unsigned;
#define KSWZ(row, colB) ((row) * 256 + ((colB) ^ (((row) & 7) << 4)))
#define SBAR() __builtin_amdgcn_sched_barrier(0)
__device__ __forceinline__ int crow(int r, int hi) { return (r & 3) + 8 * (r >> 2) + 4 * hi; }
__device__ __forceinline__ unsigned cvtpk(float lo, float hi) {
  unsigned r; asm volatile("v_cvt_pk_bf16_f32 %0, %1, %2" : "=v"(r) : "v"(lo), "v"(hi)); return r;
}
template <typename TIn> struct Stage;
template <> struct Stage<bf16>  { using T = bf16x8;
  __device__ static __forceinline__ T ld8(const bf16* p) { return *reinterpret_cast<const bf16x8*>(p); }
  __device__ static __forceinline__ bf16x8 tobf(T x) { return x; } };
template <> struct Stage<float> { using T = f32x8;
  __device__ static __forceinline__ T ld8(const float* p) { return *reinterpret_cast<const f32x8*>(p); }
  __device__ static __forceinline__ bf16x8 tobf(T x) {
    u32x4 w = {cvtpk(x[0], x[1]), cvtpk(x[2], x[3]), cvtpk(x[4], x[5]), cvtpk(x[6], x[7])}; return *reinterpret_cast<bf16x8*>(&w); } };

__device__ __forceinline__ void partialSM(f32x16& p0, f32x16& p1, float& m_reg, float& mn, float& alpha) {
  constexpr float C = SCALE * 1.4426950408889634f;
  float pmax = p0[0]; for (int r = 1; r < 16; ++r) pmax = fmaxf(pmax, p0[r]); for (int r = 0; r < 16; ++r) pmax = fmaxf(pmax, p1[r]);
  { auto rr = __builtin_amdgcn_permlane32_swap(__float_as_uint(pmax), __float_as_uint(pmax), false, false);
    pmax = fmaxf(__uint_as_float(rr[0]), __uint_as_float(rr[1])); }
  if (__builtin_expect(__all(pmax - m_reg <= THR / SCALE), 1)) { mn = m_reg; alpha = 1.f; }
  else { mn = fmaxf(m_reg, pmax); alpha = __builtin_amdgcn_exp2f((m_reg - mn) * C); m_reg = mn; }
  float mnC = -mn * C;
  for (int r = 0; r < 16; ++r) p0[r] = fmaf(p0[r], C, mnC); for (int r = 0; r < 16; ++r) p1[r] = fmaf(p1[r], C, mnC);
  for (int r = 0; r < 16; ++r) p0[r] = __builtin_amdgcn_exp2f(p0[r]);
}
__device__ __forceinline__ void finishSM(f32x16& p0, f32x16& p1, float alpha, float& l_reg, bf16x8& pa0, bf16x8& pa1, bf16x8& pa2, bf16x8& pa3) {
  for (int r = 0; r < 16; ++r) p1[r] = __builtin_amdgcn_exp2f(p1[r]);
  float ps = 0; for (int r = 0; r < 16; ++r) ps += p0[r]; for (int r = 0; r < 16; ++r) ps += p1[r];
  { auto rr = __builtin_amdgcn_permlane32_swap(__float_as_uint(ps), __float_as_uint(ps), false, false);
    ps = __uint_as_float(rr[0]) + __uint_as_float(rr[1]); }
  l_reg = l_reg * alpha + ps;
#define PK4(P, BASE, OUT) do { unsigned a0 = cvtpk(P[BASE + 0], P[BASE + 1]), a1 = cvtpk(P[BASE + 2], P[BASE + 3]);   \
    unsigned b0 = cvtpk(P[BASE + 4], P[BASE + 5]), b1 = cvtpk(P[BASE + 6], P[BASE + 7]);                              \
    auto r0 = __builtin_amdgcn_permlane32_swap(a0, b0, false, false); auto r1 = __builtin_amdgcn_permlane32_swap(a1, b1, false, false); \
    u32x4 w = {r0[0], r1[0], r0[1], r1[1]}; OUT = *reinterpret_cast<bf16x8*>(&w); } while (0)
  PK4(p0, 0, pa0); PK4(p0, 8, pa1); PK4(p1, 0, pa2); PK4(p1, 8, pa3);
#undef PK4
}
__device__ __forceinline__ void qkt(f32x16& p0, f32x16& p1, const bf16* Ks, const bf16x8* qr, int r32, int hi) {
  p0 = f32x16{}; p1 = f32x16{};
  for (int d0 = 0; d0 < 8; ++d0) { int cb = (d0 * 16 + hi * 8) * 2;
    bf16x8 b0 = *reinterpret_cast<const bf16x8*>((const char*)Ks + KSWZ(r32, cb));
    bf16x8 b1 = *reinterpret_cast<const bf16x8*>((const char*)Ks + KSWZ(32 + r32, cb));
    p0 = __builtin_amdgcn_mfma_f32_32x32x16_bf16(b0, qr[d0], p0, 0, 0, 0);
    p1 = __builtin_amdgcn_mfma_f32_32x32x16_bf16(b1, qr[d0], p1, 0, 0, 0); }
}
__device__ __forceinline__ int v_st(int k, int c) { const int kk = (k & ~0xC) | ((k & 4) << 1) | ((k & 8) >> 1); return ((kk >> 3) * 4 + (c >> 5)) * 512 + ((kk & 7) * 32 + (c & 31)) * 2; }
__device__ __forceinline__ int v_rd_base(int lane) { return ((lane & 3) << 3) | (((lane >> 2) & 3) << 6) | (((lane >> 4) & 1) << 5) | (((lane >> 5) & 1) << 8); }
constexpr int v_rd_off(int d0, int ks, int half) { return d0 * 512 + ks * 4096 + half * 2048; }
template <int OFF> __device__ __forceinline__ s16x4 tr_read(int vb) {
  s16x4 r; asm volatile("ds_read_b64_tr_b16 %0, %1 offset:%2" : "=&v"(r) : "v"(vb), "i"(OFF) : "memory"); return r;
}
template <int D0> __device__ __forceinline__ void pv_one(f32x16& od, int vb, bf16x8 pa0, bf16x8 pa1, bf16x8 pa2, bf16x8 pa3) {
  const s16x4 l0 = tr_read<v_rd_off(D0, 0, 0)>(vb), h0 = tr_read<v_rd_off(D0, 0, 1)>(vb), l1 = tr_read<v_rd_off(D0, 1, 0)>(vb), h1 = tr_read<v_rd_off(D0, 1, 1)>(vb);
  const s16x4 l2 = tr_read<v_rd_off(D0, 2, 0)>(vb), h2 = tr_read<v_rd_off(D0, 2, 1)>(vb), l3 = tr_read<v_rd_off(D0, 3, 0)>(vb), h3 = tr_read<v_rd_off(D0, 3, 1)>(vb);
  asm volatile("s_waitcnt lgkmcnt(0)" ::: "memory"); SBAR();
#define PK(L, H) (bf16x8){L[0], L[1], L[2], L[3], H[0], H[1], H[2], H[3]}
  od = __builtin_amdgcn_mfma_f32_32x32x16_bf16(pa0, PK(l0, h0), od, 0, 0, 0);
  od = __builtin_amdgcn_mfma_f32_32x32x16_bf16(pa1, PK(l1, h1), od, 0, 0, 0);
  od = __builtin_amdgcn_mfma_f32_32x32x16_bf16(pa2, PK(l2, h2), od, 0, 0, 0);
  od = __builtin_amdgcn_mfma_f32_32x32x16_bf16(pa3, PK(l3, h3), od, 0, 0, 0);
#undef PK
}
__device__ __forceinline__ void pv_d0(f32x16* o, int vb, bf16x8 pa0, bf16x8 pa1, bf16x8 pa2, bf16x8 pa3) {
  pv_one<0>(o[0], vb, pa0, pa1, pa2, pa3); pv_one<1>(o[1], vb, pa0, pa1, pa2, pa3); pv_one<2>(o[2], vb, pa0, pa1, pa2, pa3); pv_one<3>(o[3], vb, pa0, pa1, pa2, pa3);
}

template <typename TQ>
__device__ __forceinline__ void attn_dense_body(const TQ* __restrict__ Qb, const bf16* __restrict__ Kh, const bf16* __restrict__ Vh,
                                                bf16* __restrict__ Ob, int seq, char* lds) {
  using St = Stage<bf16>; using SQ = Stage<TQ>;
  const int tid = ltid(), wid = tid >> 6, lane = tid & 63, r32 = lane & 31, hi = lane >> 5;
  bf16* V_lds = (bf16*)lds; bf16* K_lds = (bf16*)(lds + 2 * SHM_V);
  float* ws = (float*)(lds + 2 * SHM_V + 2 * SHM_K) + wid * 64; float* li_l = ws; float* al_l = ws + 32;
  float m_reg = -1e30f, l_reg = 0; f32x16 o[4] = {}; bf16x8 qr[8];
  const TQ* Qw = Qb + (long)(wid * QBLK + r32) * LDQ + hi * 8;
#pragma unroll
  for (int d0 = 0; d0 < 8; ++d0) qr[d0] = SQ::tobf(SQ::ld8(Qw + d0 * 16));
  const int sr = tid >> 4, sc = (tid & 15) * 8, vst0 = v_st(sr, sc), vst1 = v_st(32 + sr, sc);
  const int vb0 = (int)(uintptr_t)V_lds + v_rd_base(lane);
  struct { typename St::T vs0, vs1, ks0, ks1; } sr_[SDEPTH];
#define SLOAD(i, k0) do { sr_[i].vs0 = St::ld8(&Vh[(long)((k0) + sr) * LDK + sc]); sr_[i].vs1 = St::ld8(&Vh[(long)((k0) + 32 + sr) * LDK + sc]); \
    sr_[i].ks0 = St::ld8(&Kh[(long)((k0) + sr) * LDK + sc]); sr_[i].ks1 = St::ld8(&Kh[(long)((k0) + 32 + sr) * LDK + sc]); } while (0)
#define SWRITE(b, i) do { *(bf16x8*)((char*)V_lds + (b) * SHM_V + vst0) = St::tobf(sr_[i].vs0);          \
    *(bf16x8*)((char*)V_lds + (b) * SHM_V + vst1) = St::tobf(sr_[i].vs1); int kc = sc * 2;               \
    *(bf16x8*)((char*)K_lds + (b) * SHM_K + KSWZ(sr, kc)) = St::tobf(sr_[i].ks0);                       \
    *(bf16x8*)((char*)K_lds + (b) * SHM_K + KSWZ(32 + sr, kc)) = St::tobf(sr_[i].ks1); } while (0)
#define SWAIT() do { if constexpr (SDEPTH == 2) asm volatile("s_waitcnt vmcnt(4)" ::: "memory"); else asm volatile("s_waitcnt vmcnt(0)" ::: "memory"); } while (0)
#define RESC(a) do { if (__any((a) < 1.f)) { if (hi == 0) al_l[r32] = (a); asm volatile("s_waitcnt lgkmcnt(0)" ::: "memory"); \
    for (int d = 0; d < 4; ++d) for (int r = 0; r < 16; ++r) o[d][r] *= al_l[crow(r, hi)]; } } while (0)
  f32x16 pA0, pA1, pB0, pB1; float mnA, mnB, alA, alB; bf16x8 pa0, pa1, pa2, pa3; const int NT = seq / KVBLK;
  constexpr int SE = 0, SO = SDEPTH - 1;
  SLOAD(SE, 0); asm volatile("s_waitcnt vmcnt(0)" ::: "memory"); SWRITE(0, SE); __syncthreads();
  qkt(pA0, pA1, K_lds, qr, r32, hi); partialSM(pA0, pA1, m_reg, mnA, alA);
  SLOAD(SO, KVBLK); if constexpr (SDEPTH == 2) { if (2 < NT) SLOAD(SE, 2 * KVBLK); }
  SWAIT(); SWRITE(1, SO); __syncthreads();
  for (int j = 1; j + 1 < NT; j += 2) {
    SBAR(); qkt(pB0, pB1, (bf16*)((char*)K_lds + SHM_K), qr, r32, hi);
    finishSM(pA0, pA1, alA, l_reg, pa0, pa1, pa2, pa3); SBAR();
    SLOAD(SO, (j + SDEPTH) * KVBLK); SBAR();
    pv_d0(o, vb0, pa0, pa1, pa2, pa3); partialSM(pB0, pB1, m_reg, mnB, alB);
    __syncthreads(); SWAIT(); SWRITE(0, SE);
    RESC(alB); __syncthreads();
    SBAR(); qkt(pA0, pA1, K_lds, qr, r32, hi);
    finishSM(pB0, pB1, alB, l_reg, pa0, pa1, pa2, pa3); SBAR();
    if (SDEPTH == 1 || j + 3 < NT) SLOAD(SE, (j + 1 + SDEPTH) * KVBLK); SBAR();
    pv_d0(o, vb0 + (int)SHM_V, pa0, pa1, pa2, pa3); partialSM(pA0, pA1, m_reg, mnA, alA);
    __syncthreads(); SWAIT(); SWRITE(1, SO);
    RESC(alA); __syncthreads();
  }
  SBAR(); qkt(pB0, pB1, (bf16*)((char*)K_lds + SHM_K), qr, r32, hi);
  finishSM(pA0, pA1, alA, l_reg, pa0, pa1, pa2, pa3); SBAR();
  pv_d0(o, vb0, pa0, pa1, pa2, pa3); partialSM(pB0, pB1, m_reg, mnB, alB);
  __syncthreads(); RESC(alB);
  finishSM(pB0, pB1, alB, l_reg, pa0, pa1, pa2, pa3); SBAR();
  pv_d0(o, vb0 + (int)SHM_V, pa0, pa1, pa2, pa3);
  if (hi == 0) li_l[r32] = l_reg; asm volatile("s_waitcnt lgkmcnt(0)" ::: "memory");
  float rli[16];
#pragma unroll
  for (int r = 0; r < 16; ++r) rli[r] = __builtin_amdgcn_rcpf(li_l[crow(r, hi)]);
  bf16* Ow = Ob + (long)(wid * QBLK) * LDO;
#pragma unroll
  for (int r = 0; r < 16; ++r) { int orow = crow(r, hi);
    for (int d0 = 0; d0 < 4; ++d0) { const float ov = o[d0][r] * rli[r]; unsigned uu = __float_as_uint(ov); uu += 0x7FFFu + ((uu >> 16) & 1u); Ow[(long)orow * LDO + d0 * 32 + r32] = (bf16)(uu >> 16); } }
#undef SLOAD
#undef SWRITE
#undef SWAIT
#undef RESC
}
}

#ifndef PHM
#define PHM 255
#endif
namespace mk {
__device__ const double INVD[64] = {1,0.86596432336006535,0.74989420933245587,0.64938163157621132,0.56234132519034907,0.48696752516586311,0.42169650342858223,0.36517412725483772,0.31622776601683794,0.27384196342643613,0.23713737056616552,0.20535250264571461,0.17782794100389229,0.15399265260594919,0.1333521432163324,0.11547819846894582,0.10000000000000001,0.086596432336006529,0.074989420933245579,0.064938163157621132,0.056234132519034911,0.048696752516586311,0.042169650342858224,0.036517412725483769,0.031622776601683791,0.027384196342643614,0.023713737056616554,0.02053525026457146,0.017782794100389229,0.015399265260594919,0.013335214321633241,0.011547819846894581,0.01,0.0086596432336006543,0.0074989420933245579,0.006493816315762113,0.005623413251903491,0.004869675251658631,0.0042169650342858229,0.0036517412725483771,0.0031622776601683794,0.0027384196342643613,0.0023713737056616554,0.002053525026457146,0.0017782794100389228,0.001539926526059492,0.0013335214321633241,0.0011547819846894581,0.001,0.00086596432336006539,0.00074989420933245586,0.00064938163157621134,0.0005623413251903491,0.0004869675251658631,0.00042169650342858224,0.0003651741272548377,0.00031622776601683794,0.00027384196342643611,0.00023713737056616554,0.00020535250264571461,0.00017782794100389227,0.00015399265260594919,0.0001333521432163324,0.00011547819846894582};
typedef unsigned short bf16_t;
typedef float f32x4 __attribute__((ext_vector_type(4)));
typedef unsigned u32x4 __attribute__((ext_vector_type(4)));
typedef unsigned u32x2 __attribute__((ext_vector_type(2)));
typedef float f32x2 __attribute__((ext_vector_type(2)));
constexpr int DM = 4096, NPROJ = 16384, LDP = 16512  , DFF = 16384, MH = 16384, MC = 16384;
constexpr size_t MiB = 1ull << 20;
constexpr size_t WS_CTL = 0, WS_WIN = 1 * MiB, WS_WOUT = WS_WIN + 128 * MiB, WS_WUP = WS_WOUT + 32 * MiB, WS_WDN = WS_WUP + 128 * MiB,
                 WS_HB = WS_WDN + 128 * MiB, WS_PROJ = WS_HB + 128 * MiB, WS_OB = WS_PROJ + 520 * MiB, WS_ST = WS_OB + 128 * MiB,
                 WS_PD = WS_ST + 128 * MiB, WS_END = WS_PD + 1 * MiB;
constexpr int LDS_BAR_OFF = 135168, LDS_BYTES = 135168 + 64;
constexpr float EPS = 1e-6f;

__device__ __forceinline__ float bf2f(unsigned b) { return __uint_as_float(b << 16); }
__device__ __forceinline__ float bflo(unsigned w) { return __uint_as_float(w << 16); }
__device__ __forceinline__ float bfhi(unsigned w) { return __uint_as_float(w & 0xffff0000u); }
__device__ __forceinline__ unsigned short f2bf(float f) { unsigned u = __float_as_uint(f); u += 0x7FFFu + ((u >> 16) & 1u); return (unsigned short)(u >> 16); }
__device__ __forceinline__ unsigned pk(float lo, float hi) { return pg8::cvt_pk_bf16(lo, hi); }

template <int ACT> struct EpiB {
    static constexpr bool PERM = true, AFTER_DRAIN = false;
    bf16_t* O; int ldc;
    __device__ __forceinline__ void operator()(const pg8::f32x4 (&acc)[2][2][4][2], const pg8::Unit& u, int wr, int wc, int fr, int fq) const {
        const int row0 = u.pm * 256 + wr * 64 + fr, col0 = u.pn * 256 + wc * 32 + 8 * fq;
#pragma unroll
        for (int ai = 0; ai < 2; ++ai)
#pragma unroll
            for (int m = 0; m < 4; ++m) { bf16_t* rowp = O + (size_t)(row0 + ai * 128 + m * 16) * ldc + col0;
#pragma unroll
                for (int bj = 0; bj < 2; ++bj) { pg8::f32x4 v0 = acc[ai][bj][m][0], v1 = acc[ai][bj][m][1];
                    if (ACT == 1) {
#pragma unroll
                        for (int j = 0; j < 4; ++j) { const float a = fmaxf(v0[j], 0.f), b = fmaxf(v1[j], 0.f); v0[j] = a * a; v1[j] = b * b; } }
                    pg8::u32x4 w; w.x = pk(v0[0], v0[1]); w.y = pk(v0[2], v0[3]); w.z = pk(v1[0], v1[1]); w.w = pk(v1[2], v1[3]);
                    *(pg8::u32x4*)(rowp + bj * 128) = w; } }
    }
};
struct EpiRes {
    static constexpr bool PERM = false, AFTER_DRAIN = false;
    const float* base; float* C; int ldc;
    __device__ __forceinline__ void operator()(const pg8::f32x4 (&acc)[2][2][4][2], const pg8::Unit& u, int wr, int wc, int fr, int fq) const {
        const int row0 = u.pm * 256 + wr * 64 + fr, col0 = u.pn * 256 + wc * 32 + 4 * fq;
#pragma unroll
        for (int ai = 0; ai < 2; ++ai)
#pragma unroll
            for (int m = 0; m < 4; ++m) { const size_t off = (size_t)(row0 + ai * 128 + m * 16) * ldc + col0;
#pragma unroll
                for (int bj = 0; bj < 2; ++bj)
#pragma unroll
                    for (int n = 0; n < 2; ++n) { const pg8::f32x4 b = *(const pg8::f32x4*)(base + off + bj * 128 + n * 16);
                        *(pg8::f32x4*)(C + off + bj * 128 + n * 16) = acc[ai][bj][m][n] + b; } }
    }
};


struct EpiResNorm {
    static constexpr bool PERM = false, AFTER_DRAIN = false;
    const float* base; float* C; int ldc; bf16_t* H2; const float* wn; float* ssq;
    __device__ __forceinline__ void operator()(const pg8::f32x4 (&acc)[2][2][4][2], const pg8::Unit& u, int wr, int wc, int fr, int fq) const {
        const int row0 = u.pm * 256 + wr * 64 + fr, col0 = u.pn * 256 + wc * 32 + 4 * fq;
        pg8::f32x4 wv[2][2];
#pragma unroll
        for (int bj = 0; bj < 2; ++bj)
#pragma unroll
            for (int n = 0; n < 2; ++n) wv[bj][n] = *(const pg8::f32x4*)(wn + col0 + bj * 128 + n * 16);
#pragma unroll
        for (int ai = 0; ai < 2; ++ai)
#pragma unroll
            for (int m = 0; m < 4; ++m) { const int row = row0 + ai * 128 + m * 16; const size_t off = (size_t)row * ldc + col0; float ss = 0.f;
#pragma unroll
                for (int bj = 0; bj < 2; ++bj)
#pragma unroll
                    for (int n = 0; n < 2; ++n) { const pg8::f32x4 b = *(const pg8::f32x4*)(base + off + bj * 128 + n * 16); const pg8::f32x4 v = acc[ai][bj][m][n] + b;
                        *(pg8::f32x4*)(C + off + bj * 128 + n * 16) = v; ss += v[0] * v[0] + v[1] * v[1] + v[2] * v[2] + v[3] * v[3];
                        const pg8::f32x4 y = v * wv[bj][n]; u32x2 o2; o2.x = pk(y[0], y[1]); o2.y = pk(y[2], y[3]); *(u32x2*)(H2 + off + bj * 128 + n * 16) = o2; }
                ss += __shfl_xor(ss, 16); ss += __shfl_xor(ss, 32);
                if (fq == 0) atomicAdd(ssq + row, ss); }
    }
};
struct EpiResScale {
    static constexpr bool PERM = false, AFTER_DRAIN = false;
    float* C; int ldc; const float* ssq;
    __device__ __forceinline__ void operator()(const pg8::f32x4 (&acc)[2][2][4][2], const pg8::Unit& u, int wr, int wc, int fr, int fq) const {
        const int row0 = u.pm * 256 + wr * 64 + fr, col0 = u.pn * 256 + wc * 32 + 4 * fq;
#pragma unroll
        for (int ai = 0; ai < 2; ++ai)
#pragma unroll
            for (int m = 0; m < 4; ++m) { const int row = row0 + ai * 128 + m * 16; const size_t off = (size_t)row * ldc + col0;
                const float sc = 1.0f / (__hip_atomic_load(ssq + row, __ATOMIC_RELAXED, __HIP_MEMORY_SCOPE_AGENT) * (1.0f / DM) + EPS);
#pragma unroll
                for (int bj = 0; bj < 2; ++bj)
#pragma unroll
                    for (int n = 0; n < 2; ++n) { const pg8::f32x4 b = *(const pg8::f32x4*)(C + off + bj * 128 + n * 16);
                        *(pg8::f32x4*)(C + off + bj * 128 + n * 16) = b + acc[ai][bj][m][n] * sc; } }
    }
};

__device__ __forceinline__ void transpose_cvt(const float* __restrict__ W, bf16_t* __restrict__ Wt, int K, int N, float* tile, int bid, int nb) {
    const int tid = ltid(); const int ntn = N / 64, nt = (K / 64) * ntn;
    f32x4 pv[2];
#define TLOAD(t_) do { const int tn_ = (t_) % ntn, tk_ = (t_) / ntn; const float* src_ = W + (size_t)(tk_ * 64) * N + tn_ * 64; \
        _Pragma("unroll") for (int i = 0; i < 2; ++i) pv[i] = *(const f32x4*)(src_ + (size_t)((tid >> 4) + i * 32) * N + (tid & 15) * 4); } while (0)
    if (bid < nt) TLOAD(bid);
    for (int t = bid; t < nt; t += nb) {
        const int tn = t % ntn, tk = t / ntn;
#pragma unroll
        for (int i = 0; i < 2; ++i) { const int r = (tid >> 4) + i * 32, c = (tid & 15) * 4;
            tile[r * 65 + c] = pv[i][0]; tile[r * 65 + c + 1] = pv[i][1]; tile[r * 65 + c + 2] = pv[i][2]; tile[r * 65 + c + 3] = pv[i][3]; }
        __syncthreads();
        if (t + nb < nt) TLOAD(t + nb);
        const int n = tid >> 3, k8 = (tid & 7) * 8; float v[8];
#pragma unroll
        for (int i = 0; i < 8; ++i) v[i] = tile[(k8 + i) * 65 + n];
        u32x4 w; w.x = pk(v[0], v[1]); w.y = pk(v[2], v[3]); w.z = pk(v[4], v[5]); w.w = pk(v[6], v[7]);
        *(u32x4*)(Wt + (size_t)(tn * 64 + n) * K + tk * 64 + k8) = w;
        __syncthreads();
    }
#undef TLOAD
}

template <bool OUT_BF16>
__device__ __forceinline__ void rmsnorm_rows(const float* X, const float* __restrict__ w, void* out, int rows, int bid, int nb) {
    const int tid_ = ltid(); const int lane = tid_ & 63, wid = tid_ >> 6;
    for (int r = bid * 8 + wid; r < rows; r += nb * 8) {
        const float* x = X + (size_t)r * DM; f32x4 v[16]; float ss = 0.f;
#pragma unroll
        for (int i = 0; i < 16; ++i) { v[i] = *(const f32x4*)(x + i * 256 + lane * 4); ss += v[i][0] * v[i][0] + v[i][1] * v[i][1] + v[i][2] * v[i][2] + v[i][3] * v[i][3]; }
#pragma unroll
        for (int o = 32; o >= 1; o >>= 1) ss += __shfl_xor(ss, o);
        const float rs = rsqrtf(ss * (1.0f / DM) + EPS);
#pragma unroll
        for (int i = 0; i < 16; ++i) { const f32x4 ww = *(const f32x4*)(w + i * 256 + lane * 4); const f32x4 y = v[i] * rs * ww;
            if (OUT_BF16) { u32x2 o2; o2.x = pk(y[0], y[1]); o2.y = pk(y[2], y[3]); *(u32x2*)((bf16_t*)out + (size_t)r * DM + i * 256 + lane * 4) = o2; }
            else *(f32x4*)((float*)out + (size_t)r * DM + i * 256 + lane * 4) = y; }
    }
}

__device__ __forceinline__ void rope_phase(bf16_t* proj, int rows, int L, int bid, int nb) {
    const int tid_ = ltid(); const int lane = tid_ & 63, wid = tid_ >> 6, sub = lane >> 5, d = (lane & 31) * 2;
    const double i2pi = 0.15915494309189533577;
    for (int rp = bid * 8 + wid; rp < rows / 2; rp += nb * 8) {
        const int r = rp * 2 + sub, pos = r & (L - 1);
        double a0 = (double)pos * INVD[d] * i2pi, a1 = (double)pos * INVD[d + 1] * i2pi;
        a0 -= __builtin_rint(a0); a1 -= __builtin_rint(a1);
        const float f0 = (float)a0, f1 = (float)a1;
        const float c0 = __builtin_amdgcn_cosf(f0), s0 = __builtin_amdgcn_sinf(f0), c1 = __builtin_amdgcn_cosf(f1), s1 = __builtin_amdgcn_sinf(f1);
        bf16_t* row = proj + (size_t)r * LDP + d;
#pragma unroll 8
        for (int vct = 0; vct < 32; ++vct) { unsigned* p1 = (unsigned*)(row + vct * 128); unsigned* p2 = (unsigned*)(row + vct * 128 + 64);
            const unsigned w1 = *p1, w2 = *p2; const float x10 = bflo(w1), x11 = bfhi(w1), x20 = bflo(w2), x21 = bfhi(w2);
            *p1 = pk(x10 * c0 - x20 * s0, x11 * c1 - x21 * s1); *p2 = pk(x20 * c0 + x10 * s0, x21 * c1 + x11 * s1); }
    }
}

constexpr int HT = 256, HTB = 16;
template <bool PASS3>
__device__ __forceinline__ void hgrn_pass(bf16_t* proj, const float* __restrict__ hgrn_lb, float* ST, float* PD, int nseq, int L, float* lds, int bid, int nb) {
    const int tid = ltid(), g = tid >> 7, j = tid & 127;
    float* qs = lds + g * (3 * HTB * 128); float* fs = qs + HTB * 128; float* vs = fs + HTB * 128;
    const int NSC = L / HT, nitems = nseq * NSC * 8;
    const int sr = j >> 4, c8 = (j & 15) * 8;
    for (int it = bid; it < nitems; it += nb) {
        const int u = it * 4 + g, dir = u & 1, h = (u >> 1) & 15, sc = (u >> 5) % NSC, s = (u >> 5) / NSC;
        const size_t row0 = (size_t)s * L + (size_t)sc * HT;
        const int colq = 6144 + h * 128, colf = (dir ? 10240 : 8192) + h * 128, colv = 12288 + h * 128;
        float lb[8];
#pragma unroll
        for (int e = 0; e < 8; ++e) { const float a0 = hgrn_lb[dir * 4096 + h * 128 + c8 + e], a1 = hgrn_lb[dir * 4096 + 2048 + h * 128 + c8 + e]; lb[e] = 1.0f / (1.0f + __expf(a1 - a0)); }
        float S[128];
#pragma unroll
        for (int k = 0; k < 128; ++k) S[k] = PASS3 ? ST[(size_t)u * 16384 + k * 128 + j] : 0.f;
        float P = 1.f;
        u32x4 rq[2], rf[2], rv[2];
#define HLOAD(b) do { const size_t rb_ = row0 + (dir ? (HT - HTB * ((b) + 1)) : HTB * (b)); _Pragma("unroll") for (int i = 0; i < 2; ++i) { const bf16_t* p_ = proj + (rb_ + sr + 8 * i) * LDP + c8; \
            if (PASS3) rq[i] = *(const u32x4*)(p_ + colq); rf[i] = *(const u32x4*)(p_ + colf); rv[i] = *(const u32x4*)(p_ + colv); } } while (0)
        HLOAD(0);
        for (int b = 0; b < HT / HTB; ++b) {
            __syncthreads();
#pragma unroll
            for (int i = 0; i < 2; ++i) { const int ro = (sr + 8 * i) * 128 + c8;
#pragma unroll
                for (int e = 0; e < 4; ++e) {
                    const unsigned wf = rf[i][e], wv = rv[i][e];
                    const float f0 = bflo(wf), f1 = bfhi(wf);
                    fs[ro + 2 * e] = lb[2 * e] + (1.f - lb[2 * e]) / (1.f + __expf(-f0)); fs[ro + 2 * e + 1] = lb[2 * e + 1] + (1.f - lb[2 * e + 1]) / (1.f + __expf(-f1));
                    vs[ro + 2 * e] = bflo(wv); vs[ro + 2 * e + 1] = bfhi(wv);
                    if (PASS3) { const unsigned wq = rq[i][e]; const float q0 = bflo(wq), q1 = bfhi(wq); qs[ro + 2 * e] = q0 / (1.f + __expf(-q0)); qs[ro + 2 * e + 1] = q1 / (1.f + __expf(-q1)); }
                } }
            __syncthreads();
            if (b + 1 < HT / HTB) HLOAD(b + 1);
            const size_t rb = row0 + (dir ? (HT - HTB * (b + 1)) : HTB * b);
#pragma unroll 1
            for (int tt = 0; tt < HTB; ++tt) {
                const int t = dir ? (HTB - 1 - tt) : tt;
                const float v = vs[t * 128 + j]; f32x2 o2 = {0.f, 0.f};
#pragma unroll
                for (int k4 = 0; k4 < 32; ++k4) { const f32x4 f4 = *(const f32x4*)(fs + t * 128 + k4 * 4);
#pragma unroll
                    for (int e = 0; e < 4; ++e) S[k4 * 4 + e] = fmaf(f4[e], S[k4 * 4 + e] - v, v);
                    if (PASS3) { const f32x4 q4 = *(const f32x4*)(qs + t * 128 + k4 * 4);
#pragma unroll
                        for (int e = 0; e < 4; e += 2) { const f32x2 qq = {q4[e], q4[e + 1]}, sv = {S[k4 * 4 + e], S[k4 * 4 + e + 1]}; o2 = __builtin_elementwise_fma(qq, sv, o2); } } }
                if (PASS3) proj[(rb + t) * LDP + colf + j] = f2bf(o2[0] + o2[1]);
                else P *= fs[t * 128 + j];
            }
        }
#undef HLOAD
        if (!PASS3) {
#pragma unroll
            for (int k = 0; k < 128; ++k) ST[(size_t)u * 16384 + k * 128 + j] = S[k];
            PD[(size_t)u * 128 + j] = P; }
        __syncthreads();
    }
}

constexpr int LDT = 264;
__device__ __forceinline__ void hgrn_ends(const bf16_t* proj, const float* __restrict__ hgrn_lb, float* ST, float* PD, int nseq, int L, unsigned char* lds, int bid, int nb) {
    const int tid = ltid(), grp = tid >> 7, x = tid & 127, wid = tid >> 6, lane = tid & 63, fr = lane & 15, fq = lane >> 4;
    bf16_t* wT = (bf16_t*)lds; bf16_t* vT = (bf16_t*)(lds + 128 * LDT * 2);
    const int NSC = L / HT, nunits = nseq * NSC * 32;
    for (int u = bid; u < nunits; u += nb) {
        const int dir = u & 1, h = (u >> 1) & 15, sc = (u >> 5) % NSC, s = (u >> 5) / NSC;
        const size_t row0 = (size_t)s * L + (size_t)sc * HT;
        if (grp == 0) {
            const bf16_t* pf = proj + row0 * LDP + (dir ? 10240 : 8192) + h * 128 + x;
            const float a0 = hgrn_lb[dir * 4096 + h * 128 + x], a1 = hgrn_lb[dir * 4096 + 2048 + h * 128 + x]; const float lb = __builtin_amdgcn_rcpf(1.0f + __expf(a1 - a0));
            float R = 1.f; unsigned short raw[32], nxt[32];
#pragma unroll
            for (int i = 0; i < 32; ++i) { const int t = dir ? i : 255 - i; raw[i] = pf[(size_t)t * LDP]; }
#pragma unroll 1
            for (int tb = 0; tb < 8; ++tb) {
                if (tb < 7) {
#pragma unroll
                    for (int i = 0; i < 32; ++i) { const int t = dir ? (tb + 1) * 32 + i : 255 - ((tb + 1) * 32 + i); nxt[i] = pf[(size_t)t * LDP]; } }
#pragma unroll
                for (int i = 0; i < 32; ++i) { const int t = dir ? tb * 32 + i : 255 - (tb * 32 + i);
                    const float fraw = bf2f(raw[i]); const float f = lb + (1.f - lb) * __builtin_amdgcn_rcpf(1.f + __expf(-fraw));
                    wT[x * LDT + t] = f2bf((1.f - f) * R); R *= f; }
#pragma unroll
                for (int i = 0; i < 32; ++i) raw[i] = nxt[i];
            }
            PD[(size_t)u * 128 + x] = R;
        } else if (grp < 3) {
            const bf16_t* pv = proj + (row0 + (size_t)(grp - 1) * 128) * LDP + 12288 + h * 128 + x; bf16_t* dst = vT + x * LDT + (grp - 1) * 128;
#pragma unroll 1
            for (int tb = 0; tb < 4; ++tb) { unsigned short raw[32];
#pragma unroll
                for (int i = 0; i < 32; ++i) raw[i] = pv[(size_t)(tb * 32 + i) * LDP];
#pragma unroll
                for (int i = 0; i < 32; i += 2) *(unsigned*)(dst + tb * 32 + i) = (unsigned)raw[i] | ((unsigned)raw[i + 1] << 16); }
        }
        __syncthreads();
        pg8::f32x4 acc[8];
#pragma unroll
        for (int jb = 0; jb < 8; ++jb) acc[jb] = (pg8::f32x4){0.f, 0.f, 0.f, 0.f};
#pragma unroll
        for (int ks = 0; ks < 8; ++ks) { const pg8::bf16x8 a = *(const pg8::bf16x8*)(wT + (wid * 16 + fr) * LDT + ks * 32 + fq * 8);
#pragma unroll
            for (int jb = 0; jb < 8; ++jb) { const pg8::bf16x8 b = *(const pg8::bf16x8*)(vT + (jb * 16 + fr) * LDT + ks * 32 + fq * 8);
                acc[jb] = __builtin_amdgcn_mfma_f32_16x16x32_bf16(a, b, acc[jb], 0, 0, 0); } }
        float* st = ST + (size_t)u * 16384;
#pragma unroll
        for (int jb = 0; jb < 8; ++jb)
#pragma unroll
            for (int i = 0; i < 4; ++i) st[(wid * 16 + fq * 4 + i) * 128 + jb * 16 + fr] = acc[jb][i];
        __syncthreads();
    }
}

__device__ __forceinline__ void hgrn_out(bf16_t* proj, const float* __restrict__ hgrn_lb, const float* ST, int nseq, int L, unsigned char* lds, int bid, int nb) {
    const int tid = ltid(), wid = tid >> 6, lane = tid & 63, fr = lane & 15, fq = lane >> 4, x = tid & 127, role = tid >> 7;
    bf16_t* QD = (bf16_t*)lds; bf16_t* KD = QD + 32 * 136; bf16_t* KE = KD + 32 * 136; bf16_t* VT = KE + 128 * 40; bf16_t* SB = VT + 128 * 40; bf16_t* AM = SB + 128 * 136; float* DC = (float*)(AM + 32 * 40);
    const int NSC = L / HT, nunits = nseq * NSC * 32;
    for (int u = bid; u < nunits; u += nb) {
        const int dir = u & 1, h = (u >> 1) & 15, sc = (u >> 5) % NSC, s = (u >> 5) / NSC;
        const size_t row0 = (size_t)s * L + (size_t)sc * HT;
        const int colq = 6144 + h * 128, colf = (dir ? 10240 : 8192) + h * 128, colv = 12288 + h * 128;
        pg8::f32x4 Sacc[8];
        { const float* st = ST + (size_t)u * 16384;
#pragma unroll
          for (int jb = 0; jb < 8; ++jb)
#pragma unroll
              for (int r = 0; r < 4; ++r) Sacc[jb][r] = st[(wid * 16 + fq * 4 + r) * 128 + jb * 16 + fr]; }
        float lb = 0.f;
        if (role == 0) { const float a0 = hgrn_lb[dir * 4096 + h * 128 + x], a1 = hgrn_lb[dir * 4096 + 2048 + h * 128 + x]; lb = __builtin_amdgcn_rcpf(1.0f + __expf(a1 - a0)); }
        unsigned short ra[32], rb[32];
#define PLOAD(cc_) do { if (role == 0) { _Pragma("unroll") for (int i = 0; i < 32; ++i) { const int tt_ = (cc_) * 32 + i; const bf16_t* p_ = proj + (row0 + (dir ? 255 - tt_ : tt_)) * LDP + x; ra[i] = p_[colf]; rb[i] = p_[colq]; } } \
        else if (role == 1) { _Pragma("unroll") for (int i = 0; i < 32; ++i) { const int tt_ = (cc_) * 32 + i; ra[i] = proj[(row0 + (dir ? 255 - tt_ : tt_)) * LDP + colv + x]; } } } while (0)
        PLOAD(0);
#define SBWRITE() do { _Pragma("unroll") for (int jb = 0; jb < 8; ++jb) { u32x2 w_; w_.x = pk(Sacc[jb][0], Sacc[jb][1]); w_.y = pk(Sacc[jb][2], Sacc[jb][3]); *(u32x2*)(SB + (jb * 16 + fr) * 136 + wid * 16 + fq * 4) = w_; } } while (0)
        SBWRITE();
#pragma unroll 1
        for (int cc = 0; cc < 8; ++cc) {
            if (role == 0) { float D = 1.f; float kd[32];
#pragma unroll
                for (int i = 0; i < 32; ++i) { const float fraw = bf2f(ra[i]), qraw = bf2f(rb[i]); const float f = lb + (1.f - lb) * __builtin_amdgcn_rcpf(1.f + __expf(-fraw)); const float q = qraw * __builtin_amdgcn_rcpf(1.f + __expf(-qraw));
                    D *= f; QD[i * 136 + x] = f2bf(q * D); kd[i] = (1.f - f) * __builtin_amdgcn_rcpf(D); KD[i * 136 + x] = f2bf(kd[i]); }
                DC[x] = D;
#pragma unroll
                for (int i = 0; i < 32; i += 2) *(unsigned*)(KE + x * 40 + i) = pk(kd[i] * D, kd[i + 1] * D);
            } else if (role == 1) {
#pragma unroll
                for (int i = 0; i < 32; i += 2) *(unsigned*)(VT + x * 40 + i) = (unsigned)ra[i] | ((unsigned)ra[i + 1] << 16);
            }
            if (cc < 7) PLOAD(cc + 1);
            __syncthreads();
            if (wid < 4) { const int mb = wid >> 1, nbk = wid & 1; pg8::f32x4 acc = {0.f, 0.f, 0.f, 0.f};
#pragma unroll
                for (int ks = 0; ks < 4; ++ks) { const pg8::bf16x8 a = *(const pg8::bf16x8*)(QD + (mb * 16 + fr) * 136 + ks * 32 + fq * 8), b = *(const pg8::bf16x8*)(KD + (nbk * 16 + fr) * 136 + ks * 32 + fq * 8);
                    acc = __builtin_amdgcn_mfma_f32_16x16x32_bf16(a, b, acc, 0, 0, 0); }
#pragma unroll
                for (int r = 0; r < 4; ++r) { const int i = mb * 16 + fq * 4 + r, ip = nbk * 16 + fr; AM[i * 40 + ip] = (ip <= i) ? f2bf(acc[r]) : (unsigned short)0; } }
            __syncthreads();
            { const int mb = wid >> 2;
#pragma unroll
              for (int q2 = 0; q2 < 2; ++q2) { const int jb = (wid & 3) * 2 + q2; pg8::f32x4 acc = {0.f, 0.f, 0.f, 0.f};
                  { const pg8::bf16x8 a = *(const pg8::bf16x8*)(AM + (mb * 16 + fr) * 40 + fq * 8), b = *(const pg8::bf16x8*)(VT + (jb * 16 + fr) * 40 + fq * 8); acc = __builtin_amdgcn_mfma_f32_16x16x32_bf16(a, b, acc, 0, 0, 0); }
#pragma unroll
                  for (int ks = 0; ks < 4; ++ks) { const pg8::bf16x8 a = *(const pg8::bf16x8*)(QD + (mb * 16 + fr) * 136 + ks * 32 + fq * 8), b = *(const pg8::bf16x8*)(SB + (jb * 16 + fr) * 136 + ks * 32 + fq * 8);
                      acc = __builtin_amdgcn_mfma_f32_16x16x32_bf16(a, b, acc, 0, 0, 0); }
#pragma unroll
                  for (int r = 0; r < 4; ++r) { const int tt = cc * 32 + mb * 16 + fq * 4 + r; proj[(row0 + (dir ? 255 - tt : tt)) * LDP + colf + jb * 16 + fr] = f2bf(acc[r]); } } }
            { const pg8::f32x4 dc = *(const pg8::f32x4*)(DC + wid * 16 + fq * 4); const pg8::bf16x8 a = *(const pg8::bf16x8*)(KE + (wid * 16 + fr) * 40 + fq * 8);
#pragma unroll
              for (int jb = 0; jb < 8; ++jb) { const pg8::bf16x8 b = *(const pg8::bf16x8*)(VT + (jb * 16 + fr) * 40 + fq * 8); Sacc[jb] = Sacc[jb] * dc; Sacc[jb] = __builtin_amdgcn_mfma_f32_16x16x32_bf16(a, b, Sacc[jb], 0, 0, 0); } }
            __syncthreads();
            if (cc < 7) SBWRITE();
        }
#undef PLOAD
#undef SBWRITE
    }
}
__device__ __forceinline__ void hgrn_scan(float* ST, const float* PD, int nseq, int NSC, int bid, int nb) {
    const int nitems = nseq * 32 * 32; const int tid_ = ltid();
    for (int it = bid; it < nitems; it += nb) {
        const int eb = it & 31, hd = (it >> 5) & 31, s = it >> 10, dir = hd & 1;
        const int e = eb * 512 + tid_, k = e >> 7; float carry = 0.f;
        for (int cc = 0; cc < NSC; cc += 8) { float E[8], p[8]; size_t ui[8];
#pragma unroll
            for (int q = 0; q < 8; ++q) { const int c = dir ? NSC - 1 - (cc + q) : (cc + q); ui[q] = ((size_t)(s * NSC + c)) * 32 + hd; E[q] = ST[ui[q] * 16384 + e]; p[q] = PD[ui[q] * 128 + k]; }
#pragma unroll
            for (int q = 0; q < 8; ++q) { ST[ui[q] * 16384 + e] = carry; carry = fmaf(p[q], carry, E[q]); } }
    }
}

__device__ __forceinline__ void combine_phase(const bf16_t* OB, const bf16_t* proj, bf16_t* mix, const float* __restrict__ dl, const float* __restrict__ subln_w, const float* __restrict__ hnw, int rows, int bid, int nb) {
    const int tid_ = ltid(); const int lane = tid_ & 63, wid = tid_ >> 6;
    float a = dl[lane] * dl[128 + lane] + dl[64 + lane] * dl[192 + lane], b = dl[256 + lane] * dl[384 + lane] + dl[320 + lane] * dl[448 + lane];
#pragma unroll
    for (int o = 32; o >= 1; o >>= 1) { a += __shfl_xor(a, o); b += __shfl_xor(b, o); }
    const float lam = expf(a) - expf(b) + 0.2f;
    for (int r = bid * 8 + wid; r < rows; r += nb * 8) {
#pragma unroll
        for (int i = 0; i < 4; ++i) { const int head = i * 2 + (lane >> 5), e = (lane & 31) * 8;
            const bf16_t* o0 = OB + (size_t)r * DM + head * 512 + e; const u32x4 x0 = *(const u32x4*)o0, x1 = *(const u32x4*)(o0 + 256);
            float dv[8]; float ss = 0.f;
#pragma unroll
            for (int q = 0; q < 4; ++q) { dv[2 * q] = bflo(x0[q]) - lam * bflo(x1[q]); dv[2 * q + 1] = bfhi(x0[q]) - lam * bfhi(x1[q]); ss += dv[2 * q] * dv[2 * q] + dv[2 * q + 1] * dv[2 * q + 1]; }
#pragma unroll
            for (int o = 16; o >= 1; o >>= 1) ss += __shfl_xor(ss, o);
            const float rs = rsqrtf(ss * (1.0f / 256.0f) + EPS) * 0.8f;
            const f32x4 w0 = *(const f32x4*)(subln_w + e), w1 = *(const f32x4*)(subln_w + e + 4);
            u32x4 w; w.x = pk(dv[0] * rs * w0[0], dv[1] * rs * w0[1]); w.y = pk(dv[2] * rs * w0[2], dv[3] * rs * w0[3]); w.z = pk(dv[4] * rs * w1[0], dv[5] * rs * w1[1]); w.w = pk(dv[6] * rs * w1[2], dv[7] * rs * w1[3]);
            *(u32x4*)(mix + (size_t)r * DM + head * 256 + e) = w; }
#pragma unroll
        for (int i = 0; i < 4; ++i) { const int col = i * 512 + lane * 8, dd = col & 127;
            const bf16_t* pr = proj + (size_t)r * LDP + col; const u32x4 xf = *(const u32x4*)(pr + 8192), xb = *(const u32x4*)(pr + 10240), xg = *(const u32x4*)(pr + 14336);
            float ov[8], gv[8]; float ss = 0.f;
#pragma unroll
            for (int q = 0; q < 4; ++q) { ov[2 * q] = bflo(xf[q]) + bflo(xb[q]); ov[2 * q + 1] = bfhi(xf[q]) + bfhi(xb[q]); gv[2 * q] = bflo(xg[q]); gv[2 * q + 1] = bfhi(xg[q]); ss += ov[2 * q] * ov[2 * q] + ov[2 * q + 1] * ov[2 * q + 1]; }
#pragma unroll
            for (int o = 8; o >= 1; o >>= 1) ss += __shfl_xor(ss, o);
            const float rs = rsqrtf(ss * (1.0f / 128.0f) + EPS);
            const f32x4 w0 = *(const f32x4*)(hnw + dd), w1 = *(const f32x4*)(hnw + dd + 4);
            float y[8];
#pragma unroll
            for (int q = 0; q < 8; ++q) { const float wq = q < 4 ? w0[q & 3] : w1[q & 3]; y[q] = ov[q] * rs * wq * (gv[q] * __builtin_amdgcn_rcpf(1.f + __expf(-gv[q]))); }
            u32x4 w; w.x = pk(y[0], y[1]); w.y = pk(y[2], y[3]); w.z = pk(y[4], y[5]); w.w = pk(y[6], y[7]);
            *(u32x4*)(mix + (size_t)r * DM + 2048 + col) = w; }
    }
}

__device__ __forceinline__ void attn_phase(const bf16_t* proj, bf16_t* OB, int nseq, int L, char* lds, int bid, int nb) {
    const int nqb = L / 256, nunits = nseq * 32 * nqb;
    for (int u = bid; u < nunits; u += nb) {
        const int qb = u % nqb, r = u / nqb, vh = r & 1, c = (r >> 1) & 1, h = (r >> 2) & 7, s = r >> 5;
        const size_t row0 = (size_t)s * L;
        att::attn_dense_body<att::bf16>(proj + (row0 + (size_t)qb * 256) * LDP + h * 256 + c * 128, proj + row0 * LDP + 2048 + h * 256 + c * 128,
                                        proj + row0 * LDP + 4096 + h * 256 + vh * 128, OB + (row0 + (size_t)qb * 256) * DM + h * 512 + c * 256 + vh * 128, L, lds);
        __syncthreads();
    }
}

struct Params { const float* in[13]; float* out; unsigned char* ws; };

__global__ void __launch_bounds__(512, 2) fwd(Params p) {
    extern __shared__ __attribute__((aligned(16))) unsigned char lds[];
    const int tid = threadIdx.x, bid = blockIdx.x, nb = gridDim.x;
    if (tid < 4) ((unsigned*)(lds + LDS_BAR_OFF))[tid] = 0u;
    __syncthreads();
    XcdBarrier bar = xcd_barrier_post((unsigned*)(p.ws + WS_CTL), (volatile LAS unsigned*)(lds + LDS_BAR_OFF));
    const float* attn_norm_w = p.in[2]; const float* w_in = p.in[3]; const float* diff_lambda = p.in[4]; const float* subln_w = p.in[5];
    const float* hgrn_lb = p.in[6]; const float* hgrn_norm_w = p.in[7]; const float* w_out = p.in[8]; const float* mlp_norm_w = p.in[9];
    const float* w_up = p.in[10]; const float* w_down = p.in[11]; const float* final_norm_w = p.in[12];
    bf16_t* WIN = (bf16_t*)(p.ws + WS_WIN); bf16_t* WOUT = (bf16_t*)(p.ws + WS_WOUT); bf16_t* WUP = (bf16_t*)(p.ws + WS_WUP); bf16_t* WDN = (bf16_t*)(p.ws + WS_WDN);
    bf16_t* HB = (bf16_t*)(p.ws + WS_HB); bf16_t* PROJ = (bf16_t*)(p.ws + WS_PROJ); bf16_t* OB = (bf16_t*)(p.ws + WS_OB);
    float* ST = (float*)(p.ws + WS_ST); float* PD = (float*)(p.ws + WS_PD); float* SSQ = (float*)(p.ws + WS_CTL + 512 * 1024);
    PG8_LAS unsigned char* ldsl = (PG8_LAS unsigned char*)lds;

    for (int i = bid * 512 + tid; i < 2 * MH; i += nb * 512) SSQ[i] = 0.f;
#if PHM & 1
    transpose_cvt(w_in, WIN, DM, NPROJ, (float*)lds, bid, nb);
    transpose_cvt(w_out, WOUT, DM, DM, (float*)lds, bid, nb);
    transpose_cvt(w_up, WUP, DM, DFF, (float*)lds, bid, nb);
    transpose_cvt(w_down, WDN, DFF, DM, (float*)lds, bid, nb);
#endif

    for (int hf = 0; hf < 2; ++hf) {
        const float* x = hf ? p.in[1] : p.in[0]; const int nseq = hf ? 1 : 8, L = hf ? 16384 : 2048;
        float* outp = p.out + (size_t)hf * MH * DM;
        rmsnorm_rows<true>(x, attn_norm_w, HB, MH, bid, nb);
        xcd_barrier(bar);
#if PHM & 2
        { pg8::Gemm g{HB, WIN, MH, NPROJ, DM}; pg8::StaticOrder S; S.init(MH, NPROJ, nb, bid); EpiB<0> E{PROJ, LDP};
          pg8::gemm_phase<EpiB<0>, pg8::StaticOrder>(ldsl, g, S, E, nullptr); }
#endif
        xcd_barrier(bar);
        rope_phase(PROJ, MH, L, bid, nb);
#if PHM & 4
        hgrn_ends(PROJ, hgrn_lb, ST, PD, nseq, L, lds, bid, nb);
#endif
        xcd_barrier(bar);
        hgrn_scan(ST, PD, nseq, L / HT, bid, nb);
#if PHM & 8
        attn_phase(PROJ, OB, nseq, L, (char*)lds, bid, nb);
#endif
        xcd_barrier(bar);
#if PHM & 16
        hgrn_out(PROJ, hgrn_lb, ST, nseq, L, lds, bid, nb);
#endif
        xcd_barrier(bar);
        combine_phase(OB, PROJ, HB, diff_lambda, subln_w, hgrn_norm_w, MH, bid, nb);
        xcd_barrier(bar);
#if PHM & 32
        { pg8::Gemm g{HB, WOUT, MH, DM, DM}; pg8::StaticOrder S; S.init(MH, DM, nb, bid); EpiResNorm E{x, outp, DM, OB, mlp_norm_w, SSQ + hf * MH};
          pg8::gemm_phase<EpiResNorm, pg8::StaticOrder>(ldsl, g, S, E, nullptr); }
#endif
        xcd_barrier(bar);
        for (int ch = 0; ch < MH / MC; ++ch) {
#if PHM & 64
            { pg8::Gemm g{OB + (size_t)ch * MC * DM, WUP, MC, DFF, DM}; pg8::StaticOrder S; S.init(MC, DFF, nb, bid); EpiB<1> E{PROJ, DFF};
              pg8::gemm_phase<EpiB<1>, pg8::StaticOrder>(ldsl, g, S, E, nullptr); }
#endif
            xcd_barrier(bar);
#if PHM & 128
            { float* oc = outp + (size_t)ch * MC * DM; pg8::Gemm g{PROJ, WDN, MC, DM, DFF}; pg8::StaticOrder S; S.init(MC, DM, nb, bid); EpiResScale E{oc, DM, SSQ + hf * MH + ch * MC};
              pg8::gemm_phase<EpiResScale, pg8::StaticOrder>(ldsl, g, S, E, nullptr); }
#endif
            xcd_barrier(bar);
        }
        rmsnorm_rows<false>(outp, final_norm_w, outp, MH, bid, nb);
    }
}
}

extern "C" void kernel_launch(void* const* d_in, const int* in_sizes, int n_in, void* d_out, int out_size, void* d_ws, size_t ws_size, hipStream_t stream) {
    static int grid = 0;
    if (grid == 0) {
        if (n_in != 13 || ws_size < mk::WS_END) { fprintf(stderr, "kernel_launch: n_in %d ws %zu (need %zu)\n", n_in, ws_size, (size_t)mk::WS_END); grid = -1; return; }
        int dev = 0, cus = 0, per_cu = 0;
        hipGetDevice(&dev); hipDeviceGetAttribute(&cus, hipDeviceAttributeMultiprocessorCount, dev);
        if (hipFuncSetAttribute((const void*)mk::fwd, hipFuncAttributeMaxDynamicSharedMemorySize, mk::LDS_BYTES) != hipSuccess) { fprintf(stderr, "kernel_launch: hipFuncSetAttribute failed\n"); grid = -1; return; }
        if (hipOccupancyMaxActiveBlocksPerMultiprocessor(&per_cu, (const void*)mk::fwd, 512, mk::LDS_BYTES) != hipSuccess || per_cu < 1) { fprintf(stderr, "kernel_launch: occupancy %d\n", per_cu); grid = -1; return; }
        (void)hipGetLastError();
        grid = cus;
    }
    if (grid < 0) return;
    hipMemsetAsync((char*)d_ws + mk::WS_CTL, 0, 65536, stream);
    mk::Params p{};
    for (int i = 0; i < 13; ++i) p.in[i] = (const float*)d_in[i];
    p.out = (float*)d_out; p.ws = (unsigned char*)d_ws;
    hipLaunchKernelGGL(mk::fwd, dim3(grid), dim3(512), mk::LDS_BYTES, stream, p);
}
```

```cpp
#include <hip/hip_runtime.h>
#include <cstdio>
#include <cstdint>
__device__ __forceinline__ int ltid() { int t = threadIdx.x; asm volatile("" : "+v"(t)); return t; }
__device__ __forceinline__ int lsg(int v) { asm volatile("" : "+s"(v)); return v; }
namespace pg8 {
#define PG8_LAS __attribute__((address_space(3)))
typedef unsigned short bf16_t;
typedef short bf16x8 __attribute__((ext_vector_type(8)));
typedef float f32x4 __attribute__((ext_vector_type(4)));
typedef unsigned u32x4 __attribute__((ext_vector_type(4)));
constexpr int BM = 256, BK = 64, HALF = 128, HTB = HALF * BK * 2  , STAGE_BYTES = 8 * HTB, NXCD = 8, WGM = 8;

__host__ __device__ __forceinline__ int lds_byte(int r, int c) { const int st = (r >> 4) * 2 + (c >> 5), rr = r & 15, cc = c & 31, ob = rr * 64 + cc * 2; return st * 1024 + (ob ^ (((ob >> 9) & 1) << 5)); }
__host__ __device__ __forceinline__ void stage_rc(int b, int& R, int& C) { const int st = b / 1024, sb = b % 1024, swz = sb ^ (((sb >> 9) & 1) << 5); R = (st >> 1) * 16 + swz / 64; C = (st & 1) * 32 + (swz % 64) / 2; }
__host__ __device__ __forceinline__ int perm32(int rho) { const int n = rho >> 4, i = rho & 15; return 8 * (i >> 2) + 4 * n + (i & 3); }

struct Unit { int pm, pn; };
struct Gemm { const bf16_t* A; const bf16_t* Bt; int M, N, K; };

struct StaticOrder {
    int nM, nN, nwg, G, c;
    __host__ __device__ void init(int M, int N, int G_, int c_) { nM = M / BM; nN = N / BM; nwg = nM * nN; G = G_; c = c_; }
    __host__ __device__ bool next(int i, Unit& u) const {
        const long L = (long)i * G + c; if (L >= nwg) return false;
        int wgid = (int)L; { const int q = nwg / NXCD, r = nwg % NXCD, xcd = wgid % NXCD, off = wgid / NXCD; wgid = (xcd < r ? xcd * (q + 1) : r * (q + 1) + (xcd - r) * q) + off; }
        const int nig = WGM * nN, gid = wgid / nig, fm = gid * WGM, gsz = (nM - fm) < WGM ? (nM - fm) : WGM;
        u.pm = fm + ((wgid % nig) % gsz); u.pn = (wgid % nig) / gsz; return true;
    }
    __device__ __forceinline__ void a_ready(const Unit&) const {}
    __device__ __forceinline__ void done(const Unit&) const {}
};
struct CountedOrder : StaticOrder {
    const unsigned* ready; unsigned need; unsigned* tmo;
    __device__ __forceinline__ void a_ready(const Unit& u) const {
        if (threadIdx.x < 64) {
            const unsigned long long t0 = __builtin_amdgcn_s_memrealtime(); unsigned polls = 0;
            while ((unsigned)__builtin_amdgcn_readfirstlane(__hip_atomic_load(ready + 64 * u.pm, __ATOMIC_RELAXED, __HIP_MEMORY_SCOPE_AGENT)) < need) {
                if ((++polls & 255u) == 0u && __builtin_amdgcn_readfirstlane(__hip_atomic_load(tmo, __ATOMIC_RELAXED, __HIP_MEMORY_SCOPE_AGENT)) != 0u) break;
                if (__builtin_amdgcn_s_memrealtime() - t0 > 2000000ull) {
                    if (threadIdx.x == 0) { unsigned expect = 0u; __hip_atomic_compare_exchange_strong(tmo + 1, &expect, 0x600u | (unsigned)(u.pm & 0xff), __ATOMIC_RELAXED, __ATOMIC_RELAXED, __HIP_MEMORY_SCOPE_AGENT); __hip_atomic_store(tmo, 1u, __ATOMIC_RELAXED, __HIP_MEMORY_SCOPE_AGENT); }
                    break; }
                __builtin_amdgcn_s_sleep(2); }
            __builtin_amdgcn_fence(__ATOMIC_ACQUIRE, "agent");
            asm volatile("s_waitcnt vmcnt(0)" ::: "memory");
        }
#if !defined(BROKEN_HOOK_NO_BARRIER)
        asm volatile("" ::: "memory"); __builtin_amdgcn_s_barrier(); asm volatile("" ::: "memory");
#endif
    }
};

__device__ __forceinline__ unsigned cvt_pk_bf16(float lo, float hi) { unsigned r; asm volatile("v_cvt_pk_bf16_f32 %0, %1, %2" : "=v"(r) : "v"(lo), "v"(hi)); return r; }
typedef float f32x2 __attribute__((ext_vector_type(2)));
__device__ __forceinline__ f32x2 gelu_pk(f32x2 v) {
    const f32x2 av = __builtin_elementwise_abs(v), d = av * 0.2316418882f + 1.0f;
    f32x2 t; t.x = __builtin_amdgcn_rcpf(d.x); t.y = __builtin_amdgcn_rcpf(d.y);
    f32x2 q = t * 0.5307027145f + (-0.7265760135f); q = q * t + 0.7107068705f; q = q * t + (-0.142248368f); q = q * t + 0.127414796f; q = q * t;
    const f32x2 s = (v * v) * (-0.72134752044f);
    f32x2 e; e.x = __builtin_amdgcn_exp2f(s.x); e.y = __builtin_amdgcn_exp2f(s.y);
    const f32x2 m = v * (q * e), r = v - m;
    f32x2 o; o.x = v.x < 0.f ? m.x : r.x; o.y = v.y < 0.f ? m.y : r.y; return o;
}

struct EpiF32 {
    static constexpr bool PERM = false, AFTER_DRAIN = false;
    float* C; int ldc; const float* bias;
    __device__ __forceinline__ void operator()(const f32x4 (&acc)[2][2][4][2], const Unit& u, int wr, int wc, int fr, int fq) const {
        const int row0 = u.pm * BM + wr * 64 + fr, col0 = u.pn * BM + wc * 32 + 4 * fq;
        f32x4 bv[2][2];
#pragma unroll
        for (int bj = 0; bj < 2; ++bj)
#pragma unroll
            for (int n = 0; n < 2; ++n) bv[bj][n] = bias ? *(const f32x4*)(bias + col0 + bj * HALF + n * 16) : (f32x4){0.f, 0.f, 0.f, 0.f};
#pragma unroll
        for (int ai = 0; ai < 2; ++ai)
#pragma unroll
            for (int m = 0; m < 4; ++m) { float* rowp = C + (size_t)(row0 + ai * HALF + m * 16) * ldc + col0;
#pragma unroll
                for (int bj = 0; bj < 2; ++bj)
#pragma unroll
                    for (int n = 0; n < 2; ++n) *(f32x4*)(rowp + bj * HALF + n * 16) = acc[ai][bj][m][n] + bv[bj][n]; }
    }
};
template <int ACT  > struct EpiBf16 {
    static constexpr bool PERM = true, AFTER_DRAIN = false;
    bf16_t* O; int ldc; const float* bias; int split_cols; size_t split_stride;
    __device__ __forceinline__ void operator()(const f32x4 (&acc)[2][2][4][2], const Unit& u, int wr, int wc, int fr, int fq) const {
        const int row0 = u.pm * BM + wr * 64 + fr; int colt = u.pn * BM; bf16_t* base = O;
        if (split_cols) { const int t = colt / split_cols; base += (size_t)t * split_stride; colt -= t * split_cols; }
        const int col0 = colt + wc * 32 + 8 * fq, bcol0 = u.pn * BM + wc * 32 + 8 * fq;
        f32x4 bv[2][2];
#pragma unroll
        for (int bj = 0; bj < 2; ++bj)
#pragma unroll
            for (int n = 0; n < 2; ++n) bv[bj][n] = bias ? *(const f32x4*)(bias + bcol0 + bj * HALF + 4 * n) : (f32x4){0.f, 0.f, 0.f, 0.f};
#pragma unroll
        for (int ai = 0; ai < 2; ++ai)
#pragma unroll
            for (int m = 0; m < 4; ++m) { bf16_t* rowp = base + (size_t)(row0 + ai * HALF + m * 16) * ldc + col0;
#pragma unroll
                for (int bj = 0; bj < 2; ++bj) { f32x4 v0 = acc[ai][bj][m][0] + bv[bj][0], v1 = acc[ai][bj][m][1] + bv[bj][1];
                    if (ACT == 1) { f32x2 a = gelu_pk((f32x2){v0[0], v0[1]}), b = gelu_pk((f32x2){v0[2], v0[3]}), c = gelu_pk((f32x2){v1[0], v1[1]}), d = gelu_pk((f32x2){v1[2], v1[3]});
                        v0 = (f32x4){a.x, a.y, b.x, b.y}; v1 = (f32x4){c.x, c.y, d.x, d.y}; }
                    if (ACT == 2) {
#pragma unroll
                        for (int j = 0; j < 4; ++j) { v0[j] = 0.5f * v0[j] * (1.0f + erff(v0[j] * 0.70710678f)); v1[j] = 0.5f * v1[j] * (1.0f + erff(v1[j] * 0.70710678f)); } }
                    u32x4 w; w.x = cvt_pk_bf16(v0[0], v0[1]); w.y = cvt_pk_bf16(v0[2], v0[3]); w.z = cvt_pk_bf16(v1[0], v1[1]); w.w = cvt_pk_bf16(v1[2], v1[3]);
                    *(u32x4*)(rowp + bj * HALF) = w; } }
    }
};
template <class Epi, class Sched, bool STAMP = false>
__device__ __forceinline__ void gemm_phase(PG8_LAS unsigned char* lds, const Gemm g, const Sched& S, const Epi& E, unsigned long long* stamps) {
    const int tid = ltid(), wid = __builtin_amdgcn_readfirstlane(tid >> 6), lane = tid & 63, wr = wid >> 2, wc = wid & 3, fr = lane & 15, fq = lane >> 4;
    const int K = g.K, nt = K / BK;
    int ts_lo = 0, ts_hi = 0, nts = 0; const unsigned long long rt_entry = STAMP ? (unsigned long long)wall_clock64() : 0ull;
#define PG8_STAMP() do { if (STAMP && wid == 0 && nts < 64) { const unsigned long long _c = (unsigned long long)clock64(); \
        ts_lo = (lane == nts) ? (int)(unsigned)_c : ts_lo; ts_hi = (lane == nts) ? (int)(unsigned)(_c >> 32) : ts_hi; ++nts; } } while (0)
    PG8_STAMP();
    unsigned voffA[2], voffB[2];
#pragma unroll
    for (int i = 0; i < 2; ++i) { int R, C; stage_rc(tid * 16 + i * 8192, R, C); const int Rb = Epi::PERM ? ((R & ~31) + perm32(R & 31)) : R;
        voffA[i] = (unsigned)(R * K + C) * 2u; voffB[i] = (unsigned)(Rb * K + C) * 2u; }
    const size_t kstep = (size_t)(BK * 2);
    const size_t hstep = (size_t)HALF * K * 2;
    const size_t tstep = 2 * hstep;
    const unsigned ldsw = (unsigned)wid * 1024u;
    const int aoff = lds_byte(wr * 64 + fr, fq * 8), boff = lds_byte(wc * 32 + fr, fq * 8);
#define PG8_SA(b, h) (((b) * 2 + (h)) * HTB)
#define PG8_SB(b, h) ((4 + (b) * 2 + (h)) * HTB)
#define PG8_STAGE(bufoff, gbase, voff) do { _Pragma("unroll") for (int _i = 0; _i < 2; ++_i) \
        __builtin_amdgcn_global_load_lds((const unsigned*)((const char*)(gbase) + (voff)[_i]), (PG8_LAS unsigned*)(lds + (bufoff) + ldsw + _i * 8192), 16, 0, 0); } while (0)
#define PG8_LDA(dst, b, h) do { _Pragma("unroll") for (int m = 0; m < 4; ++m) _Pragma("unroll") for (int k = 0; k < 2; ++k) dst[m][k] = *(const PG8_LAS bf16x8*)(lds + PG8_SA(b, h) + aoff + m * 2048 + k * 1024); } while (0)
#define PG8_LDB(dst, b, h) do { _Pragma("unroll") for (int n = 0; n < 2; ++n) _Pragma("unroll") for (int k = 0; k < 2; ++k) dst[n][k] = *(const PG8_LAS bf16x8*)(lds + PG8_SB(b, h) + boff + n * 2048 + k * 1024); } while (0)
#define PG8_MMA(ai, bj, At, Bt) do { __builtin_amdgcn_s_setprio(1); _Pragma("unroll") for (int m = 0; m < 4; ++m) _Pragma("unroll") for (int n = 0; n < 2; ++n) _Pragma("unroll") for (int k = 0; k < 2; ++k) \
        acc[ai][bj][m][n] = __builtin_amdgcn_mfma_f32_16x16x32_bf16(Bt[n][k], At[m][k], acc[ai][bj][m][n], 0, 0, 0); __builtin_amdgcn_s_setprio(0); } while (0)
#define PG8_WAIT_V(n) asm volatile("s_waitcnt vmcnt(" #n ")" ::: "memory")
#define PG8_WAIT_L(n) asm volatile("s_waitcnt lgkmcnt(" #n ")" ::: "memory")
#define PG8_BAR __builtin_amdgcn_s_barrier()
#define PG8_SCHED __builtin_amdgcn_sched_barrier(0)
    Unit cur, nxt; int ui = 0;
    if (!S.next(0, cur)) return;
    f32x4 acc[2][2][4][2];
#pragma unroll
    for (int a = 0; a < 2; ++a)
#pragma unroll
        for (int b = 0; b < 2; ++b)
#pragma unroll
            for (int m = 0; m < 4; ++m)
#pragma unroll
                for (int n = 0; n < 2; ++n) acc[a][b][m][n] = (f32x4){0.f, 0.f, 0.f, 0.f};
    bf16x8 At[4][2], B0[2][2], B1[2][2];
    const char* cA = (const char*)g.A + (size_t)cur.pm * tstep; const char* cB = (const char*)g.Bt + (size_t)cur.pn * tstep;
    S.a_ready(cur);
    PG8_STAGE(PG8_SB(0, 0), cB, voffB); PG8_STAGE(PG8_SA(0, 0), cA, voffA); PG8_STAGE(PG8_SB(0, 1), cB + hstep, voffB); PG8_STAGE(PG8_SA(0, 1), cA + hstep, voffA);
    if (wr == 1) PG8_BAR;
    PG8_WAIT_V(4); PG8_BAR;
    PG8_STAGE(PG8_SB(1, 0), cB + kstep, voffB); PG8_STAGE(PG8_SA(1, 0), cA + kstep, voffA); PG8_STAGE(PG8_SB(1, 1), cB + hstep + kstep, voffB);
    PG8_WAIT_V(6); PG8_BAR;
    PG8_STAMP();
    for (;;) {
        const bool has_next = S.next(ui + 1, nxt);
        const char* nA = has_next ? (const char*)g.A + (size_t)nxt.pm * tstep : cA; const char* nB = has_next ? (const char*)g.Bt + (size_t)nxt.pn * tstep : cB;
        for (int t = 0; t < nt; t += 2) {
            const bool last = (t == nt - 2);
            const char* a1 = cA + (size_t)(t + 1) * kstep;
            const char* a2 = last ? nA : cA + (size_t)(t + 2) * kstep; const char* b2 = last ? nB : cB + (size_t)(t + 2) * kstep;
            const char* a3 = a2 + kstep; const char* b3 = b2 + kstep;
            if (last && has_next) S.a_ready(nxt);
            PG8_LDB(B0, 0, 0); PG8_SCHED; PG8_LDA(At, 0, 0); PG8_STAGE(PG8_SA(1, 1), a1 + hstep, voffA);
            PG8_WAIT_L(8); PG8_BAR; PG8_WAIT_L(0); PG8_MMA(0, 0, At, B0); PG8_BAR; PG8_SCHED;
            PG8_LDB(B1, 0, 1); PG8_STAGE(PG8_SB(0, 0), b2, voffB);
            PG8_BAR; PG8_WAIT_L(0); PG8_MMA(0, 1, At, B1); PG8_BAR;
            PG8_LDA(At, 0, 1); PG8_STAGE(PG8_SA(0, 0), a2, voffA);
            PG8_BAR; PG8_WAIT_L(0); PG8_MMA(1, 0, At, B0); PG8_BAR; PG8_SCHED;
            PG8_STAGE(PG8_SB(0, 1), b2 + hstep, voffB);
            PG8_WAIT_V(6); PG8_BAR; PG8_MMA(1, 1, At, B1); PG8_BAR;
            PG8_LDB(B0, 1, 0); PG8_SCHED; PG8_LDA(At, 1, 0); PG8_STAGE(PG8_SA(0, 1), a2 + hstep, voffA);
            PG8_WAIT_L(8); PG8_BAR; PG8_WAIT_L(0); PG8_MMA(0, 0, At, B0); PG8_BAR; PG8_SCHED;
            PG8_LDB(B1, 1, 1); PG8_STAGE(PG8_SB(1, 0), b3, voffB);
            PG8_BAR; PG8_WAIT_L(0); PG8_MMA(0, 1, At, B1); PG8_BAR;
            PG8_LDA(At, 1, 1); PG8_STAGE(PG8_SA(1, 0), a3, voffA);
            PG8_BAR; PG8_WAIT_L(0); PG8_MMA(1, 0, At, B0); PG8_BAR; PG8_SCHED;
            PG8_STAGE(PG8_SB(1, 1), b3 + hstep, voffB);
            PG8_WAIT_V(6); PG8_BAR; PG8_MMA(1, 1, At, B1); PG8_BAR;
        }
        PG8_STAMP();
        if constexpr (!Epi::AFTER_DRAIN) { E(acc, cur, wr, wc, fr, fq); S.done(cur); }
        PG8_STAMP();
        if (!has_next) break;
#pragma unroll
        for (int a = 0; a < 2; ++a)
#pragma unroll
            for (int b = 0; b < 2; ++b)
#pragma unroll
                for (int m = 0; m < 4; ++m)
#pragma unroll
                    for (int n = 0; n < 2; ++n) acc[a][b][m][n] = (f32x4){0.f, 0.f, 0.f, 0.f};
        cur = nxt; cA = nA; cB = nB; ++ui;
    }
    PG8_WAIT_V(0);
    if (wr == 0) PG8_BAR;
    PG8_BAR;
    if constexpr (Epi::AFTER_DRAIN) { E.fused(acc, cur, wr, wc, fr, fq, lds, wid, lane); S.done(cur); }
    PG8_STAMP();
    if (STAMP && wid == 0) { stamps[lane] = lane < nts ? (((unsigned long long)(unsigned)ts_hi << 32) | (unsigned)ts_lo) : 0ull;
        if (lane == 62) stamps[62] = rt_entry; if (lane == 63) stamps[63] = (unsigned long long)wall_clock64(); }
#undef PG8_STAMP
#undef PG8_SA
#undef PG8_SB
#undef PG8_STAGE
#undef PG8_LDA
#undef PG8_LDB
#undef PG8_MMA
#undef PG8_WAIT_V
#undef PG8_WAIT_L
#undef PG8_BAR
#undef PG8_SCHED
}
}
#define XB_TMO      128
#define XB_XCNT(j)  (256  + 64 * (j))
#define XB_XSUB(j)  (1280 + 64 * (j))
#define XB_XGEN(j)  (2304 + 64 * (j))
#define XB_TOP      3328
#define XB_TOPGEN   3392
#define XCD_BAR_WORDS 3456
#define XB_SPIN_CAP (1u << 22)
#define LAS __attribute__((address_space(3)))

__device__ __forceinline__ unsigned xb_ld(unsigned* p)              { return __hip_atomic_load(p, __ATOMIC_RELAXED, __HIP_MEMORY_SCOPE_AGENT); }
__device__ __forceinline__ unsigned xb_add(unsigned* p, unsigned v) { return __hip_atomic_fetch_add(p, v, __ATOMIC_RELAXED, __HIP_MEMORY_SCOPE_AGENT); }
__device__ __forceinline__ unsigned xb_xcc_id() { return (unsigned)__builtin_amdgcn_s_getreg((3 << 11) | 20) & 0xFu; }
#define XB_SPIN(cond, bar) do { unsigned _sp = 0; while (cond) { __builtin_amdgcn_s_sleep(1); \
    if ((++_sp & 255u) == 0u) { if (xb_ld(&(bar)[XB_TMO])) break; if (_sp > XB_SPIN_CAP) { atomicAdd(&(bar)[XB_TMO], 1u); break; } } } } while (0)

struct XcdBarrier {
    unsigned* bar; unsigned x;
    volatile LAS unsigned* st;
};

__device__ __forceinline__ XcdBarrier xcd_barrier_post(unsigned* bar, volatile LAS unsigned* st) {
    XcdBarrier b; b.bar = bar; b.x = xb_xcc_id(); b.st = st;
    if (threadIdx.x == 0) (void)xb_add(&bar[XB_XCNT(b.x)], 1u);
    return b;
}
__device__ __forceinline__ void xcd_barrier_complete(unsigned* bar, unsigned x, unsigned& nloc, unsigned& nx) {
    const unsigned G = gridDim.x * gridDim.y * gridDim.z;
    unsigned sum, cnt, mine, sp = 0u;
    for (;;) {
        sum = 0u; cnt = 0u; mine = 0u;
#pragma unroll
        for (unsigned j = 0; j < 16; ++j) { const unsigned c = xb_ld(&bar[XB_XCNT(j)]); sum += c; cnt += (c > 0u) ? 1u : 0u; mine = (j == x) ? c : mine; }
        if (sum == G) break;
        __builtin_amdgcn_s_sleep(1);
        if ((++sp & 255u) == 0u) { if (xb_ld(&bar[XB_TMO])) break; if (sp > XB_SPIN_CAP) { atomicAdd(&bar[XB_TMO], 1u); break; } }
    }
    nloc = mine > 0u ? mine : 1u; nx = cnt > 0u ? cnt : 1u;
}

__device__ __forceinline__ void xcd_barrier(const XcdBarrier& b) {
    asm volatile("s_waitcnt vmcnt(0)" ::: "memory");
    __syncthreads();
    if (threadIdx.x == 0) {
        unsigned* bar = b.bar;
        __builtin_amdgcn_s_waitcnt(0);
        unsigned nloc = b.st[0], nx = b.st[1];
        if (nloc == 0u) { xcd_barrier_complete(bar, b.x, nloc, nx); b.st[0] = nloc; b.st[1] = nx; }
        const unsigned old = xb_add(&bar[XB_XSUB(b.x)], 1u);
        const unsigned gen = old / nloc;
        if (old + 1u == (gen + 1u) * nloc) {
            __builtin_amdgcn_fence(__ATOMIC_RELEASE, "agent");
            asm volatile("s_waitcnt vmcnt(0)" ::: "memory");
            const unsigned og = xb_add(&bar[XB_TOP], 1u);
            const unsigned tg = og / nx;
            if (og + 1u == (tg + 1u) * nx) xb_add(&bar[XB_TOPGEN], 1u);
            else XB_SPIN(xb_ld(&bar[XB_TOPGEN]) == tg, bar);
            __builtin_amdgcn_fence(__ATOMIC_ACQUIRE, "agent");
            xb_add(&bar[XB_XGEN(b.x)], 1u);
            asm volatile("s_waitcnt vmcnt(0)" ::: "memory");
        } else {
            XB_SPIN(xb_ld(&bar[XB_XGEN(b.x)]) == gen, bar);
            __builtin_amdgcn_fence(__ATOMIC_ACQUIRE, "agent");
            asm volatile("s_waitcnt vmcnt(0)" ::: "memory");
        }
    }
    __syncthreads();
}
namespace att {
using bf16 = unsigned short;
constexpr int   D = 128, NW = 8, QBLK = 32, KVBLK = 64;
constexpr float SCALE = 0.088388347648318440f;
constexpr float THR = 8.f;
constexpr int SDEPTH = 2;
constexpr int LDQ = 16512, LDK = 16512, LDO = 4096;
constexpr size_t SHM_V = KVBLK * D * 2, SHM_K = KVBLK * D * 2, SHM_ATTN = 2 * SHM_V + 2 * SHM_K + NW * 64 * 4;
using bf16x8 = __attribute__((ext_vector_type(8))) short;
using s16x4  = __attribute__((ext_vector_type(4))) short;
using f32x16 = __attribute__((ext_vector_type(16))) float;
using f32x8  = __attribute__((ext_vector_type(8))) float;
using u32x4  = __attribute__((ext_vector_type(4))) unsigned;
#define KSWZ(row, colB) ((row) * 256 + ((colB) ^ (((row) & 7) << 4)))
#define SBAR() __builtin_amdgcn_sched_barrier(0)
__device__ __forceinline__ int crow(int r, int hi) { return (r & 3) + 8 * (r >> 2) + 4 * hi; }
__device__ __forceinline__ unsigned cvtpk(float lo, float hi) {
  unsigned r; asm volatile("v_cvt_pk_bf16_f32 %0, %1, %2" : "=v"(r) : "v"(lo), "v"(hi)); return r;
}
template <typename TIn> struct Stage;
template <> struct Stage<bf16>  { using T = bf16x8;
  __device__ static __forceinline__ T ld8(const bf16* p) { return *reinterpret_cast<const bf16x8*>(p); }
  __device__ static __forceinline__ bf16x8 tobf(T x) { return x; } };
template <> struct Stage<float> { using T = f32x8;
  __device__ static __forceinline__ T ld8(const float* p) { return *reinterpret_cast<const f32x8*>(p); }
  __device__ static __forceinline__ bf16x8 tobf(T x) {
    u32x4 w = {cvtpk(x[0], x[1]), cvtpk(x[2], x[3]), cvtpk(x[4], x[5]), cvtpk(x[6], x[7])}; return *reinterpret_cast<bf16x8*>(&w); } };

__device__ __forceinline__ void partialSM(f32x16& p0, f32x16& p1, float& m_reg, float& mn, float& alpha) {
  constexpr float C = SCALE * 1.4426950408889634f;
  float pmax = p0[0]; for (int r = 1; r < 16; ++r) pmax = fmaxf(pmax, p0[r]); for (int r = 0; r < 16; ++r) pmax = fmaxf(pmax, p1[r]);
  { auto rr = __builtin_amdgcn_permlane32_swap(__float_as_uint(pmax), __float_as_uint(pmax), false, false);
    pmax = fmaxf(__uint_as_float(rr[0]), __uint_as_float(rr[1])); }
  if (__builtin_expect(__all(pmax - m_reg <= THR / SCALE), 1)) { mn = m_reg; alpha = 1.f; }
  else { mn = fmaxf(m_reg, pmax); alpha = __builtin_amdgcn_exp2f((m_reg - mn) * C); m_reg = mn; }
  float mnC = -mn * C;
  for (int r = 0; r < 16; ++r) p0[r] = fmaf(p0[r], C, mnC); for (int r = 0; r < 16; ++r) p1[r] = fmaf(p1[r], C, mnC);
  for (int r = 0; r < 16; ++r) p0[r] = __builtin_amdgcn_exp2f(p0[r]);
}
__device__ __forceinline__ void finishSM(f32x16& p0, f32x16& p1, float alpha, float& l_reg, bf16x8& pa0, bf16x8& pa1, bf16x8& pa2, bf16x8& pa3) {
  for (int r = 0; r < 16; ++r) p1[r] = __builtin_amdgcn_exp2f(p1[r]);
  float ps = 0; for (int r = 0; r < 16; ++r) ps += p0[r]; for (int r = 0; r < 16; ++r) ps += p1[r];
  { auto rr = __builtin_amdgcn_permlane32_swap(__float_as_uint(ps), __float_as_uint(ps), false, false);
    ps = __uint_as_float(rr[0]) + __uint_as_float(rr[1]); }
  l_reg = l_reg * alpha + ps;
#define PK4(P, BASE, OUT) do { unsigned a0 = cvtpk(P[BASE + 0], P[BASE + 1]), a1 = cvtpk(P[BASE + 2], P[BASE + 3]);   \
    unsigned b0 = cvtpk(P[BASE + 4], P[BASE + 5]), b1 = cvtpk(P[BASE + 6], P[BASE + 7]);                              \
    auto r0 = __builtin_amdgcn_permlane32_swap(a0, b0, false, false); auto r1 = __builtin_amdgcn_permlane32_swap(a1, b1, false, false); \
    u32x4 w = {r0[0], r1[0], r0[1], r1[1]}; OUT = *reinterpret_cast<bf16x8*>(&w); } while (0)
  PK4(p0, 0, pa0); PK4(p0, 8, pa1); PK4(p1, 0, pa2); PK4(p1, 8, pa3);
#undef PK4
}
__device__ __forceinline__ void qkt(f32x16& p0, f32x16& p1, const bf16* Ks, const bf16x8* qr, int r32, int hi) {
  p0 = f32x16{}; p1 = f32x16{};
  for (int d0 = 0; d0 < 8; ++d0) { int cb = (d0 * 16 + hi * 8) * 2;
    bf16x8 b0 = *reinterpret_cast<const bf16x8*>((const char*)Ks + KSWZ(r32, cb));
    bf16x8 b1 = *reinterpret_cast<const bf16x8*>((const char*)Ks + KSWZ(32 + r32, cb));
    p0 = __builtin_amdgcn_mfma_f32_32x32x16_bf16(b0, qr[d0], p0, 0, 0, 0);
    p1 = __builtin_amdgcn_mfma_f32_32x32x16_bf16(b1, qr[d0], p1, 0, 0, 0); }
}
__device__ __forceinline__ int v_st(int k, int c) { const int kk = (k & ~0xC) | ((k & 4) << 1) | ((k & 8) >> 1); return ((kk >> 3) * 4 + (c >> 5)) * 512 + ((kk & 7) * 32 + (c & 31)) * 2; }
__device__ __forceinline__ int v_rd_base(int lane) { return ((lane & 3) << 3) | (((lane >> 2) & 3) << 6) | (((lane >> 4) & 1) << 5) | (((lane >> 5) & 1) << 8); }
constexpr int v_rd_off(int d0, int ks, int half) { return d0 * 512 + ks * 4096 + half * 2048; }
template <int OFF> __device__ __forceinline__ s16x4 tr_read(int vb) {
  s16x4 r; asm volatile("ds_read_b64_tr_b16 %0, %1 offset:%2" : "=&v"(r) : "v"(vb), "i"(OFF) : "memory"); return r;
}
template <int D0> __device__ __forceinline__ void pv_one(f32x16& od, int vb, bf16x8 pa0, bf16x8 pa1, bf16x8 pa2, bf16x8 pa3) {
  const s16x4 l0 = tr_read<v_rd_off(D0, 0, 0)>(vb), h0 = tr_read<v_rd_off(D0, 0, 1)>(vb), l1 = tr_read<v_rd_off(D0, 1, 0)>(vb), h1 = tr_read<v_rd_off(D0, 1, 1)>(vb);
  const s16x4 l2 = tr_read<v_rd_off(D0, 2, 0)>(vb), h2 = tr_read<v_rd_off(D0, 2, 1)>(vb), l3 = tr_read<v_rd_off(D0, 3, 0)>(vb), h3 = tr_read<v_rd_off(D0, 3, 1)>(vb);
  asm volatile("s_waitcnt lgkmcnt(0)" ::: "memory"); SBAR();
#define PK(L, H) (bf16x8){L[0], L[1], L[2], L[3], H[0], H[1], H[2], H[3]}
  od = __builtin_amdgcn_mfma_f32_32x32x16_bf16(pa0, PK(l0, h0), od, 0, 0, 0);
  od = __builtin_amdgcn_mfma_f32_32x32x16_bf16(pa1, PK(l1, h1), od, 0, 0, 0);
  od = __builtin_amdgcn_mfma_f32_32x32x16_bf16(pa2, PK(l2, h2), od, 0, 0, 0);
  od = __builtin_amdgcn_mfma_f32_32x32x16_bf16(pa3, PK(l3, h3), od, 0, 0, 0);
#undef PK
}
__device__ __forceinline__ void pv_d0(f32x16* o, int vb, bf16x8 pa0, bf16x8 pa1, bf16x8 pa2, bf16x8 pa3) {
  pv_one<0>(o[0], vb, pa0, pa1, pa2, pa3); pv_one<1>(o[1], vb, pa0, pa1, pa2, pa3); pv_one<2>(o[2], vb, pa0, pa1, pa2, pa3); pv_one<3>(o[3], vb, pa0, pa1, pa2, pa3);
}

template <typename TQ>
__device__ __forceinline__ void attn_dense_body(const TQ* __restrict__ Qb, const bf16* __restrict__ Kh, const bf16* __restrict__ Vh,
                                                bf16* __restrict__ Ob, int seq, char* lds) {
  using St = Stage<bf16>; using SQ = Stage<TQ>;
  const int tid = ltid(), wid = tid >> 6, lane = tid & 63, r32 = lane & 31, hi = lane >> 5;
  bf16* V_lds = (bf16*)lds; bf16* K_lds = (bf16*)(lds + 2 * SHM_V);
  float* ws = (float*)(lds + 2 * SHM_V + 2 * SHM_K) + wid * 64; float* li_l = ws; float* al_l = ws + 32;
  float m_reg = -1e30f, l_reg = 0; f32x16 o[4] = {}; bf16x8 qr[8];
  const TQ* Qw = Qb + (long)(wid * QBLK + r32) * LDQ + hi * 8;
#pragma unroll
  for (int d0 = 0; d0 < 8; ++d0) qr[d0] = SQ::tobf(SQ::ld8(Qw + d0 * 16));
  const int sr = tid >> 4, sc = (tid & 15) * 8, vst0 = v_st(sr, sc), vst1 = v_st(32 + sr, sc);
  const int vb0 = (int)(uintptr_t)V_lds + v_rd_base(lane);
  struct { typename St::T vs0, vs1, ks0, ks1; } sr_[SDEPTH];
#define SLOAD(i, k0) do { sr_[i].vs0 = St::ld8(&Vh[(long)((k0) + sr) * LDK + sc]); sr_[i].vs1 = St::ld8(&Vh[(long)((k0) + 32 + sr) * LDK + sc]); \
    sr_[i].ks0 = St::ld8(&Kh[(long)((k0) + sr) * LDK + sc]); sr_[i].ks1 = St::ld8(&Kh[(long)((k0) + 32 + sr) * LDK + sc]); } while (0)
#define SWRITE(b, i) do { *(bf16x8*)((char*)V_lds + (b) * SHM_V + vst0) = St::tobf(sr_[i].vs0);          \
    *(bf16x8*)((char*)V_lds + (b) * SHM_V + vst1) = St::tobf(sr_[i].vs1); int kc = sc * 2;               \
    *(bf16x8*)((char*)K_lds + (b) * SHM_K + KSWZ(sr, kc)) = St::tobf(sr_[i].ks0);                       \
    *(bf16x8*)((char*)K_lds + (b) * SHM_K + KSWZ(32 + sr, kc)) = St::tobf(sr_[i].ks1); } while (0)
#define SWAIT() do { if constexpr (SDEPTH == 2) asm volatile("s_waitcnt vmcnt(4)" ::: "memory"); else asm volatile("s_waitcnt vmcnt(0)" ::: "memory"); } while (0)
#define RESC(a) do { if (__any((a) < 1.f)) { if (hi == 0) al_l[r32] = (a); asm volatile("s_waitcnt lgkmcnt(0)" ::: "memory"); \
    for (int d = 0; d < 4; ++d) for (int r = 0; r < 16; ++r) o[d][r] *= al_l[crow(r, hi)]; } } while (0)
  f32x16 pA0, pA1, pB0, pB1; float mnA, mnB, alA, alB; bf16x8 pa0, pa1, pa2, pa3; const int NT = seq / KVBLK;
  constexpr int SE = 0, SO = SDEPTH - 1;
  SLOAD(SE, 0); asm volatile("s_waitcnt vmcnt(0)" ::: "memory"); SWRITE(0, SE); __syncthreads();
  qkt(pA0, pA1, K_lds, qr, r32, hi); partialSM(pA0, pA1, m_reg, mnA, alA);
  SLOAD(SO, KVBLK); if constexpr (SDEPTH == 2) { if (2 < NT) SLOAD(SE, 2 * KVBLK); }
  SWAIT(); SWRITE(1, SO); __syncthreads();
  for (int j = 1; j + 1 < NT; j += 2) {
    SBAR(); qkt(pB0, pB1, (bf16*)((char*)K_lds + SHM_K), qr, r32, hi);
    finishSM(pA0, pA1, alA, l_reg, pa0, pa1, pa2, pa3); SBAR();
    SLOAD(SO, (j + SDEPTH) * KVBLK); SBAR();
    pv_d0(o, vb0, pa0, pa1, pa2, pa3); partialSM(pB0, pB1, m_reg, mnB, alB);
    __syncthreads(); SWAIT(); SWRITE(0, SE);
    RESC(alB); __syncthreads();
    SBAR(); qkt(pA0, pA1, K_lds, qr, r32, hi);
    finishSM(pB0, pB1, alB, l_reg, pa0, pa1, pa2, pa3); SBAR();
    if (SDEPTH == 1 || j + 3 < NT) SLOAD(SE, (j + 1 + SDEPTH) * KVBLK); SBAR();
    pv_d0(o, vb0 + (int)SHM_V, pa0, pa1, pa2, pa3); partialSM(pA0, pA1, m_reg, mnA, alA);
    __syncthreads(); SWAIT(); SWRITE(1, SO);
    RESC(alA); __syncthreads();
  }
  SBAR(); qkt(pB0, pB1, (bf16*)((char*)K_lds + SHM_K), qr, r32, hi);
  finishSM(pA0, pA1, alA, l_reg, pa0, pa1, pa2, pa3); SBAR();
  pv_d0(o, vb0, pa0, pa1, pa2, pa3); partialSM(pB0, pB1, m_reg, mnB, alB);
  __syncthreads(); RESC(alB);
  finishSM(pB0, pB1, alB, l_reg, pa0, pa1, pa2, pa3); SBAR();
  pv_d0(o, vb0 + (int)SHM_V, pa0, pa1, pa2, pa3);
  if (hi == 0) li_l[r32] = l_reg; asm volatile("s_waitcnt lgkmcnt(0)" ::: "memory");
  float rli[16];
#pragma unroll
  for (int r = 0; r < 16; ++r) rli[r] = __builtin_amdgcn_rcpf(li_l[crow(r, hi)]);
  bf16* Ow = Ob + (long)(wid * QBLK) * LDO;
#pragma unroll
  for (int r = 0; r < 16; ++r) { int orow = crow(r, hi);
    for (int d0 = 0; d0 < 4; ++d0) { const float ov = o[d0][r] * rli[r]; unsigned uu = __float_as_uint(ov); uu += 0x7FFFu + ((uu >> 16) & 1u); Ow[(long)orow * LDO + d0 * 32 + r32] = (bf16)(uu >> 16); } }
#undef SLOAD
#undef SWRITE
#undef SWAIT
#undef RESC
}
}

#ifndef PHM
#define PHM 255
#endif
namespace mk {
__device__ const double INVD[64] = {1,0.86596432336006535,0.74989420933245587,0.64938163157621132,0.56234132519034907,0.48696752516586311,0.42169650342858223,0.36517412725483772,0.31622776601683794,0.27384196342643613,0.23713737056616552,0.20535250264571461,0.17782794100389229,0.15399265260594919,0.1333521432163324,0.11547819846894582,0.10000000000000001,0.086596432336006529,0.074989420933245579,0.064938163157621132,0.056234132519034911,0.048696752516586311,0.042169650342858224,0.036517412725483769,0.031622776601683791,0.027384196342643614,0.023713737056616554,0.02053525026457146,0.017782794100389229,0.015399265260594919,0.013335214321633241,0.011547819846894581,0.01,0.0086596432336006543,0.0074989420933245579,0.006493816315762113,0.005623413251903491,0.004869675251658631,0.0042169650342858229,0.0036517412725483771,0.0031622776601683794,0.0027384196342643613,0.0023713737056616554,0.002053525026457146,0.0017782794100389228,0.001539926526059492,0.0013335214321633241,0.0011547819846894581,0.001,0.00086596432336006539,0.00074989420933245586,0.00064938163157621134,0.0005623413251903491,0.0004869675251658631,0.00042169650342858224,0.0003651741272548377,0.00031622776601683794,0.00027384196342643611,0.00023713737056616554,0.00020535250264571461,0.00017782794100389227,0.00015399265260594919,0.0001333521432163324,0.00011547819846894582};
typedef unsigned short bf16_t;
typedef float f32x4 __attribute__((ext_vector_type(4)));
typedef unsigned u32x4 __attribute__((ext_vector_type(4)));
typedef unsigned u32x2 __attribute__((ext_vector_type(2)));
typedef float f32x2 __attribute__((ext_vector_type(2)));
constexpr int DM = 4096, NPROJ = 16384, LDP = 16512  , DFF = 16384, MH = 16384, MC = 16384;
constexpr size_t MiB = 1ull << 20;
constexpr size_t WS_CTL = 0, WS_WIN = 1 * MiB, WS_WOUT = WS_WIN + 128 * MiB, WS_WUP = WS_WOUT + 32 * MiB, WS_WDN = WS_WUP + 128 * MiB,
                 WS_HB = WS_WDN + 128 * MiB, WS_PROJ = WS_HB + 128 * MiB, WS_OB = WS_PROJ + 520 * MiB, WS_ST = WS_OB + 128 * MiB,
                 WS_PD = WS_ST + 128 * MiB, WS_END = WS_PD + 1 * MiB;
constexpr int LDS_BAR_OFF = 135168, LDS_BYTES = 135168 + 64;
constexpr float EPS = 1e-6f;

__device__ __forceinline__ float bf2f(unsigned b) { return __uint_as_float(b << 16); }
__device__ __forceinline__ float bflo(unsigned w) { return __uint_as_float(w << 16); }
__device__ __forceinline__ float bfhi(unsigned w) { return __uint_as_float(w & 0xffff0000u); }
__device__ __forceinline__ unsigned short f2bf(float f) { unsigned u = __float_as_uint(f); u += 0x7FFFu + ((u >> 16) & 1u); return (unsigned short)(u >> 16); }
__device__ __forceinline__ unsigned pk(float lo, float hi) { return pg8::cvt_pk_bf16(lo, hi); }

template <int ACT> struct EpiB {
    static constexpr bool PERM = true, AFTER_DRAIN = false;
    bf16_t* O; int ldc;
    __device__ __forceinline__ void operator()(const pg8::f32x4 (&acc)[2][2][4][2], const pg8::Unit& u, int wr, int wc, int fr, int fq) const {
        const int row0 = u.pm * 256 + wr * 64 + fr, col0 = u.pn * 256 + wc * 32 + 8 * fq;
#pragma unroll
        for (int ai = 0; ai < 2; ++ai)
#pragma unroll
            for (int m = 0; m < 4; ++m) { bf16_t* rowp = O + (size_t)(row0 + ai * 128 + m * 16) * ldc + col0;
#pragma unroll
                for (int bj = 0; bj < 2; ++bj) { pg8::f32x4 v0 = acc[ai][bj][m][0], v1 = acc[ai][bj][m][1];
                    if (ACT == 1) {
#pragma unroll
                        for (int j = 0; j < 4; ++j) { const float a = fmaxf(v0[j], 0.f), b = fmaxf(v1[j], 0.f); v0[j] = a * a; v1[j] = b * b; } }
                    pg8::u32x4 w; w.x = pk(v0[0], v0[1]); w.y = pk(v0[2], v0[3]); w.z = pk(v1[0], v1[1]); w.w = pk(v1[2], v1[3]);
                    *(pg8::u32x4*)(rowp + bj * 128) = w; } }
    }
};

struct EpiProjRope {
    static constexpr bool PERM = true, AFTER_DRAIN = false;
    bf16_t* O; int ldc; int Lmask;
    __device__ __forceinline__ void operator()(const pg8::f32x4 (&acc)[2][2][4][2], const pg8::Unit& u, int wr, int wc, int fr, int fq) const {
        const int row0 = u.pm * 256 + wr * 64 + fr;
        if (u.pn >= 16) { const int col0 = u.pn * 256 + wc * 32 + 8 * fq;
#pragma unroll
            for (int ai = 0; ai < 2; ++ai)
#pragma unroll
                for (int m = 0; m < 4; ++m) { bf16_t* rowp = O + (size_t)(row0 + ai * 128 + m * 16) * ldc + col0;
#pragma unroll
                    for (int bj = 0; bj < 2; ++bj) { const pg8::f32x4 v0 = acc[ai][bj][m][0], v1 = acc[ai][bj][m][1];
                        pg8::u32x4 w; w.x = pk(v0[0], v0[1]); w.y = pk(v0[2], v0[3]); w.z = pk(v1[0], v1[1]); w.w = pk(v1[2], v1[3]);
                        *(pg8::u32x4*)(rowp + bj * 128) = w; } }
        } else { const int d0 = 16 * wc + 4 * fq; double iv[4];
#pragma unroll
            for (int e = 0; e < 4; ++e) iv[e] = INVD[d0 + e] * 0.15915494309189533577;
#pragma unroll
            for (int ai = 0; ai < 2; ++ai)
#pragma unroll
                for (int m = 0; m < 4; ++m) { const int row = row0 + ai * 128 + m * 16; const int pos = row & Lmask; float c[4], sn[4];
#pragma unroll
                    for (int e = 0; e < 4; ++e) { double a = (double)pos * iv[e]; a -= __builtin_rint(a); const float f = (float)a; c[e] = __builtin_amdgcn_cosf(f); sn[e] = __builtin_amdgcn_sinf(f); }
                    bf16_t* rowp = O + (size_t)row * ldc + u.pn * 256 + d0;
#pragma unroll
                    for (int bj = 0; bj < 2; ++bj) { const pg8::f32x4 v0 = acc[ai][bj][m][0], v1 = acc[ai][bj][m][1]; float lo[4], hi[4];
#pragma unroll
                        for (int e = 0; e < 4; ++e) { lo[e] = v0[e] * c[e] - v1[e] * sn[e]; hi[e] = v1[e] * c[e] + v0[e] * sn[e]; }
                        u32x2 wl, wh; wl.x = pk(lo[0], lo[1]); wl.y = pk(lo[2], lo[3]); wh.x = pk(hi[0], hi[1]); wh.y = pk(hi[2], hi[3]);
                        *(u32x2*)(rowp + bj * 128) = wl; *(u32x2*)(rowp + bj * 128 + 64) = wh; } }
        }
    }
};
struct EpiRes {
    static constexpr bool PERM = false, AFTER_DRAIN = false;
    const float* base; float* C; int ldc;
    __device__ __forceinline__ void operator()(const pg8::f32x4 (&acc)[2][2][4][2], const pg8::Unit& u, int wr, int wc, int fr, int fq) const {
        const int row0 = u.pm * 256 + wr * 64 + fr, col0 = u.pn * 256 + wc * 32 + 4 * fq;
#pragma unroll
        for (int ai = 0; ai < 2; ++ai)
#pragma unroll
            for (int m = 0; m < 4; ++m) { const size_t off = (size_t)(row0 + ai * 128 + m * 16) * ldc + col0;
#pragma unroll
                for (int bj = 0; bj < 2; ++bj)
#pragma unroll
                    for (int n = 0; n < 2; ++n) { const pg8::f32x4 b = *(const pg8::f32x4*)(base + off + bj * 128 + n * 16);
                        *(pg8::f32x4*)(C + off + bj * 128 + n * 16) = acc[ai][bj][m][n] + b; } }
    }
};


struct EpiResNorm {
    static constexpr bool PERM = false, AFTER_DRAIN = false;
    const float* base; float* C; int ldc; bf16_t* H2; const float* wn; float* ssq;
    __device__ __forceinline__ void operator()(const pg8::f32x4 (&acc)[2][2][4][2], const pg8::Unit& u, int wr, int wc, int fr, int fq) const {
        const int row0 = u.pm * 256 + wr * 64 + fr, col0 = u.pn * 256 + wc * 32 + 4 * fq;
        pg8::f32x4 wv[2][2];
#pragma unroll
        for (int bj = 0; bj < 2; ++bj)
#pragma unroll
            for (int n = 0; n < 2; ++n) wv[bj][n] = *(const pg8::f32x4*)(wn + col0 + bj * 128 + n * 16);
#pragma unroll
        for (int ai = 0; ai < 2; ++ai)
#pragma unroll
            for (int m = 0; m < 4; ++m) { const int row = row0 + ai * 128 + m * 16; const size_t off = (size_t)row * ldc + col0; float ss = 0.f;
#pragma unroll
                for (int bj = 0; bj < 2; ++bj)
#pragma unroll
                    for (int n = 0; n < 2; ++n) { const pg8::f32x4 b = *(const pg8::f32x4*)(base + off + bj * 128 + n * 16); const pg8::f32x4 v = acc[ai][bj][m][n] + b;
                        *(pg8::f32x4*)(C + off + bj * 128 + n * 16) = v; ss += v[0] * v[0] + v[1] * v[1] + v[2] * v[2] + v[3] * v[3];
                        const pg8::f32x4 y = v * wv[bj][n]; u32x2 o2; o2.x = pk(y[0], y[1]); o2.y = pk(y[2], y[3]); *(u32x2*)(H2 + off + bj * 128 + n * 16) = o2; }
                ss += __shfl_xor(ss, 16); ss += __shfl_xor(ss, 32);
                if (fq == 0) atomicAdd(ssq + row, ss); }
    }
};
struct EpiResScale {
    static constexpr bool PERM = false, AFTER_DRAIN = false;
    float* C; int ldc; const float* ssq;
    __device__ __forceinline__ void operator()(const pg8::f32x4 (&acc)[2][2][4][2], const pg8::Unit& u, int wr, int wc, int fr, int fq) const {
        const int row0 = u.pm * 256 + wr * 64 + fr, col0 = u.pn * 256 + wc * 32 + 4 * fq;
#pragma unroll
        for (int ai = 0; ai < 2; ++ai)
#pragma unroll
            for (int m = 0; m < 4; ++m) { const int row = row0 + ai * 128 + m * 16; const size_t off = (size_t)row * ldc + col0;
                const float sc = 1.0f / (__hip_atomic_load(ssq + row, __ATOMIC_RELAXED, __HIP_MEMORY_SCOPE_AGENT) * (1.0f / DM) + EPS);
#pragma unroll
                for (int bj = 0; bj < 2; ++bj)
#pragma unroll
                    for (int n = 0; n < 2; ++n) { const pg8::f32x4 b = *(const pg8::f32x4*)(C + off + bj * 128 + n * 16);
                        *(pg8::f32x4*)(C + off + bj * 128 + n * 16) = b + acc[ai][bj][m][n] * sc; } }
    }
};

__device__ __forceinline__ void transpose_cvt(const float* __restrict__ W, bf16_t* __restrict__ Wt, int K, int N, float* tile, int bid, int nb, bool rperm) {
    const int tid = ltid(); const int ntn = N / 64, nt = (K / 64) * ntn;
    f32x4 pv[2];
#define TLOAD(t_) do { const int tn_ = (t_) % ntn, tk_ = (t_) / ntn; const float* src_ = W + (size_t)(tk_ * 64) * N + tn_ * 64; \
        _Pragma("unroll") for (int i = 0; i < 2; ++i) pv[i] = *(const f32x4*)(src_ + (size_t)((tid >> 4) + i * 32) * N + (tid & 15) * 4); } while (0)
    if (bid < nt) TLOAD(bid);
    for (int t = bid; t < nt; t += nb) {
        const int tn = t % ntn, tk = t / ntn;
#pragma unroll
        for (int i = 0; i < 2; ++i) { const int r = (tid >> 4) + i * 32, c = (tid & 15) * 4;
            tile[r * 65 + c] = pv[i][0]; tile[r * 65 + c + 1] = pv[i][1]; tile[r * 65 + c + 2] = pv[i][2]; tile[r * 65 + c + 3] = pv[i][3]; }
        __syncthreads();
        if (t + nb < nt) TLOAD(t + nb);
        const int n = tid >> 3, k8 = (tid & 7) * 8; float v[8];
#pragma unroll
        for (int i = 0; i < 8; ++i) v[i] = tile[(k8 + i) * 65 + n];
        u32x4 w; w.x = pk(v[0], v[1]); w.y = pk(v[2], v[3]); w.z = pk(v[4], v[5]); w.w = pk(v[6], v[7]);
        int orow = tn * 64 + n;
        if (rperm && orow < 4096) { const int V = orow >> 7, d = orow & 127; const int r = (d < 64) ? ((d >> 2) * 8 + (d & 3)) : (((d - 64) >> 2) * 8 + 4 + ((d - 64) & 3)); orow = V * 128 + r; }
        *(u32x4*)(Wt + (size_t)orow * K + tk * 64 + k8) = w;
        __syncthreads();
    }
#undef TLOAD
}

template <bool OUT_BF16>
__device__ __forceinline__ void rmsnorm_rows(const float* X, const float* __restrict__ w, void* out, int rows, int bid, int nb) {
    const int tid_ = ltid(); const int lane = tid_ & 63, wid = tid_ >> 6;
    for (int r = bid * 8 + wid; r < rows; r += nb * 8) {
        const float* x = X + (size_t)r * DM; f32x4 v[16]; float ss = 0.f;
#pragma unroll
        for (int i = 0; i < 16; ++i) { v[i] = *(const f32x4*)(x + i * 256 + lane * 4); ss += v[i][0] * v[i][0] + v[i][1] * v[i][1] + v[i][2] * v[i][2] + v[i][3] * v[i][3]; }
#pragma unroll
        for (int o = 32; o >= 1; o >>= 1) ss += __shfl_xor(ss, o);
        const float rs = rsqrtf(ss * (1.0f / DM) + EPS);
#pragma unroll
        for (int i = 0; i < 16; ++i) { const f32x4 ww = *(const f32x4*)(w + i * 256 + lane * 4); const f32x4 y = v[i] * rs * ww;
            if (OUT_BF16) { u32x2 o2; o2.x = pk(y[0], y[1]); o2.y = pk(y[2], y[3]); *(u32x2*)((bf16_t*)out + (size_t)r * DM + i * 256 + lane * 4) = o2; }
            else *(f32x4*)((float*)out + (size_t)r * DM + i * 256 + lane * 4) = y; }
    }
}

__device__ __forceinline__ void rope_phase(bf16_t* proj, int rows, int L, int bid, int nb) {
    const int tid_ = ltid(); const int lane = tid_ & 63, wid = tid_ >> 6, sub = lane >> 5, d = (lane & 31) * 2;
    const double i2pi = 0.15915494309189533577;
    for (int rp = bid * 8 + wid; rp < rows / 2; rp += nb * 8) {
        const int r = rp * 2 + sub, pos = r & (L - 1);
        double a0 = (double)pos * INVD[d] * i2pi, a1 = (double)pos * INVD[d + 1] * i2pi;
        a0 -= __builtin_rint(a0); a1 -= __builtin_rint(a1);
        const float f0 = (float)a0, f1 = (float)a1;
        const float c0 = __builtin_amdgcn_cosf(f0), s0 = __builtin_amdgcn_sinf(f0), c1 = __builtin_amdgcn_cosf(f1), s1 = __builtin_amdgcn_sinf(f1);
        bf16_t* row = proj + (size_t)r * LDP + d;
#pragma unroll 8
        for (int vct = 0; vct < 32; ++vct) { unsigned* p1 = (unsigned*)(row + vct * 128); unsigned* p2 = (unsigned*)(row + vct * 128 + 64);
            const unsigned w1 = *p1, w2 = *p2; const float x10 = bflo(w1), x11 = bfhi(w1), x20 = bflo(w2), x21 = bfhi(w2);
            *p1 = pk(x10 * c0 - x20 * s0, x11 * c1 - x21 * s1); *p2 = pk(x20 * c0 + x10 * s0, x21 * c1 + x11 * s1); }
    }
}

constexpr int HT = 256, HTB = 16;
template <bool PASS3>
__device__ __forceinline__ void hgrn_pass(bf16_t* proj, const float* __restrict__ hgrn_lb, float* ST, float* PD, int nseq, int L, float* lds, int bid, int nb) {
    const int tid = ltid(), g = tid >> 7, j = tid & 127;
    float* qs = lds + g * (3 * HTB * 128); float* fs = qs + HTB * 128; float* vs = fs + HTB * 128;
    const int NSC = L / HT, nitems = nseq * NSC * 8;
    const int sr = j >> 4, c8 = (j & 15) * 8;
    for (int it = bid; it < nitems; it += nb) {
        const int u = it * 4 + g, dir = u & 1, h = (u >> 1) & 15, sc = (u >> 5) % NSC, s = (u >> 5) / NSC;
        const size_t row0 = (size_t)s * L + (size_t)sc * HT;
        const int colq = 6144 + h * 128, colf = (dir ? 10240 : 8192) + h * 128, colv = 12288 + h * 128;
        float lb[8];
#pragma unroll
        for (int e = 0; e < 8; ++e) { const float a0 = hgrn_lb[dir * 4096 + h * 128 + c8 + e], a1 = hgrn_lb[dir * 4096 + 2048 + h * 128 + c8 + e]; lb[e] = 1.0f / (1.0f + __expf(a1 - a0)); }
        float S[128];
#pragma unroll
        for (int k = 0; k < 128; ++k) S[k] = PASS3 ? ST[(size_t)u * 16384 + k * 128 + j] : 0.f;
        float P = 1.f;
        u32x4 rq[2], rf[2], rv[2];
#define HLOAD(b) do { const size_t rb_ = row0 + (dir ? (HT - HTB * ((b) + 1)) : HTB * (b)); _Pragma("unroll") for (int i = 0; i < 2; ++i) { const bf16_t* p_ = proj + (rb_ + sr + 8 * i) * LDP + c8; \
            if (PASS3) rq[i] = *(const u32x4*)(p_ + colq); rf[i] = *(const u32x4*)(p_ + colf); rv[i] = *(const u32x4*)(p_ + colv); } } while (0)
        HLOAD(0);
        for (int b = 0; b < HT / HTB; ++b) {
            __syncthreads();
#pragma unroll
            for (int i = 0; i < 2; ++i) { const int ro = (sr + 8 * i) * 128 + c8;
#pragma unroll
                for (int e = 0; e < 4; ++e) {
                    const unsigned wf = rf[i][e], wv = rv[i][e];
                    const float f0 = bflo(wf), f1 = bfhi(wf);
                    fs[ro + 2 * e] = lb[2 * e] + (1.f - lb[2 * e]) / (1.f + __expf(-f0)); fs[ro + 2 * e + 1] = lb[2 * e + 1] + (1.f - lb[2 * e + 1]) / (1.f + __expf(-f1));
                    vs[ro + 2 * e] = bflo(wv); vs[ro + 2 * e + 1] = bfhi(wv);
                    if (PASS3) { const unsigned wq = rq[i][e]; const float q0 = bflo(wq), q1 = bfhi(wq); qs[ro + 2 * e] = q0 / (1.f + __expf(-q0)); qs[ro + 2 * e + 1] = q1 / (1.f + __expf(-q1)); }
                } }
            __syncthreads();
            if (b + 1 < HT / HTB) HLOAD(b + 1);
            const size_t rb = row0 + (dir ? (HT - HTB * (b + 1)) : HTB * b);
#pragma unroll 1
            for (int tt = 0; tt < HTB; ++tt) {
                const int t = dir ? (HTB - 1 - tt) : tt;
                const float v = vs[t * 128 + j]; f32x2 o2 = {0.f, 0.f};
#pragma unroll
                for (int k4 = 0; k4 < 32; ++k4) { const f32x4 f4 = *(const f32x4*)(fs + t * 128 + k4 * 4);
#pragma unroll
                    for (int e = 0; e < 4; ++e) S[k4 * 4 + e] = fmaf(f4[e], S[k4 * 4 + e] - v, v);
                    if (PASS3) { const f32x4 q4 = *(const f32x4*)(qs + t * 128 + k4 * 4);
#pragma unroll
                        for (int e = 0; e < 4; e += 2) { const f32x2 qq = {q4[e], q4[e + 1]}, sv = {S[k4 * 4 + e], S[k4 * 4 + e + 1]}; o2 = __builtin_elementwise_fma(qq, sv, o2); } } }
                if (PASS3) proj[(rb + t) * LDP + colf + j] = f2bf(o2[0] + o2[1]);
                else P *= fs[t * 128 + j];
            }
        }
#undef HLOAD
        if (!PASS3) {
#pragma unroll
            for (int k = 0; k < 128; ++k) ST[(size_t)u * 16384 + k * 128 + j] = S[k];
            PD[(size_t)u * 128 + j] = P; }
        __syncthreads();
    }
}

constexpr int LDT = 264;
__device__ __forceinline__ void hgrn_ends(const bf16_t* proj, const float* __restrict__ hgrn_lb, float* ST, float* PD, int nseq, int L, unsigned char* lds, int bid, int nb) {
    const int tid = ltid(), grp = tid >> 7, x = tid & 127, wid = tid >> 6, lane = tid & 63, fr = lane & 15, fq = lane >> 4;
    bf16_t* wT = (bf16_t*)lds; bf16_t* vT = (bf16_t*)(lds + 128 * LDT * 2);
    const int NSC = L / HT, nunits = nseq * NSC * 32;
    for (int u = bid; u < nunits; u += nb) {
        const int dir = u & 1, h = (u >> 1) & 15, sc = (u >> 5) % NSC, s = (u >> 5) / NSC;
        const size_t row0 = (size_t)s * L + (size_t)sc * HT;
        if (grp == 0) {
            const bf16_t* pf = proj + row0 * LDP + (dir ? 10240 : 8192) + h * 128 + x;
            const float a0 = hgrn_lb[dir * 4096 + h * 128 + x], a1 = hgrn_lb[dir * 4096 + 2048 + h * 128 + x]; const float lb = __builtin_amdgcn_rcpf(1.0f + __expf(a1 - a0));
            float R = 1.f; unsigned short raw[32], nxt[32];
#pragma unroll
            for (int i = 0; i < 32; ++i) { const int t = dir ? i : 255 - i; raw[i] = pf[(size_t)t * LDP]; }
#pragma unroll 1
            for (int tb = 0; tb < 8; ++tb) {
                if (tb < 7) {
#pragma unroll
                    for (int i = 0; i < 32; ++i) { const int t = dir ? (tb + 1) * 32 + i : 255 - ((tb + 1) * 32 + i); nxt[i] = pf[(size_t)t * LDP]; } }
#pragma unroll
                for (int i = 0; i < 32; ++i) { const int t = dir ? tb * 32 + i : 255 - (tb * 32 + i);
                    const float fraw = bf2f(raw[i]); const float f = lb + (1.f - lb) * __builtin_amdgcn_rcpf(1.f + __expf(-fraw));
                    wT[x * LDT + t] = f2bf((1.f - f) * R); R *= f; }
#pragma unroll
                for (int i = 0; i < 32; ++i) raw[i] = nxt[i];
            }
            PD[(size_t)u * 128 + x] = R;
        } else if (grp < 3) {
            const bf16_t* pv = proj + (row0 + (size_t)(grp - 1) * 128) * LDP + 12288 + h * 128 + x; bf16_t* dst = vT + x * LDT + (grp - 1) * 128;
#pragma unroll 1
            for (int tb = 0; tb < 4; ++tb) { unsigned short raw[32];
#pragma unroll
                for (int i = 0; i < 32; ++i) raw[i] = pv[(size_t)(tb * 32 + i) * LDP];
#pragma unroll
                for (int i = 0; i < 32; i += 2) *(unsigned*)(dst + tb * 32 + i) = (unsigned)raw[i] | ((unsigned)raw[i + 1] << 16); }
        }
        __syncthreads();
        pg8::f32x4 acc[8];
#pragma unroll
        for (int jb = 0; jb < 8; ++jb) acc[jb] = (pg8::f32x4){0.f, 0.f, 0.f, 0.f};
#pragma unroll
        for (int ks = 0; ks < 8; ++ks) { const pg8::bf16x8 a = *(const pg8::bf16x8*)(wT + (wid * 16 + fr) * LDT + ks * 32 + fq * 8);
#pragma unroll
            for (int jb = 0; jb < 8; ++jb) { const pg8::bf16x8 b = *(const pg8::bf16x8*)(vT + (jb * 16 + fr) * LDT + ks * 32 + fq * 8);
                acc[jb] = __builtin_amdgcn_mfma_f32_16x16x32_bf16(a, b, acc[jb], 0, 0, 0); } }
        float* st = ST + (size_t)u * 16384;
#pragma unroll
        for (int jb = 0; jb < 8; ++jb)
#pragma unroll
            for (int i = 0; i < 4; ++i) st[(wid * 16 + fq * 4 + i) * 128 + jb * 16 + fr] = acc[jb][i];
        __syncthreads();
    }
}

__device__ __forceinline__ void hgrn_out(bf16_t* proj, const float* __restrict__ hgrn_lb, const float* ST, int nseq, int L, unsigned char* lds, int bid, int nb) {
    const int tid = ltid(), wid = tid >> 6, lane = tid & 63, fr = lane & 15, fq = lane >> 4, x = tid & 127, role = tid >> 7;
    bf16_t* QD = (bf16_t*)lds; bf16_t* KD = QD + 32 * 136; bf16_t* KE = KD + 32 * 136; bf16_t* VT = KE + 128 * 40; bf16_t* SB = VT + 128 * 40; bf16_t* AM = SB + 128 * 136; float* DC = (float*)(AM + 32 * 40);
    const int NSC = L / HT, nunits = nseq * NSC * 32;
    for (int u = bid; u < nunits; u += nb) {
        const int dir = u & 1, h = (u >> 1) & 15, sc = (u >> 5) % NSC, s = (u >> 5) / NSC;
        const size_t row0 = (size_t)s * L + (size_t)sc * HT;
        const int colq = 6144 + h * 128, colf = (dir ? 10240 : 8192) + h * 128, colv = 12288 + h * 128;
        pg8::f32x4 Sacc[8];
        { const float* st = ST + (size_t)u * 16384;
#pragma unroll
          for (int jb = 0; jb < 8; ++jb)
#pragma unroll
              for (int r = 0; r < 4; ++r) Sacc[jb][r] = st[(wid * 16 + fq * 4 + r) * 128 + jb * 16 + fr]; }
        float lb = 0.f;
        if (role == 0) { const float a0 = hgrn_lb[dir * 4096 + h * 128 + x], a1 = hgrn_lb[dir * 4096 + 2048 + h * 128 + x]; lb = __builtin_amdgcn_rcpf(1.0f + __expf(a1 - a0)); }
        unsigned short ra[32], rb[32];
#define PLOAD(cc_) do { if (role == 0) { _Pragma("unroll") for (int i = 0; i < 32; ++i) { const int tt_ = (cc_) * 32 + i; const bf16_t* p_ = proj + (row0 + (dir ? 255 - tt_ : tt_)) * LDP + x; ra[i] = p_[colf]; rb[i] = p_[colq]; } } \
        else if (role == 1) { _Pragma("unroll") for (int i = 0; i < 32; ++i) { const int tt_ = (cc_) * 32 + i; ra[i] = proj[(row0 + (dir ? 255 - tt_ : tt_)) * LDP + colv + x]; } } } while (0)
        PLOAD(0);
#define SBWRITE() do { _Pragma("unroll") for (int jb = 0; jb < 8; ++jb) { u32x2 w_; w_.x = pk(Sacc[jb][0], Sacc[jb][1]); w_.y = pk(Sacc[jb][2], Sacc[jb][3]); *(u32x2*)(SB + (jb * 16 + fr) * 136 + wid * 16 + fq * 4) = w_; } } while (0)
        SBWRITE();
#pragma unroll 1
        for (int cc = 0; cc < 8; ++cc) {
            if (role == 0) { float D = 1.f; float kd[32];
#pragma unroll
                for (int i = 0; i < 32; ++i) { const float fraw = bf2f(ra[i]), qraw = bf2f(rb[i]); const float f = lb + (1.f - lb) * __builtin_amdgcn_rcpf(1.f + __expf(-fraw)); const float q = qraw * __builtin_amdgcn_rcpf(1.f + __expf(-qraw));
                    D *= f; QD[i * 136 + x] = f2bf(q * D); kd[i] = (1.f - f) * __builtin_amdgcn_rcpf(D); KD[i * 136 + x] = f2bf(kd[i]); }
                DC[x] = D;
#pragma unroll
                for (int i = 0; i < 32; i += 2) *(unsigned*)(KE + x * 40 + i) = pk(kd[i] * D, kd[i + 1] * D);
            } else if (role == 1) {
#pragma unroll
                for (int i = 0; i < 32; i += 2) *(unsigned*)(VT + x * 40 + i) = (unsigned)ra[i] | ((unsigned)ra[i + 1] << 16);
            }
            if (cc < 7) PLOAD(cc + 1);
            __syncthreads();
            if (wid < 4) { const int mb = wid >> 1, nbk = wid & 1; pg8::f32x4 acc = {0.f, 0.f, 0.f, 0.f};
#pragma unroll
                for (int ks = 0; ks < 4; ++ks) { const pg8::bf16x8 a = *(const pg8::bf16x8*)(QD + (mb * 16 + fr) * 136 + ks * 32 + fq * 8), b = *(const pg8::bf16x8*)(KD + (nbk * 16 + fr) * 136 + ks * 32 + fq * 8);
                    acc = __builtin_amdgcn_mfma_f32_16x16x32_bf16(a, b, acc, 0, 0, 0); }
#pragma unroll
                for (int r = 0; r < 4; ++r) { const int i = mb * 16 + fq * 4 + r, ip = nbk * 16 + fr; AM[i * 40 + ip] = (ip <= i) ? f2bf(acc[r]) : (unsigned short)0; } }
            __syncthreads();
            { const int mb = wid >> 2;
#pragma unroll
              for (int q2 = 0; q2 < 2; ++q2) { const int jb = (wid & 3) * 2 + q2; pg8::f32x4 acc = {0.f, 0.f, 0.f, 0.f};
                  { const pg8::bf16x8 a = *(const pg8::bf16x8*)(AM + (mb * 16 + fr) * 40 + fq * 8), b = *(const pg8::bf16x8*)(VT + (jb * 16 + fr) * 40 + fq * 8); acc = __builtin_amdgcn_mfma_f32_16x16x32_bf16(a, b, acc, 0, 0, 0); }
#pragma unroll
                  for (int ks = 0; ks < 4; ++ks) { const pg8::bf16x8 a = *(const pg8::bf16x8*)(QD + (mb * 16 + fr) * 136 + ks * 32 + fq * 8), b = *(const pg8::bf16x8*)(SB + (jb * 16 + fr) * 136 + ks * 32 + fq * 8);
                      acc = __builtin_amdgcn_mfma_f32_16x16x32_bf16(a, b, acc, 0, 0, 0); }
#pragma unroll
                  for (int r = 0; r < 4; ++r) { const int tt = cc * 32 + mb * 16 + fq * 4 + r; proj[(row0 + (dir ? 255 - tt : tt)) * LDP + colf + jb * 16 + fr] = f2bf(acc[r]); } } }
            { const pg8::f32x4 dc = *(const pg8::f32x4*)(DC + wid * 16 + fq * 4); const pg8::bf16x8 a = *(const pg8::bf16x8*)(KE + (wid * 16 + fr) * 40 + fq * 8);
#pragma unroll
              for (int jb = 0; jb < 8; ++jb) { const pg8::bf16x8 b = *(const pg8::bf16x8*)(VT + (jb * 16 + fr) * 40 + fq * 8); Sacc[jb] = Sacc[jb] * dc; Sacc[jb] = __builtin_amdgcn_mfma_f32_16x16x32_bf16(a, b, Sacc[jb], 0, 0, 0); } }
            __syncthreads();
            if (cc < 7) SBWRITE();
        }
#undef PLOAD
#undef SBWRITE
    }
}
__device__ __forceinline__ void hgrn_scan(float* ST, const float* PD, int nseq, int NSC, int bid, int nb) {
    const int nitems = nseq * 32 * 32; const int tid_ = ltid();
    for (int it = bid; it < nitems; it += nb) {
        const int eb = it & 31, hd = (it >> 5) & 31, s = it >> 10, dir = hd & 1;
        const int e = eb * 512 + tid_, k = e >> 7; float carry = 0.f;
        for (int cc = 0; cc < NSC; cc += 8) { float E[8], p[8]; size_t ui[8];
#pragma unroll
            for (int q = 0; q < 8; ++q) { const int c = dir ? NSC - 1 - (cc + q) : (cc + q); ui[q] = ((size_t)(s * NSC + c)) * 32 + hd; E[q] = ST[ui[q] * 16384 + e]; p[q] = PD[ui[q] * 128 + k]; }
#pragma unroll
            for (int q = 0; q < 8; ++q) { ST[ui[q] * 16384 + e] = carry; carry = fmaf(p[q], carry, E[q]); } }
    }
}

__device__ __forceinline__ void combine_phase(const bf16_t* OB, const bf16_t* proj, bf16_t* mix, const float* __restrict__ dl, const float* __restrict__ subln_w, const float* __restrict__ hnw, int rows, int bid, int nb) {
    const int tid_ = ltid(); const int lane = tid_ & 63, wid = tid_ >> 6;
    float a = dl[lane] * dl[128 + lane] + dl[64 + lane] * dl[192 + lane], b = dl[256 + lane] * dl[384 + lane] + dl[320 + lane] * dl[448 + lane];
#pragma unroll
    for (int o = 32; o >= 1; o >>= 1) { a += __shfl_xor(a, o); b += __shfl_xor(b, o); }
    const float lam = expf(a) - expf(b) + 0.2f;
    for (int r = bid * 8 + wid; r < rows; r += nb * 8) {
#pragma unroll
        for (int i = 0; i < 4; ++i) { const int head = i * 2 + (lane >> 5), e = (lane & 31) * 8;
            const bf16_t* o0 = OB + (size_t)r * DM + head * 512 + e; const u32x4 x0 = *(const u32x4*)o0, x1 = *(const u32x4*)(o0 + 256);
            float dv[8]; float ss = 0.f;
#pragma unroll
            for (int q = 0; q < 4; ++q) { dv[2 * q] = bflo(x0[q]) - lam * bflo(x1[q]); dv[2 * q + 1] = bfhi(x0[q]) - lam * bfhi(x1[q]); ss += dv[2 * q] * dv[2 * q] + dv[2 * q + 1] * dv[2 * q + 1]; }
#pragma unroll
            for (int o = 16; o >= 1; o >>= 1) ss += __shfl_xor(ss, o);
            const float rs = rsqrtf(ss * (1.0f / 256.0f) + EPS) * 0.8f;
            const f32x4 w0 = *(const f32x4*)(subln_w + e), w1 = *(const f32x4*)(subln_w + e + 4);
            u32x4 w; w.x = pk(dv[0] * rs * w0[0], dv[1] * rs * w0[1]); w.y = pk(dv[2] * rs * w0[2], dv[3] * rs * w0[3]); w.z = pk(dv[4] * rs * w1[0], dv[5] * rs * w1[1]); w.w = pk(dv[6] * rs * w1[2], dv[7] * rs * w1[3]);
            *(u32x4*)(mix + (size_t)r * DM + head * 256 + e) = w; }
#pragma unroll
        for (int i = 0; i < 4; ++i) { const int col = i * 512 + lane * 8, dd = col & 127;
            const bf16_t* pr = proj + (size_t)r * LDP + col; const u32x4 xf = *(const u32x4*)(pr + 8192), xb = *(const u32x4*)(pr + 10240), xg = *(const u32x4*)(pr + 14336);
            float ov[8], gv[8]; float ss = 0.f;
#pragma unroll
            for (int q = 0; q < 4; ++q) { ov[2 * q] = bflo(xf[q]) + bflo(xb[q]); ov[2 * q + 1] = bfhi(xf[q]) + bfhi(xb[q]); gv[2 * q] = bflo(xg[q]); gv[2 * q + 1] = bfhi(xg[q]); ss += ov[2 * q] * ov[2 * q] + ov[2 * q + 1] * ov[2 * q + 1]; }
#pragma unroll
            for (int o = 8; o >= 1; o >>= 1) ss += __shfl_xor(ss, o);
            const float rs = rsqrtf(ss * (1.0f / 128.0f) + EPS);
            const f32x4 w0 = *(const f32x4*)(hnw + dd), w1 = *(const f32x4*)(hnw + dd + 4);
            float y[8];
#pragma unroll
            for (int q = 0; q < 8; ++q) { const float wq = q < 4 ? w0[q & 3] : w1[q & 3]; y[q] = ov[q] * rs * wq * (gv[q] * __builtin_amdgcn_rcpf(1.f + __expf(-gv[q]))); }
            u32x4 w; w.x = pk(y[0], y[1]); w.y = pk(y[2], y[3]); w.z = pk(y[4], y[5]); w.w = pk(y[6], y[7]);
            *(u32x4*)(mix + (size_t)r * DM + 2048 + col) = w; }
    }
}

__device__ __forceinline__ void attn_phase(const bf16_t* proj, bf16_t* OB, int nseq, int L, char* lds, int bid, int nb) {
    const int nqb = L / 256, nunits = nseq * 32 * nqb;
    for (int u = bid; u < nunits; u += nb) {
        const int qb = u % nqb, r = u / nqb, vh = r & 1, c = (r >> 1) & 1, h = (r >> 2) & 7, s = r >> 5;
        const size_t row0 = (size_t)s * L;
        att::attn_dense_body<att::bf16>(proj + (row0 + (size_t)qb * 256) * LDP + h * 256 + c * 128, proj + row0 * LDP + 2048 + h * 256 + c * 128,
                                        proj + row0 * LDP + 4096 + h * 256 + vh * 128, OB + (row0 + (size_t)qb * 256) * DM + h * 512 + c * 256 + vh * 128, L, lds);
        __syncthreads();
    }
}

struct Params { const float* in[13]; float* out; unsigned char* ws; };

__global__ void __launch_bounds__(512, 2) fwd(Params p) {
    extern __shared__ __attribute__((aligned(16))) unsigned char lds[];
    const int tid = threadIdx.x, bid = blockIdx.x, nb = gridDim.x;
    if (tid < 4) ((unsigned*)(lds + LDS_BAR_OFF))[tid] = 0u;
    __syncthreads();
    XcdBarrier bar = xcd_barrier_post((unsigned*)(p.ws + WS_CTL), (volatile LAS unsigned*)(lds + LDS_BAR_OFF));
    const float* attn_norm_w = p.in[2]; const float* w_in = p.in[3]; const float* diff_lambda = p.in[4]; const float* subln_w = p.in[5];
    const float* hgrn_lb = p.in[6]; const float* hgrn_norm_w = p.in[7]; const float* w_out = p.in[8]; const float* mlp_norm_w = p.in[9];
    const float* w_up = p.in[10]; const float* w_down = p.in[11]; const float* final_norm_w = p.in[12];
    bf16_t* WIN = (bf16_t*)(p.ws + WS_WIN); bf16_t* WOUT = (bf16_t*)(p.ws + WS_WOUT); bf16_t* WUP = (bf16_t*)(p.ws + WS_WUP); bf16_t* WDN = (bf16_t*)(p.ws + WS_WDN);
    bf16_t* HB = (bf16_t*)(p.ws + WS_HB); bf16_t* PROJ = (bf16_t*)(p.ws + WS_PROJ); bf16_t* OB = (bf16_t*)(p.ws + WS_OB);
    float* ST = (float*)(p.ws + WS_ST); float* PD = (float*)(p.ws + WS_PD); float* SSQ = (float*)(p.ws + WS_CTL + 512 * 1024);
    PG8_LAS unsigned char* ldsl = (PG8_LAS unsigned char*)lds;

    for (int i = bid * 512 + tid; i < 2 * MH; i += nb * 512) SSQ[i] = 0.f;
#if PHM & 1
    transpose_cvt(w_in, WIN, DM, NPROJ, (float*)lds, bid, nb, true);
    transpose_cvt(w_out, WOUT, DM, DM, (float*)lds, bid, nb, false);
    transpose_cvt(w_up, WUP, DM, DFF, (float*)lds, bid, nb, false);
    transpose_cvt(w_down, WDN, DFF, DM, (float*)lds, bid, nb, false);
#endif

    for (int hf = 0; hf < 2; ++hf) {
        const float* x = hf ? p.in[1] : p.in[0]; const int nseq = hf ? 1 : 8, L = hf ? 16384 : 2048;
        float* outp = p.out + (size_t)hf * MH * DM;
        rmsnorm_rows<true>(x, attn_norm_w, HB, MH, bid, nb);
        xcd_barrier(bar);
#if PHM & 2
        { pg8::Gemm g{HB, WIN, MH, NPROJ, DM}; pg8::StaticOrder S; S.init(MH, NPROJ, nb, bid); EpiProjRope E{PROJ, LDP, L - 1};
          pg8::gemm_phase<EpiProjRope, pg8::StaticOrder>(ldsl, g, S, E, nullptr); }
#endif
        xcd_barrier(bar);
#if PHM & 4
        hgrn_ends(PROJ, hgrn_lb, ST, PD, nseq, L, lds, bid, nb);
#endif
        xcd_barrier(bar);
        hgrn_scan(ST, PD, nseq, L / HT, bid, nb);
#if PHM & 8
        attn_phase(PROJ, OB, nseq, L, (char*)lds, bid, nb);
#endif
        xcd_barrier(bar);
#if PHM & 16
        hgrn_out(PROJ, hgrn_lb, ST, nseq, L, lds, bid, nb);
#endif
        xcd_barrier(bar);
        combine_phase(OB, PROJ, HB, diff_lambda, subln_w, hgrn_norm_w, MH, bid, nb);
        xcd_barrier(bar);
#if PHM & 32
        { pg8::Gemm g{HB, WOUT, MH, DM, DM}; pg8::StaticOrder S; S.init(MH, DM, nb, bid); EpiResNorm E{x, outp, DM, OB, mlp_norm_w, SSQ + hf * MH};
          pg8::gemm_phase<EpiResNorm, pg8::StaticOrder>(ldsl, g, S, E, nullptr); }
#endif
        xcd_barrier(bar);
        for (int ch = 0; ch < MH / MC; ++ch) {
#if PHM & 64
            { pg8::Gemm g{OB + (size_t)ch * MC * DM, WUP, MC, DFF, DM}; pg8::StaticOrder S; S.init(MC, DFF, nb, bid); EpiB<1> E{PROJ, DFF};
              pg8::gemm_phase<EpiB<1>, pg8::StaticOrder>(ldsl, g, S, E, nullptr); }
#endif
            xcd_barrier(bar);
#if PHM & 128
            { float* oc = outp + (size_t)ch * MC * DM; pg8::Gemm g{PROJ, WDN, MC, DM, DFF}; pg8::StaticOrder S; S.init(MC, DM, nb, bid); EpiResScale E{oc, DM, SSQ + hf * MH + ch * MC};
              pg8::gemm_phase<EpiResScale, pg8::StaticOrder>(ldsl, g, S, E, nullptr); }
#endif
            xcd_barrier(bar);
        }
        rmsnorm_rows<false>(outp, final_norm_w, outp, MH, bid, nb);
    }
}
}

extern "C" void kernel_launch(void* const* d_in, const int* in_sizes, int n_in, void* d_out, int out_size, void* d_ws, size_t ws_size, hipStream_t stream) {
    static int grid = 0;
    if (grid == 0) {
        if (n_in != 13 || ws_size < mk::WS_END) { fprintf(stderr, "kernel_launch: n_in %d ws %zu (need %zu)\n", n_in, ws_size, (size_t)mk::WS_END); grid = -1; return; }
        int dev = 0, cus = 0, per_cu = 0;
        hipGetDevice(&dev); hipDeviceGetAttribute(&cus, hipDeviceAttributeMultiprocessorCount, dev);
        if (hipFuncSetAttribute((const void*)mk::fwd, hipFuncAttributeMaxDynamicSharedMemorySize, mk::LDS_BYTES) != hipSuccess) { fprintf(stderr, "kernel_launch: hipFuncSetAttribute failed\n"); grid = -1; return; }
        if (hipOccupancyMaxActiveBlocksPerMultiprocessor(&per_cu, (const void*)mk::fwd, 512, mk::LDS_BYTES) != hipSuccess || per_cu < 1) { fprintf(stderr, "kernel_launch: occupancy %d\n", per_cu); grid = -1; return; }
        (void)hipGetLastError();
        grid = cus;
    }
    if (grid < 0) return;
    hipMemsetAsync((char*)d_ws + mk::WS_CTL, 0, 65536, stream);
    mk::Params p{};
    for (int i = 0; i < 13; ++i) p.in[i] = (const float*)d_in[i];
    p.out = (float*)d_out; p.ws = (unsigned char*)d_ws;
    hipLaunchKernelGGL(mk::fwd, dim3(grid), dim3(512), mk::LDS_BYTES, stream, p);
}
```

```cpp
#include <hip/hip_runtime.h>
#include <cstdio>
#include <cstdint>
__device__ __forceinline__ int ltid() { int t = threadIdx.x; asm volatile("" : "+v"(t)); return t; }
__device__ __forceinline__ int lsg(int v) { asm volatile("" : "+s"(v)); return v; }
namespace pg8 {
#define PG8_LAS __attribute__((address_space(3)))
typedef unsigned short bf16_t;
typedef short bf16x8 __attribute__((ext_vector_type(8)));
typedef float f32x4 __attribute__((ext_vector_type(4)));
typedef unsigned u32x4 __attribute__((ext_vector_type(4)));
constexpr int BM = 256, BK = 64, HALF = 128, HTB = HALF * BK * 2  , STAGE_BYTES = 8 * HTB, NXCD = 8, WGM = 8;

__host__ __device__ __forceinline__ int lds_byte(int r, int c) { const int st = (r >> 4) * 2 + (c >> 5), rr = r & 15, cc = c & 31, ob = rr * 64 + cc * 2; return st * 1024 + (ob ^ (((ob >> 9) & 1) << 5)); }
__host__ __device__ __forceinline__ void stage_rc(int b, int& R, int& C) { const int st = b / 1024, sb = b % 1024, swz = sb ^ (((sb >> 9) & 1) << 5); R = (st >> 1) * 16 + swz / 64; C = (st & 1) * 32 + (swz % 64) / 2; }
__host__ __device__ __forceinline__ int perm32(int rho) { const int n = rho >> 4, i = rho & 15; return 8 * (i >> 2) + 4 * n + (i & 3); }

struct Unit { int pm, pn; };
struct Gemm { const bf16_t* A; const bf16_t* Bt; int M, N, K; };

struct StaticOrder {
    int nM, nN, nwg, G, c;
    __host__ __device__ void init(int M, int N, int G_, int c_) { nM = M / BM; nN = N / BM; nwg = nM * nN; G = G_; c = c_; }
    __host__ __device__ bool next(int i, Unit& u) const {
        const long L = (long)i * G + c; if (L >= nwg) return false;
        int wgid = (int)L; { const int q = nwg / NXCD, r = nwg % NXCD, xcd = wgid % NXCD, off = wgid / NXCD; wgid = (xcd < r ? xcd * (q + 1) : r * (q + 1) + (xcd - r) * q) + off; }
        const int nig = WGM * nN, gid = wgid / nig, fm = gid * WGM, gsz = (nM - fm) < WGM ? (nM - fm) : WGM;
        u.pm = fm + ((wgid % nig) % gsz); u.pn = (wgid % nig) / gsz; return true;
    }
    __device__ __forceinline__ void a_ready(const Unit&) const {}
    __device__ __forceinline__ void done(const Unit&) const {}
};
struct CountedOrder : StaticOrder {
    const unsigned* ready; unsigned need; unsigned* tmo;
    __device__ __forceinline__ void a_ready(const Unit& u) const {
        if (threadIdx.x < 64) {
            const unsigned long long t0 = __builtin_amdgcn_s_memrealtime(); unsigned polls = 0;
            while ((unsigned)__builtin_amdgcn_readfirstlane(__hip_atomic_load(ready + 64 * u.pm, __ATOMIC_RELAXED, __HIP_MEMORY_SCOPE_AGENT)) < need) {
                if ((++polls & 255u) == 0u && __builtin_amdgcn_readfirstlane(__hip_atomic_load(tmo, __ATOMIC_RELAXED, __HIP_MEMORY_SCOPE_AGENT)) != 0u) break;
                if (__builtin_amdgcn_s_memrealtime() - t0 > 2000000ull) {
                    if (threadIdx.x == 0) { unsigned expect = 0u; __hip_atomic_compare_exchange_strong(tmo + 1, &expect, 0x600u | (unsigned)(u.pm & 0xff), __ATOMIC_RELAXED, __ATOMIC_RELAXED, __HIP_MEMORY_SCOPE_AGENT); __hip_atomic_store(tmo, 1u, __ATOMIC_RELAXED, __HIP_MEMORY_SCOPE_AGENT); }
                    break; }
                __builtin_amdgcn_s_sleep(2); }
            __builtin_amdgcn_fence(__ATOMIC_ACQUIRE, "agent");
            asm volatile("s_waitcnt vmcnt(0)" ::: "memory");
        }
#if !defined(BROKEN_HOOK_NO_BARRIER)
        asm volatile("" ::: "memory"); __builtin_amdgcn_s_barrier(); asm volatile("" ::: "memory");
#endif
    }
};

__device__ __forceinline__ unsigned cvt_pk_bf16(float lo, float hi) { unsigned r; asm volatile("v_cvt_pk_bf16_f32 %0, %1, %2" : "=v"(r) : "v"(lo), "v"(hi)); return r; }
typedef float f32x2 __attribute__((ext_vector_type(2)));
__device__ __forceinline__ f32x2 gelu_pk(f32x2 v) {
    const f32x2 av = __builtin_elementwise_abs(v), d = av * 0.2316418882f + 1.0f;
    f32x2 t; t.x = __builtin_amdgcn_rcpf(d.x); t.y = __builtin_amdgcn_rcpf(d.y);
    f32x2 q = t * 0.5307027145f + (-0.7265760135f); q = q * t + 0.7107068705f; q = q * t + (-0.142248368f); q = q * t + 0.127414796f; q = q * t;
    const f32x2 s = (v * v) * (-0.72134752044f);
    f32x2 e; e.x = __builtin_amdgcn_exp2f(s.x); e.y = __builtin_amdgcn_exp2f(s.y);
    const f32x2 m = v * (q * e), r = v - m;
    f32x2 o; o.x = v.x < 0.f ? m.x : r.x; o.y = v.y < 0.f ? m.y : r.y; return o;
}

struct EpiF32 {
    static constexpr bool PERM = false, AFTER_DRAIN = false;
    float* C; int ldc; const float* bias;
    __device__ __forceinline__ void operator()(const f32x4 (&acc)[2][2][4][2], const Unit& u, int wr, int wc, int fr, int fq) const {
        const int row0 = u.pm * BM + wr * 64 + fr, col0 = u.pn * BM + wc * 32 + 4 * fq;
        f32x4 bv[2][2];
#pragma unroll
        for (int bj = 0; bj < 2; ++bj)
#pragma unroll
            for (int n = 0; n < 2; ++n) bv[bj][n] = bias ? *(const f32x4*)(bias + col0 + bj * HALF + n * 16) : (f32x4){0.f, 0.f, 0.f, 0.f};
#pragma unroll
        for (int ai = 0; ai < 2; ++ai)
#pragma unroll
            for (int m = 0; m < 4; ++m) { float* rowp = C + (size_t)(row0 + ai * HALF + m * 16) * ldc + col0;
#pragma unroll
                for (int bj = 0; bj < 2; ++bj)
#pragma unroll
                    for (int n = 0; n < 2; ++n) *(f32x4*)(rowp + bj * HALF + n * 16) = acc[ai][bj][m][n] + bv[bj][n]; }
    }
};
template <int ACT  > struct EpiBf16 {
    static constexpr bool PERM = true, AFTER_DRAIN = false;
    bf16_t* O; int ldc; const float* bias; int split_cols; size_t split_stride;
    __device__ __forceinline__ void operator()(const f32x4 (&acc)[2][2][4][2], const Unit& u, int wr, int wc, int fr, int fq) const {
        const int row0 = u.pm * BM + wr * 64 + fr; int colt = u.pn * BM; bf16_t* base = O;
        if (split_cols) { const int t = colt / split_cols; base += (size_t)t * split_stride; colt -= t * split_cols; }
        const int col0 = colt + wc * 32 + 8 * fq, bcol0 = u.pn * BM + wc * 32 + 8 * fq;
        f32x4 bv[2][2];
#pragma unroll
        for (int bj = 0; bj < 2; ++bj)
#pragma unroll
            for (int n = 0; n < 2; ++n) bv[bj][n] = bias ? *(const f32x4*)(bias + bcol0 + bj * HALF + 4 * n) : (f32x4){0.f, 0.f, 0.f, 0.f};
#pragma unroll
        for (int ai = 0; ai < 2; ++ai)
#pragma unroll
            for (int m = 0; m < 4; ++m) { bf16_t* rowp = base + (size_t)(row0 + ai * HALF + m * 16) * ldc + col0;
#pragma unroll
                for (int bj = 0; bj < 2; ++bj) { f32x4 v0 = acc[ai][bj][m][0] + bv[bj][0], v1 = acc[ai][bj][m][1] + bv[bj][1];
                    if (ACT == 1) { f32x2 a = gelu_pk((f32x2){v0[0], v0[1]}), b = gelu_pk((f32x2){v0[2], v0[3]}), c = gelu_pk((f32x2){v1[0], v1[1]}), d = gelu_pk((f32x2){v1[2], v1[3]});
                        v0 = (f32x4){a.x, a.y, b.x, b.y}; v1 = (f32x4){c.x, c.y, d.x, d.y}; }
                    if (ACT == 2) {
#pragma unroll
                        for (int j = 0; j < 4; ++j) { v0[j] = 0.5f * v0[j] * (1.0f + erff(v0[j] * 0.70710678f)); v1[j] = 0.5f * v1[j] * (1.0f + erff(v1[j] * 0.70710678f)); } }
                    u32x4 w; w.x = cvt_pk_bf16(v0[0], v0[1]); w.y = cvt_pk_bf16(v0[2], v0[3]); w.z = cvt_pk_bf16(v1[0], v1[1]); w.w = cvt_pk_bf16(v1[2], v1[3]);
                    *(u32x4*)(rowp + bj * HALF) = w; } }
    }
};
template <class Epi, class Sched, bool STAMP = false>
__device__ __forceinline__ void gemm_phase(PG8_LAS unsigned char* lds, const Gemm g, const Sched& S, const Epi& E, unsigned long long* stamps) {
    const int tid = ltid(), wid = __builtin_amdgcn_readfirstlane(tid >> 6), lane = tid & 63, wr = wid >> 2, wc = wid & 3, fr = lane & 15, fq = lane >> 4;
    const int K = g.K, nt = K / BK;
    int ts_lo = 0, ts_hi = 0, nts = 0; const unsigned long long rt_entry = STAMP ? (unsigned long long)wall_clock64() : 0ull;
#define PG8_STAMP() do { if (STAMP && wid == 0 && nts < 64) { const unsigned long long _c = (unsigned long long)clock64(); \
        ts_lo = (lane == nts) ? (int)(unsigned)_c : ts_lo; ts_hi = (lane == nts) ? (int)(unsigned)(_c >> 32) : ts_hi; ++nts; } } while (0)
    PG8_STAMP();
    unsigned voffA[2], voffB[2];
#pragma unroll
    for (int i = 0; i < 2; ++i) { int R, C; stage_rc(tid * 16 + i * 8192, R, C); const int Rb = Epi::PERM ? ((R & ~31) + perm32(R & 31)) : R;
        voffA[i] = (unsigned)(R * K + C) * 2u; voffB[i] = (unsigned)(Rb * K + C) * 2u; }
    const size_t kstep = (size_t)(BK * 2);
    const size_t hstep = (size_t)HALF * K * 2;
    const size_t tstep = 2 * hstep;
    const unsigned ldsw = (unsigned)wid * 1024u;
    const int aoff = lds_byte(wr * 64 + fr, fq * 8), boff = lds_byte(wc * 32 + fr, fq * 8);
#define PG8_SA(b, h) (((b) * 2 + (h)) * HTB)
#define PG8_SB(b, h) ((4 + (b) * 2 + (h)) * HTB)
#define PG8_STAGE(bufoff, gbase, voff) do { _Pragma("unroll") for (int _i = 0; _i < 2; ++_i) \
        __builtin_amdgcn_global_load_lds((const unsigned*)((const char*)(gbase) + (voff)[_i]), (PG8_LAS unsigned*)(lds + (bufoff) + ldsw + _i * 8192), 16, 0, 0); } while (0)
#define PG8_LDA(dst, b, h) do { _Pragma("unroll") for (int m = 0; m < 4; ++m) _Pragma("unroll") for (int k = 0; k < 2; ++k) dst[m][k] = *(const PG8_LAS bf16x8*)(lds + PG8_SA(b, h) + aoff + m * 2048 + k * 1024); } while (0)
#define PG8_LDB(dst, b, h) do { _Pragma("unroll") for (int n = 0; n < 2; ++n) _Pragma("unroll") for (int k = 0; k < 2; ++k) dst[n][k] = *(const PG8_LAS bf16x8*)(lds + PG8_SB(b, h) + boff + n * 2048 + k * 1024); } while (0)
#define PG8_MMA(ai, bj, At, Bt) do { __builtin_amdgcn_s_setprio(1); _Pragma("unroll") for (int m = 0; m < 4; ++m) _Pragma("unroll") for (int n = 0; n < 2; ++n) _Pragma("unroll") for (int k = 0; k < 2; ++k) \
        acc[ai][bj][m][n] = __builtin_amdgcn_mfma_f32_16x16x32_bf16(Bt[n][k], At[m][k], acc[ai][bj][m][n], 0, 0, 0); __builtin_amdgcn_s_setprio(0); } while (0)
#define PG8_WAIT_V(n) asm volatile("s_waitcnt vmcnt(" #n ")" ::: "memory")
#define PG8_WAIT_L(n) asm volatile("s_waitcnt lgkmcnt(" #n ")" ::: "memory")
#define PG8_BAR __builtin_amdgcn_s_barrier()
#define PG8_SCHED __builtin_amdgcn_sched_barrier(0)
    Unit cur, nxt; int ui = 0;
    if (!S.next(0, cur)) return;
    f32x4 acc[2][2][4][2];
#pragma unroll
    for (int a = 0; a < 2; ++a)
#pragma unroll
        for (int b = 0; b < 2; ++b)
#pragma unroll
            for (int m = 0; m < 4; ++m)
#pragma unroll
                for (int n = 0; n < 2; ++n) acc[a][b][m][n] = (f32x4){0.f, 0.f, 0.f, 0.f};
    bf16x8 At[4][2], B0[2][2], B1[2][2];
    const char* cA = (const char*)g.A + (size_t)cur.pm * tstep; const char* cB = (const char*)g.Bt + (size_t)cur.pn * tstep;
    S.a_ready(cur);
    PG8_STAGE(PG8_SB(0, 0), cB, voffB); PG8_STAGE(PG8_SA(0, 0), cA, voffA); PG8_STAGE(PG8_SB(0, 1), cB + hstep, voffB); PG8_STAGE(PG8_SA(0, 1), cA + hstep, voffA);
    if (wr == 1) PG8_BAR;
    PG8_WAIT_V(4); PG8_BAR;
    PG8_STAGE(PG8_SB(1, 0), cB + kstep, voffB); PG8_STAGE(PG8_SA(1, 0), cA + kstep, voffA); PG8_STAGE(PG8_SB(1, 1), cB + hstep + kstep, voffB);
    PG8_WAIT_V(6); PG8_BAR;
    PG8_STAMP();
    for (;;) {
        const bool has_next = S.next(ui + 1, nxt);
        const char* nA = has_next ? (const char*)g.A + (size_t)nxt.pm * tstep : cA; const char* nB = has_next ? (const char*)g.Bt + (size_t)nxt.pn * tstep : cB;
        for (int t = 0; t < nt; t += 2) {
            const bool last = (t == nt - 2);
            const char* a1 = cA + (size_t)(t + 1) * kstep;
            const char* a2 = last ? nA : cA + (size_t)(t + 2) * kstep; const char* b2 = last ? nB : cB + (size_t)(t + 2) * kstep;
            const char* a3 = a2 + kstep; const char* b3 = b2 + kstep;
            if (last && has_next) S.a_ready(nxt);
            PG8_LDB(B0, 0, 0); PG8_SCHED; PG8_LDA(At, 0, 0); PG8_STAGE(PG8_SA(1, 1), a1 + hstep, voffA);
            PG8_WAIT_L(8); PG8_BAR; PG8_WAIT_L(0); PG8_MMA(0, 0, At, B0); PG8_BAR; PG8_SCHED;
            PG8_LDB(B1, 0, 1); PG8_STAGE(PG8_SB(0, 0), b2, voffB);
            PG8_BAR; PG8_WAIT_L(0); PG8_MMA(0, 1, At, B1); PG8_BAR;
            PG8_LDA(At, 0, 1); PG8_STAGE(PG8_SA(0, 0), a2, voffA);
            PG8_BAR; PG8_WAIT_L(0); PG8_MMA(1, 0, At, B0); PG8_BAR; PG8_SCHED;
            PG8_STAGE(PG8_SB(0, 1), b2 + hstep, voffB);
            PG8_WAIT_V(6); PG8_BAR; PG8_MMA(1, 1, At, B1); PG8_BAR;
            PG8_LDB(B0, 1, 0); PG8_SCHED; PG8_LDA(At, 1, 0); PG8_STAGE(PG8_SA(0, 1), a2 + hstep, voffA);
            PG8_WAIT_L(8); PG8_BAR; PG8_WAIT_L(0); PG8_MMA(0, 0, At, B0); PG8_BAR; PG8_SCHED;
            PG8_LDB(B1, 1, 1); PG8_STAGE(PG8_SB(1, 0), b3, voffB);
            PG8_BAR; PG8_WAIT_L(0); PG8_MMA(0, 1, At, B1); PG8_BAR;
            PG8_LDA(At, 1, 1); PG8_STAGE(PG8_SA(1, 0), a3, voffA);
            PG8_BAR; PG8_WAIT_L(0); PG8_MMA(1, 0, At, B0); PG8_BAR; PG8_SCHED;
            PG8_STAGE(PG8_SB(1, 1), b3 + hstep, voffB);
            PG8_WAIT_V(6); PG8_BAR; PG8_MMA(1, 1, At, B1); PG8_BAR;
        }
        PG8_STAMP();
        if constexpr (!Epi::AFTER_DRAIN) { E(acc, cur, wr, wc, fr, fq); S.done(cur); }
        PG8_STAMP();
        if (!has_next) break;
#pragma unroll
        for (int a = 0; a < 2; ++a)
#pragma unroll
            for (int b = 0; b < 2; ++b)
#pragma unroll
                for (int m = 0; m < 4; ++m)
#pragma unroll
                    for (int n = 0; n < 2; ++n) acc[a][b][m][n] = (f32x4){0.f, 0.f, 0.f, 0.f};
        cur = nxt; cA = nA; cB = nB; ++ui;
    }
    PG8_WAIT_V(0);
    if (wr == 0) PG8_BAR;
    PG8_BAR;
    if constexpr (Epi::AFTER_DRAIN) { E.fused(acc, cur, wr, wc, fr, fq, lds, wid, lane); S.done(cur); }
    PG8_STAMP();
    if (STAMP && wid == 0) { stamps[lane] = lane < nts ? (((unsigned long long)(unsigned)ts_hi << 32) | (unsigned)ts_lo) : 0ull;
        if (lane == 62) stamps[62] = rt_entry; if (lane == 63) stamps[63] = (unsigned long long)wall_clock64(); }
#undef PG8_STAMP
#undef PG8_SA
#undef PG8_SB
#undef PG8_STAGE
#undef PG8_LDA
#undef PG8_LDB
#undef PG8_MMA
#undef PG8_WAIT_V
#undef PG8_WAIT_L
#undef PG8_BAR
#undef PG8_SCHED
}
}
#define XB_TMO      128
#define XB_XCNT(j)  (256  + 64 * (j))
#define XB_XSUB(j)  (1280 + 64 * (j))
#define XB_XGEN(j)  (2304 + 64 * (j))
#define XB_TOP      3328
#define XB_TOPGEN   3392
#define XCD_BAR_WORDS 3456
#define XB_SPIN_CAP (1u << 22)
#define LAS __attribute__((address_space(3)))

__device__ __forceinline__ unsigned xb_ld(unsigned* p)              { return __hip_atomic_load(p, __ATOMIC_RELAXED, __HIP_MEMORY_SCOPE_AGENT); }
__device__ __forceinline__ unsigned xb_add(unsigned* p, unsigned v) { return __hip_atomic_fetch_add(p, v, __ATOMIC_RELAXED, __HIP_MEMORY_SCOPE_AGENT); }
__device__ __forceinline__ unsigned xb_xcc_id() { return (unsigned)__builtin_amdgcn_s_getreg((3 << 11) | 20) & 0xFu; }
#define XB_SPIN(cond, bar) do { unsigned _sp = 0; while (cond) { __builtin_amdgcn_s_sleep(1); \
    if ((++_sp & 255u) == 0u) { if (xb_ld(&(bar)[XB_TMO])) break; if (_sp > XB_SPIN_CAP) { atomicAdd(&(bar)[XB_TMO], 1u); break; } } } } while (0)

struct XcdBarrier {
    unsigned* bar; unsigned x;
    volatile LAS unsigned* st;
};

__device__ __forceinline__ XcdBarrier xcd_barrier_post(unsigned* bar, volatile LAS unsigned* st) {
    XcdBarrier b; b.bar = bar; b.x = xb_xcc_id(); b.st = st;
    if (threadIdx.x == 0) (void)xb_add(&bar[XB_XCNT(b.x)], 1u);
    return b;
}
__device__ __forceinline__ void xcd_barrier_complete(unsigned* bar, unsigned x, unsigned& nloc, unsigned& nx) {
    const unsigned G = gridDim.x * gridDim.y * gridDim.z;
    unsigned sum, cnt, mine, sp = 0u;
    for (;;) {
        sum = 0u; cnt = 0u; mine = 0u;
#pragma unroll
        for (unsigned j = 0; j < 16; ++j) { const unsigned c = xb_ld(&bar[XB_XCNT(j)]); sum += c; cnt += (c > 0u) ? 1u : 0u; mine = (j == x) ? c : mine; }
        if (sum == G) break;
        __builtin_amdgcn_s_sleep(1);
        if ((++sp & 255u) == 0u) { if (xb_ld(&bar[XB_TMO])) break; if (sp > XB_SPIN_CAP) { atomicAdd(&bar[XB_TMO], 1u); break; } }
    }
    nloc = mine > 0u ? mine : 1u; nx = cnt > 0u ? cnt : 1u;
}

__device__ __forceinline__ void xcd_barrier(const XcdBarrier& b) {
    asm volatile("s_waitcnt vmcnt(0)" ::: "memory");
    __syncthreads();
    if (threadIdx.x == 0) {
        unsigned* bar = b.bar;
        __builtin_amdgcn_s_waitcnt(0);
        unsigned nloc = b.st[0], nx = b.st[1];
        if (nloc == 0u) { xcd_barrier_complete(bar, b.x, nloc, nx); b.st[0] = nloc; b.st[1] = nx; }
        const unsigned old = xb_add(&bar[XB_XSUB(b.x)], 1u);
        const unsigned gen = old / nloc;
        if (old + 1u == (gen + 1u) * nloc) {
            __builtin_amdgcn_fence(__ATOMIC_RELEASE, "agent");
            asm volatile("s_waitcnt vmcnt(0)" ::: "memory");
            const unsigned og = xb_add(&bar[XB_TOP], 1u);
            const unsigned tg = og / nx;
            if (og + 1u == (tg + 1u) * nx) xb_add(&bar[XB_TOPGEN], 1u);
            else XB_SPIN(xb_ld(&bar[XB_TOPGEN]) == tg, bar);
            __builtin_amdgcn_fence(__ATOMIC_ACQUIRE, "agent");
            xb_add(&bar[XB_XGEN(b.x)], 1u);
            asm volatile("s_waitcnt vmcnt(0)" ::: "memory");
        } else {
            XB_SPIN(xb_ld(&bar[XB_XGEN(b.x)]) == gen, bar);
            __builtin_amdgcn_fence(__ATOMIC_ACQUIRE, "agent");
            asm volatile("s_waitcnt vmcnt(0)" ::: "memory");
        }
    }
    __syncthreads();
}
namespace att {
using bf16 = unsigned short;
constexpr int   D = 128, NW = 8, QBLK = 32, KVBLK = 64;
constexpr float SCALE = 0.088388347648318440f;
constexpr float THR = 8.f;
constexpr int SDEPTH = 2;
constexpr int LDQ = 16512, LDK = 16512, LDO = 4096;
constexpr size_t SHM_V = KVBLK * D * 2, SHM_K = KVBLK * D * 2, SHM_ATTN = 2 * SHM_V + 2 * SHM_K + NW * 64 * 4;
using bf16x8 = __attribute__((ext_vector_type(8))) short;
using s16x4  = __attribute__((ext_vector_type(4))) short;
using f32x16 = __attribute__((ext_vector_type(16))) float;
using f32x8  = __attribute__((ext_vector_type(8))) float;
using u32x4  = __attribute__((ext_vector_type(4))) unsigned;
#define KSWZ(row, colB) ((row) * 256 + ((colB) ^ (((row) & 7) << 4)))
#define SBAR() __builtin_amdgcn_sched_barrier(0)
__device__ __forceinline__ int crow(int r, int hi) { return (r & 3) + 8 * (r >> 2) + 4 * hi; }
__device__ __forceinline__ unsigned cvtpk(float lo, float hi) {
  unsigned r; asm volatile("v_cvt_pk_bf16_f32 %0, %1, %2" : "=v"(r) : "v"(lo), "v"(hi)); return r;
}
template <typename TIn> struct Stage;
template <> struct Stage<bf16>  { using T = bf16x8;
  __device__ static __forceinline__ T ld8(const bf16* p) { return *reinterpret_cast<const bf16x8*>(p); }
  __device__ static __forceinline__ bf16x8 tobf(T x) { return x; } };
template <> struct Stage<float> { using T = f32x8;
  __device__ static __forceinline__ T ld8(const float* p) { return *reinterpret_cast<const f32x8*>(p); }
  __device__ static __forceinline__ bf16x8 tobf(T x) {
    u32x4 w = {cvtpk(x[0], x[1]), cvtpk(x[2], x[3]), cvtpk(x[4], x[5]), cvtpk(x[6], x[7])}; return *reinterpret_cast<bf16x8*>(&w); } };

__device__ __forceinline__ void partialSM(f32x16& p0, f32x16& p1, float& m_reg, float& mn, float& alpha) {
  constexpr float C = SCALE * 1.4426950408889634f;
  float pmax = p0[0]; for (int r = 1; r < 16; ++r) pmax = fmaxf(pmax, p0[r]); for (int r = 0; r < 16; ++r) pmax = fmaxf(pmax, p1[r]);
  { auto rr = __builtin_amdgcn_permlane32_swap(__float_as_uint(pmax), __float_as_uint(pmax), false, false);
    pmax = fmaxf(__uint_as_float(rr[0]), __uint_as_float(rr[1])); }
  if (__builtin_expect(__all(pmax - m_reg <= THR / SCALE), 1)) { mn = m_reg; alpha = 1.f; }
  else { mn = fmaxf(m_reg, pmax); alpha = __builtin_amdgcn_exp2f((m_reg - mn) * C); m_reg = mn; }
  float mnC = -mn * C;
  for (int r = 0; r < 16; ++r) p0[r] = fmaf(p0[r], C, mnC); for (int r = 0; r < 16; ++r) p1[r] = fmaf(p1[r], C, mnC);
  for (int r = 0; r < 16; ++r) p0[r] = __builtin_amdgcn_exp2f(p0[r]);
}
__device__ __forceinline__ void finishSM(f32x16& p0, f32x16& p1, float alpha, float& l_reg, bf16x8& pa0, bf16x8& pa1, bf16x8& pa2, bf16x8& pa3) {
  for (int r = 0; r < 16; ++r) p1[r] = __builtin_amdgcn_exp2f(p1[r]);
  float ps = 0; for (int r = 0; r < 16; ++r) ps += p0[r]; for (int r = 0; r < 16; ++r) ps += p1[r];
  { auto rr = __builtin_amdgcn_permlane32_swap(__float_as_uint(ps), __float_as_uint(ps), false, false);
    ps = __uint_as_float(rr[0]) + __uint_as_float(rr[1]); }
  l_reg = l_reg * alpha + ps;
#define PK4(P, BASE, OUT) do { unsigned a0 = cvtpk(P[BASE + 0], P[BASE + 1]), a1 = cvtpk(P[BASE + 2], P[BASE + 3]);   \
    unsigned b0 = cvtpk(P[BASE + 4], P[BASE + 5]), b1 = cvtpk(P[BASE + 6], P[BASE + 7]);                              \
    auto r0 = __builtin_amdgcn_permlane32_swap(a0, b0, false, false); auto r1 = __builtin_amdgcn_permlane32_swap(a1, b1, false, false); \
    u32x4 w = {r0[0], r1[0], r0[1], r1[1]}; OUT = *reinterpret_cast<bf16x8*>(&w); } while (0)
  PK4(p0, 0, pa0); PK4(p0, 8, pa1); PK4(p1, 0, pa2); PK4(p1, 8, pa3);
#undef PK4
}
__device__ __forceinline__ void qkt(f32x16& p0, f32x16& p1, const bf16* Ks, const bf16x8* qr, int r32, int hi) {
  p0 = f32x16{}; p1 = f32x16{};
  for (int d0 = 0; d0 < 8; ++d0) { int cb = (d0 * 16 + hi * 8) * 2;
    bf16x8 b0 = *reinterpret_cast<const bf16x8*>((const char*)Ks + KSWZ(r32, cb));
    bf16x8 b1 = *reinterpret_cast<const bf16x8*>((const char*)Ks + KSWZ(32 + r32, cb));
    p0 = __builtin_amdgcn_mfma_f32_32x32x16_bf16(b0, qr[d0], p0, 0, 0, 0);
    p1 = __builtin_amdgcn_mfma_f32_32x32x16_bf16(b1, qr[d0], p1, 0, 0, 0); }
}
__device__ __forceinline__ int v_st(int k, int c) { const int kk = (k & ~0xC) | ((k & 4) << 1) | ((k & 8) >> 1); return ((kk >> 3) * 4 + (c >> 5)) * 512 + ((kk & 7) * 32 + (c & 31)) * 2; }
__device__ __forceinline__ int v_rd_base(int lane) { return ((lane & 3) << 3) | (((lane >> 2) & 3) << 6) | (((lane >> 4) & 1) << 5) | (((lane >> 5) & 1) << 8); }
constexpr int v_rd_off(int d0, int ks, int half) { return d0 * 512 + ks * 4096 + half * 2048; }
template <int OFF> __device__ __forceinline__ s16x4 tr_read(int vb) {
  s16x4 r; asm volatile("ds_read_b64_tr_b16 %0, %1 offset:%2" : "=&v"(r) : "v"(vb), "i"(OFF) : "memory"); return r;
}
template <int D0> __device__ __forceinline__ void pv_one(f32x16& od, int vb, bf16x8 pa0, bf16x8 pa1, bf16x8 pa2, bf16x8 pa3) {
  const s16x4 l0 = tr_read<v_rd_off(D0, 0, 0)>(vb), h0 = tr_read<v_rd_off(D0, 0, 1)>(vb), l1 = tr_read<v_rd_off(D0, 1, 0)>(vb), h1 = tr_read<v_rd_off(D0, 1, 1)>(vb);
  const s16x4 l2 = tr_read<v_rd_off(D0, 2, 0)>(vb), h2 = tr_read<v_rd_off(D0, 2, 1)>(vb), l3 = tr_read<v_rd_off(D0, 3, 0)>(vb), h3 = tr_read<v_rd_off(D0, 3, 1)>(vb);
  asm volatile("s_waitcnt lgkmcnt(0)" ::: "memory"); SBAR();
#define PK(L, H) (bf16x8){L[0], L[1], L[2], L[3], H[0], H[1], H[2], H[3]}
  od = __builtin_amdgcn_mfma_f32_32x32x16_bf16(pa0, PK(l0, h0), od, 0, 0, 0);
  od = __builtin_amdgcn_mfma_f32_32x32x16_bf16(pa1, PK(l1, h1), od, 0, 0, 0);
  od = __builtin_amdgcn_mfma_f32_32x32x16_bf16(pa2, PK(l2, h2), od, 0, 0, 0);
  od = __builtin_amdgcn_mfma_f32_32x32x16_bf16(pa3, PK(l3, h3), od, 0, 0, 0);
#undef PK
}
__device__ __forceinline__ void pv_d0(f32x16* o, int vb, bf16x8 pa0, bf16x8 pa1, bf16x8 pa2, bf16x8 pa3) {
  pv_one<0>(o[0], vb, pa0, pa1, pa2, pa3); pv_one<1>(o[1], vb, pa0, pa1, pa2, pa3); pv_one<2>(o[2], vb, pa0, pa1, pa2, pa3); pv_one<3>(o[3], vb, pa0, pa1, pa2, pa3);
}

template <typename TQ>
__device__ __forceinline__ void attn_dense_body(const TQ* __restrict__ Qb, const bf16* __restrict__ Kh, const bf16* __restrict__ Vh,
                                                bf16* __restrict__ Ob, int seq, char* lds) {
  using St = Stage<bf16>; using SQ = Stage<TQ>;
  const int tid = ltid(), wid = tid >> 6, lane = tid & 63, r32 = lane & 31, hi = lane >> 5;
  bf16* V_lds = (bf16*)lds; bf16* K_lds = (bf16*)(lds + 2 * SHM_V);
  float* ws = (float*)(lds + 2 * SHM_V + 2 * SHM_K) + wid * 64; float* li_l = ws; float* al_l = ws + 32;
  float m_reg = -1e30f, l_reg = 0; f32x16 o[4] = {}; bf16x8 qr[8];
  const TQ* Qw = Qb + (long)(wid * QBLK + r32) * LDQ + hi * 8;
#pragma unroll
  for (int d0 = 0; d0 < 8; ++d0) qr[d0] = SQ::tobf(SQ::ld8(Qw + d0 * 16));
  const int sr = tid >> 4, sc = (tid & 15) * 8, vst0 = v_st(sr, sc), vst1 = v_st(32 + sr, sc);
  const int vb0 = (int)(uintptr_t)V_lds + v_rd_base(lane);
  struct { typename St::T vs0, vs1, ks0, ks1; } sr_[SDEPTH];
#define SLOAD(i, k0) do { sr_[i].vs0 = St::ld8(&Vh[(long)((k0) + sr) * LDK + sc]); sr_[i].vs1 = St::ld8(&Vh[(long)((k0) + 32 + sr) * LDK + sc]); \
    sr_[i].ks0 = St::ld8(&Kh[(long)((k0) + sr) * LDK + sc]); sr_[i].ks1 = St::ld8(&Kh[(long)((k0) + 32 + sr) * LDK + sc]); } while (0)
#define SWRITE(b, i) do { *(bf16x8*)((char*)V_lds + (b) * SHM_V + vst0) = St::tobf(sr_[i].vs0);          \
    *(bf16x8*)((char*)V_lds + (b) * SHM_V + vst1) = St::tobf(sr_[i].vs1); int kc = sc * 2;               \
    *(bf16x8*)((char*)K_lds + (b) * SHM_K + KSWZ(sr, kc)) = St::tobf(sr_[i].ks0);                       \
    *(bf16x8*)((char*)K_lds + (b) * SHM_K + KSWZ(32 + sr, kc)) = St::tobf(sr_[i].ks1); } while (0)
#define SWAIT() do { if constexpr (SDEPTH == 2) asm volatile("s_waitcnt vmcnt(4)" ::: "memory"); else asm volatile("s_waitcnt vmcnt(0)" ::: "memory"); } while (0)
#define RESC(a) do { if (__any((a) < 1.f)) { if (hi == 0) al_l[r32] = (a); asm volatile("s_waitcnt lgkmcnt(0)" ::: "memory"); \
    for (int d = 0; d < 4; ++d) for (int r = 0; r < 16; ++r) o[d][r] *= al_l[crow(r, hi)]; } } while (0)
  f32x16 pA0, pA1, pB0, pB1; float mnA, mnB, alA, alB; bf16x8 pa0, pa1, pa2, pa3; const int NT = seq / KVBLK;
  constexpr int SE = 0, SO = SDEPTH - 1;
  SLOAD(SE, 0); asm volatile("s_waitcnt vmcnt(0)" ::: "memory"); SWRITE(0, SE); __syncthreads();
  qkt(pA0, pA1, K_lds, qr, r32, hi); partialSM(pA0, pA1, m_reg, mnA, alA);
  SLOAD(SO, KVBLK); if constexpr (SDEPTH == 2) { if (2 < NT) SLOAD(SE, 2 * KVBLK); }
  SWAIT(); SWRITE(1, SO); __syncthreads();
  for (int j = 1; j + 1 < NT; j += 2) {
    SBAR(); qkt(pB0, pB1, (bf16*)((char*)K_lds + SHM_K), qr, r32, hi);
    finishSM(pA0, pA1, alA, l_reg, pa0, pa1, pa2, pa3); SBAR();
    SLOAD(SO, (j + SDEPTH) * KVBLK); SBAR();
    pv_d0(o, vb0, pa0, pa1, pa2, pa3); partialSM(pB0, pB1, m_reg, mnB, alB);
    __syncthreads(); SWAIT(); SWRITE(0, SE);
    RESC(alB); __syncthreads();
    SBAR(); qkt(pA0, pA1, K_lds, qr, r32, hi);
    finishSM(pB0, pB1, alB, l_reg, pa0, pa1, pa2, pa3); SBAR();
    if (SDEPTH == 1 || j + 3 < NT) SLOAD(SE, (j + 1 + SDEPTH) * KVBLK); SBAR();
    pv_d0(o, vb0 + (int)SHM_V, pa0, pa1, pa2, pa3); partialSM(pA0, pA1, m_reg, mnA, alA);
    __syncthreads(); SWAIT(); SWRITE(1, SO);
    RESC(alA); __syncthreads();
  }
  SBAR(); qkt(pB0, pB1, (bf16*)((char*)K_lds + SHM_K), qr, r32, hi);
  finishSM(pA0, pA1, alA, l_reg, pa0, pa1, pa2, pa3); SBAR();
  pv_d0(o, vb0, pa0, pa1, pa2, pa3); partialSM(pB0, pB1, m_reg, mnB, alB);
  __syncthreads(); RESC(alB);
  finishSM(pB0, pB1, alB, l_reg, pa0, pa1, pa2, pa3); SBAR();
  pv_d0(o, vb0 + (int)SHM_V, pa0, pa1, pa2, pa3);
  if (hi == 0) li_l[r32] = l_reg; asm volatile("s_waitcnt lgkmcnt(0)" ::: "memory");
  float rli[16];
#pragma unroll
  for (int r = 0; r < 16; ++r) rli[r] = __builtin_amdgcn_rcpf(li_l[crow(r, hi)]);
  bf16* Ow = Ob + (long)(wid * QBLK) * LDO;
#pragma unroll
  for (int r = 0; r < 16; ++r) { int orow = crow(r, hi);
    for (int d0 = 0; d0 < 4; ++d0) { const float ov = o[d0][r] * rli[r]; unsigned uu = __float_as_uint(ov); uu += 0x7FFFu + ((uu >> 16) & 1u); Ow[(long)orow * LDO + d0 * 32 + r32] = (bf16)(uu >> 16); } }
#undef SLOAD
#undef SWRITE
#undef SWAIT
#undef RESC
}
}

#ifndef PHM
#define PHM 255
#endif
namespace mk {
__device__ const double INVD[64] = {1,0.86596432336006535,0.74989420933245587,0.64938163157621132,0.56234132519034907,0.48696752516586311,0.42169650342858223,0.36517412725483772,0.31622776601683794,0.27384196342643613,0.23713737056616552,0.20535250264571461,0.17782794100389229,0.15399265260594919,0.1333521432163324,0.11547819846894582,0.10000000000000001,0.086596432336006529,0.074989420933245579,0.064938163157621132,0.056234132519034911,0.048696752516586311,0.042169650342858224,0.036517412725483769,0.031622776601683791,0.027384196342643614,0.023713737056616554,0.02053525026457146,0.017782794100389229,0.015399265260594919,0.013335214321633241,0.011547819846894581,0.01,0.0086596432336006543,0.0074989420933245579,0.006493816315762113,0.005623413251903491,0.004869675251658631,0.0042169650342858229,0.0036517412725483771,0.0031622776601683794,0.0027384196342643613,0.0023713737056616554,0.002053525026457146,0.0017782794100389228,0.001539926526059492,0.0013335214321633241,0.0011547819846894581,0.001,0.00086596432336006539,0.00074989420933245586,0.00064938163157621134,0.0005623413251903491,0.0004869675251658631,0.00042169650342858224,0.0003651741272548377,0.00031622776601683794,0.00027384196342643611,0.00023713737056616554,0.00020535250264571461,0.00017782794100389227,0.00015399265260594919,0.0001333521432163324,0.00011547819846894582};
typedef unsigned short bf16_t;
typedef float f32x4 __attribute__((ext_vector_type(4)));
typedef unsigned u32x4 __attribute__((ext_vector_type(4)));
typedef unsigned u32x2 __attribute__((ext_vector_type(2)));
typedef float f32x2 __attribute__((ext_vector_type(2)));
constexpr int DM = 4096, NPROJ = 16384, LDP = 16512  , DFF = 16384, MH = 16384, MC = 16384;
constexpr size_t MiB = 1ull << 20;
constexpr size_t WS_CTL = 0, WS_WIN = 1 * MiB, WS_WOUT = WS_WIN + 128 * MiB, WS_WUP = WS_WOUT + 32 * MiB, WS_WDN = WS_WUP + 128 * MiB,
                 WS_HB = WS_WDN + 128 * MiB, WS_PROJ = WS_HB + 128 * MiB, WS_OB = WS_PROJ + 520 * MiB, WS_ST = WS_OB + 128 * MiB,
                 WS_PD = WS_ST + 128 * MiB, WS_END = WS_PD + 1 * MiB;
constexpr int LDS_BAR_OFF = 135168, LDS_BYTES = 135168 + 64;
constexpr float EPS = 1e-6f;

__device__ __forceinline__ float bf2f(unsigned b) { return __uint_as_float(b << 16); }
__device__ __forceinline__ float bflo(unsigned w) { return __uint_as_float(w << 16); }
__device__ __forceinline__ float bfhi(unsigned w) { return __uint_as_float(w & 0xffff0000u); }
__device__ __forceinline__ unsigned short f2bf(float f) { unsigned u = __float_as_uint(f); u += 0x7FFFu + ((u >> 16) & 1u); return (unsigned short)(u >> 16); }
__device__ __forceinline__ unsigned pk(float lo, float hi) { return pg8::cvt_pk_bf16(lo, hi); }

template <int ACT> struct EpiB {
    static constexpr bool PERM = true, AFTER_DRAIN = false;
    bf16_t* O; int ldc;
    __device__ __forceinline__ void operator()(const pg8::f32x4 (&acc)[2][2][4][2], const pg8::Unit& u, int wr, int wc, int fr, int fq) const {
        const int row0 = u.pm * 256 + wr * 64 + fr, col0 = u.pn * 256 + wc * 32 + 8 * fq;
#pragma unroll
        for (int ai = 0; ai < 2; ++ai)
#pragma unroll
            for (int m = 0; m < 4; ++m) { bf16_t* rowp = O + (size_t)(row0 + ai * 128 + m * 16) * ldc + col0;
#pragma unroll
                for (int bj = 0; bj < 2; ++bj) { pg8::f32x4 v0 = acc[ai][bj][m][0], v1 = acc[ai][bj][m][1];
                    if (ACT == 1) {
#pragma unroll
                        for (int j = 0; j < 4; ++j) { const float a = fmaxf(v0[j], 0.f), b = fmaxf(v1[j], 0.f); v0[j] = a * a; v1[j] = b * b; } }
                    pg8::u32x4 w; w.x = pk(v0[0], v0[1]); w.y = pk(v0[2], v0[3]); w.z = pk(v1[0], v1[1]); w.w = pk(v1[2], v1[3]);
                    *(pg8::u32x4*)(rowp + bj * 128) = w; } }
    }
};

struct EpiProjRope {
    static constexpr bool PERM = true, AFTER_DRAIN = false;
    bf16_t* O; int ldc; int Lmask;
    __device__ __forceinline__ void operator()(const pg8::f32x4 (&acc)[2][2][4][2], const pg8::Unit& u, int wr, int wc, int fr, int fq) const {
        const int row0 = u.pm * 256 + wr * 64 + fr;
        if (u.pn >= 16) { const int col0 = u.pn * 256 + wc * 32 + 8 * fq;
#pragma unroll
            for (int ai = 0; ai < 2; ++ai)
#pragma unroll
                for (int m = 0; m < 4; ++m) { bf16_t* rowp = O + (size_t)(row0 + ai * 128 + m * 16) * ldc + col0;
#pragma unroll
                    for (int bj = 0; bj < 2; ++bj) { const pg8::f32x4 v0 = acc[ai][bj][m][0], v1 = acc[ai][bj][m][1];
                        pg8::u32x4 w; w.x = pk(v0[0], v0[1]); w.y = pk(v0[2], v0[3]); w.z = pk(v1[0], v1[1]); w.w = pk(v1[2], v1[3]);
                        *(pg8::u32x4*)(rowp + bj * 128) = w; } }
        } else { const int d0 = 16 * wc + 4 * fq; double iv[4];
#pragma unroll
            for (int e = 0; e < 4; ++e) iv[e] = INVD[d0 + e] * 0.15915494309189533577;
#pragma unroll
            for (int ai = 0; ai < 2; ++ai)
#pragma unroll
                for (int m = 0; m < 4; ++m) { const int row = row0 + ai * 128 + m * 16; const int pos = row & Lmask; float c[4], sn[4];
#pragma unroll
                    for (int e = 0; e < 4; ++e) { double a = (double)pos * iv[e]; a -= __builtin_rint(a); const float f = (float)a; c[e] = __builtin_amdgcn_cosf(f); sn[e] = __builtin_amdgcn_sinf(f); }
                    bf16_t* rowp = O + (size_t)row * ldc + u.pn * 256 + d0;
#pragma unroll
                    for (int bj = 0; bj < 2; ++bj) { const pg8::f32x4 v0 = acc[ai][bj][m][0], v1 = acc[ai][bj][m][1]; float lo[4], hi[4];
#pragma unroll
                        for (int e = 0; e < 4; ++e) { lo[e] = v0[e] * c[e] - v1[e] * sn[e]; hi[e] = v1[e] * c[e] + v0[e] * sn[e]; }
                        u32x2 wl, wh; wl.x = pk(lo[0], lo[1]); wl.y = pk(lo[2], lo[3]); wh.x = pk(hi[0], hi[1]); wh.y = pk(hi[2], hi[3]);
                        *(u32x2*)(rowp + bj * 128) = wl; *(u32x2*)(rowp + bj * 128 + 64) = wh; } }
        }
    }
};
struct EpiRes {
    static constexpr bool PERM = false, AFTER_DRAIN = false;
    const float* base; float* C; int ldc;
    __device__ __forceinline__ void operator()(const pg8::f32x4 (&acc)[2][2][4][2], const pg8::Unit& u, int wr, int wc, int fr, int fq) const {
        const int row0 = u.pm * 256 + wr * 64 + fr, col0 = u.pn * 256 + wc * 32 + 4 * fq;
#pragma unroll
        for (int ai = 0; ai < 2; ++ai)
#pragma unroll
            for (int m = 0; m < 4; ++m) { const size_t off = (size_t)(row0 + ai * 128 + m * 16) * ldc + col0;
#pragma unroll
                for (int bj = 0; bj < 2; ++bj)
#pragma unroll
                    for (int n = 0; n < 2; ++n) { const pg8::f32x4 b = *(const pg8::f32x4*)(base + off + bj * 128 + n * 16);
                        *(pg8::f32x4*)(C + off + bj * 128 + n * 16) = acc[ai][bj][m][n] + b; } }
    }
};


struct EpiResNorm {
    static constexpr bool PERM = false, AFTER_DRAIN = false;
    const float* base; float* C; int ldc; bf16_t* H2; const float* wn; float* ssq;
    __device__ __forceinline__ void operator()(const pg8::f32x4 (&acc)[2][2][4][2], const pg8::Unit& u, int wr, int wc, int fr, int fq) const {
        const int row0 = u.pm * 256 + wr * 64 + fr, col0 = u.pn * 256 + wc * 32 + 4 * fq;
        pg8::f32x4 wv[2][2];
#pragma unroll
        for (int bj = 0; bj < 2; ++bj)
#pragma unroll
            for (int n = 0; n < 2; ++n) wv[bj][n] = *(const pg8::f32x4*)(wn + col0 + bj * 128 + n * 16);
#pragma unroll
        for (int ai = 0; ai < 2; ++ai)
#pragma unroll
            for (int m = 0; m < 4; ++m) { const int row = row0 + ai * 128 + m * 16; const size_t off = (size_t)row * ldc + col0; float ss = 0.f;
#pragma unroll
                for (int bj = 0; bj < 2; ++bj)
#pragma unroll
                    for (int n = 0; n < 2; ++n) { const pg8::f32x4 b = *(const pg8::f32x4*)(base + off + bj * 128 + n * 16); const pg8::f32x4 v = acc[ai][bj][m][n] + b;
                        *(pg8::f32x4*)(C + off + bj * 128 + n * 16) = v; ss += v[0] * v[0] + v[1] * v[1] + v[2] * v[2] + v[3] * v[3];
                        const pg8::f32x4 y = v * wv[bj][n]; u32x2 o2; o2.x = pk(y[0], y[1]); o2.y = pk(y[2], y[3]); *(u32x2*)(H2 + off + bj * 128 + n * 16) = o2; }
                ss += __shfl_xor(ss, 16); ss += __shfl_xor(ss, 32);
                if (fq == 0) atomicAdd(ssq + row, ss); }
    }
};
struct EpiResScale {
    static constexpr bool PERM = false, AFTER_DRAIN = false;
    float* C; int ldc; const float* ssq;
    __device__ __forceinline__ void operator()(const pg8::f32x4 (&acc)[2][2][4][2], const pg8::Unit& u, int wr, int wc, int fr, int fq) const {
        const int row0 = u.pm * 256 + wr * 64 + fr, col0 = u.pn * 256 + wc * 32 + 4 * fq;
#pragma unroll
        for (int ai = 0; ai < 2; ++ai)
#pragma unroll
            for (int m = 0; m < 4; ++m) { const int row = row0 + ai * 128 + m * 16; const size_t off = (size_t)row * ldc + col0;
                const float sc = 1.0f / (__hip_atomic_load(ssq + row, __ATOMIC_RELAXED, __HIP_MEMORY_SCOPE_AGENT) * (1.0f / DM) + EPS);
#pragma unroll
                for (int bj = 0; bj < 2; ++bj)
#pragma unroll
                    for (int n = 0; n < 2; ++n) { const pg8::f32x4 b = *(const pg8::f32x4*)(C + off + bj * 128 + n * 16);
                        *(pg8::f32x4*)(C + off + bj * 128 + n * 16) = b + acc[ai][bj][m][n] * sc; } }
    }
};

__device__ __forceinline__ void transpose_cvt(const float* __restrict__ W, bf16_t* __restrict__ Wt, int K, int N, float* tile, int bid, int nb, bool rperm) {
    const int tid = ltid(); const int ntn = N / 64, nt = (K / 64) * ntn;
    f32x4 pv[2];
#define TLOAD(t_) do { const int tn_ = (t_) % ntn, tk_ = (t_) / ntn; const float* src_ = W + (size_t)(tk_ * 64) * N + tn_ * 64; \
        _Pragma("unroll") for (int i = 0; i < 2; ++i) pv[i] = __builtin_nontemporal_load((const f32x4*)(src_ + (size_t)((tid >> 4) + i * 32) * N + (tid & 15) * 4)); } while (0)
    if (bid < nt) TLOAD(bid);
    for (int t = bid; t < nt; t += nb) {
        const int tn = t % ntn, tk = t / ntn;
#pragma unroll
        for (int i = 0; i < 2; ++i) { const int r = (tid >> 4) + i * 32, c = (tid & 15) * 4;
            tile[r * 65 + c] = pv[i][0]; tile[r * 65 + c + 1] = pv[i][1]; tile[r * 65 + c + 2] = pv[i][2]; tile[r * 65 + c + 3] = pv[i][3]; }
        __syncthreads();
        if (t + nb < nt) TLOAD(t + nb);
        const int n = tid >> 3, k8 = (tid & 7) * 8; float v[8];
#pragma unroll
        for (int i = 0; i < 8; ++i) v[i] = tile[(k8 + i) * 65 + n];
        u32x4 w; w.x = pk(v[0], v[1]); w.y = pk(v[2], v[3]); w.z = pk(v[4], v[5]); w.w = pk(v[6], v[7]);
        int orow = tn * 64 + n;
        if (rperm && orow < 4096) { const int V = orow >> 7, d = orow & 127; const int r = (d < 64) ? ((d >> 2) * 8 + (d & 3)) : (((d - 64) >> 2) * 8 + 4 + ((d - 64) & 3)); orow = V * 128 + r; }
        *(u32x4*)(Wt + (size_t)orow * K + tk * 64 + k8) = w;
        __syncthreads();
    }
#undef TLOAD
}

template <bool OUT_BF16>
__device__ __forceinline__ void rmsnorm_rows(const float* X, const float* __restrict__ w, void* out, int rows, int bid, int nb) {
    const int tid_ = ltid(); const int lane = tid_ & 63, wid = tid_ >> 6;
    for (int r = bid * 8 + wid; r < rows; r += nb * 8) {
        const float* x = X + (size_t)r * DM; f32x4 v[16]; float ss = 0.f;
#pragma unroll
        for (int i = 0; i < 16; ++i) { v[i] = *(const f32x4*)(x + i * 256 + lane * 4); ss += v[i][0] * v[i][0] + v[i][1] * v[i][1] + v[i][2] * v[i][2] + v[i][3] * v[i][3]; }
#pragma unroll
        for (int o = 32; o >= 1; o >>= 1) ss += __shfl_xor(ss, o);
        const float rs = rsqrtf(ss * (1.0f / DM) + EPS);
#pragma unroll
        for (int i = 0; i < 16; ++i) { const f32x4 ww = *(const f32x4*)(w + i * 256 + lane * 4); const f32x4 y = v[i] * rs * ww;
            if (OUT_BF16) { u32x2 o2; o2.x = pk(y[0], y[1]); o2.y = pk(y[2], y[3]); *(u32x2*)((bf16_t*)out + (size_t)r * DM + i * 256 + lane * 4) = o2; }
            else __builtin_nontemporal_store(y, (f32x4*)((float*)out + (size_t)r * DM + i * 256 + lane * 4)); }
    }
}

__device__ __forceinline__ void rope_phase(bf16_t* proj, int rows, int L, int bid, int nb) {
    const int tid_ = ltid(); const int lane = tid_ & 63, wid = tid_ >> 6, sub = lane >> 5, d = (lane & 31) * 2;
    const double i2pi = 0.15915494309189533577;
    for (int rp = bid * 8 + wid; rp < rows / 2; rp += nb * 8) {
        const int r = rp * 2 + sub, pos = r & (L - 1);
        double a0 = (double)pos * INVD[d] * i2pi, a1 = (double)pos * INVD[d + 1] * i2pi;
        a0 -= __builtin_rint(a0); a1 -= __builtin_rint(a1);
        const float f0 = (float)a0, f1 = (float)a1;
        const float c0 = __builtin_amdgcn_cosf(f0), s0 = __builtin_amdgcn_sinf(f0), c1 = __builtin_amdgcn_cosf(f1), s1 = __builtin_amdgcn_sinf(f1);
        bf16_t* row = proj + (size_t)r * LDP + d;
#pragma unroll 8
        for (int vct = 0; vct < 32; ++vct) { unsigned* p1 = (unsigned*)(row + vct * 128); unsigned* p2 = (unsigned*)(row + vct * 128 + 64);
            const unsigned w1 = *p1, w2 = *p2; const float x10 = bflo(w1), x11 = bfhi(w1), x20 = bflo(w2), x21 = bfhi(w2);
            *p1 = pk(x10 * c0 - x20 * s0, x11 * c1 - x21 * s1); *p2 = pk(x20 * c0 + x10 * s0, x21 * c1 + x11 * s1); }
    }
}

constexpr int HT = 256, HTB = 16;
template <bool PASS3>
__device__ __forceinline__ void hgrn_pass(bf16_t* proj, const float* __restrict__ hgrn_lb, float* ST, float* PD, int nseq, int L, float* lds, int bid, int nb) {
    const int tid = ltid(), g = tid >> 7, j = tid & 127;
    float* qs = lds + g * (3 * HTB * 128); float* fs = qs + HTB * 128; float* vs = fs + HTB * 128;
    const int NSC = L / HT, nitems = nseq * NSC * 8;
    const int sr = j >> 4, c8 = (j & 15) * 8;
    for (int it = bid; it < nitems; it += nb) {
        const int u = it * 4 + g, dir = u & 1, h = (u >> 1) & 15, sc = (u >> 5) % NSC, s = (u >> 5) / NSC;
        const size_t row0 = (size_t)s * L + (size_t)sc * HT;
        const int colq = 6144 + h * 128, colf = (dir ? 10240 : 8192) + h * 128, colv = 12288 + h * 128;
        float lb[8];
#pragma unroll
        for (int e = 0; e < 8; ++e) { const float a0 = hgrn_lb[dir * 4096 + h * 128 + c8 + e], a1 = hgrn_lb[dir * 4096 + 2048 + h * 128 + c8 + e]; lb[e] = 1.0f / (1.0f + __expf(a1 - a0)); }
        float S[128];
#pragma unroll
        for (int k = 0; k < 128; ++k) S[k] = PASS3 ? ST[(size_t)u * 16384 + k * 128 + j] : 0.f;
        float P = 1.f;
        u32x4 rq[2], rf[2], rv[2];
#define HLOAD(b) do { const size_t rb_ = row0 + (dir ? (HT - HTB * ((b) + 1)) : HTB * (b)); _Pragma("unroll") for (int i = 0; i < 2; ++i) { const bf16_t* p_ = proj + (rb_ + sr + 8 * i) * LDP + c8; \
            if (PASS3) rq[i] = *(const u32x4*)(p_ + colq); rf[i] = *(const u32x4*)(p_ + colf); rv[i] = *(const u32x4*)(p_ + colv); } } while (0)
        HLOAD(0);
        for (int b = 0; b < HT / HTB; ++b) {
            __syncthreads();
#pragma unroll
            for (int i = 0; i < 2; ++i) { const int ro = (sr + 8 * i) * 128 + c8;
#pragma unroll
                for (int e = 0; e < 4; ++e) {
                    const unsigned wf = rf[i][e], wv = rv[i][e];
                    const float f0 = bflo(wf), f1 = bfhi(wf);
                    fs[ro + 2 * e] = lb[2 * e] + (1.f - lb[2 * e]) / (1.f + __expf(-f0)); fs[ro + 2 * e + 1] = lb[2 * e + 1] + (1.f - lb[2 * e + 1]) / (1.f + __expf(-f1));
                    vs[ro + 2 * e] = bflo(wv); vs[ro + 2 * e + 1] = bfhi(wv);
                    if (PASS3) { const unsigned wq = rq[i][e]; const float q0 = bflo(wq), q1 = bfhi(wq); qs[ro + 2 * e] = q0 / (1.f + __expf(-q0)); qs[ro + 2 * e + 1] = q1 / (1.f + __expf(-q1)); }
                } }
            __syncthreads();
            if (b + 1 < HT / HTB) HLOAD(b + 1);
            const size_t rb = row0 + (dir ? (HT - HTB * (b + 1)) : HTB * b);
#pragma unroll 1
            for (int tt = 0; tt < HTB; ++tt) {
                const int t = dir ? (HTB - 1 - tt) : tt;
                const float v = vs[t * 128 + j]; f32x2 o2 = {0.f, 0.f};
#pragma unroll
                for (int k4 = 0; k4 < 32; ++k4) { const f32x4 f4 = *(const f32x4*)(fs + t * 128 + k4 * 4);
#pragma unroll
                    for (int e = 0; e < 4; ++e) S[k4 * 4 + e] = fmaf(f4[e], S[k4 * 4 + e] - v, v);
                    if (PASS3) { const f32x4 q4 = *(const f32x4*)(qs + t * 128 + k4 * 4);
#pragma unroll
                        for (int e = 0; e < 4; e += 2) { const f32x2 qq = {q4[e], q4[e + 1]}, sv = {S[k4 * 4 + e], S[k4 * 4 + e + 1]}; o2 = __builtin_elementwise_fma(qq, sv, o2); } } }
                if (PASS3) proj[(rb + t) * LDP + colf + j] = f2bf(o2[0] + o2[1]);
                else P *= fs[t * 128 + j];
            }
        }
#undef HLOAD
        if (!PASS3) {
#pragma unroll
            for (int k = 0; k < 128; ++k) ST[(size_t)u * 16384 + k * 128 + j] = S[k];
            PD[(size_t)u * 128 + j] = P; }
        __syncthreads();
    }
}

constexpr int LDT = 264;
__device__ __forceinline__ void hgrn_ends(const bf16_t* proj, const float* __restrict__ hgrn_lb, float* ST, float* PD, int nseq, int L, unsigned char* lds, int bid, int nb) {
    const int tid = ltid(), grp = tid >> 7, x = tid & 127, wid = tid >> 6, lane = tid & 63, fr = lane & 15, fq = lane >> 4;
    bf16_t* wT = (bf16_t*)lds; bf16_t* vT = (bf16_t*)(lds + 128 * LDT * 2);
    const int NSC = L / HT, nunits = nseq * NSC * 32;
    for (int u = bid; u < nunits; u += nb) {
        const int dir = u & 1, h = (u >> 1) & 15, sc = (u >> 5) % NSC, s = (u >> 5) / NSC;
        const size_t row0 = (size_t)s * L + (size_t)sc * HT;
        if (grp == 0) {
            const bf16_t* pf = proj + row0 * LDP + (dir ? 10240 : 8192) + h * 128 + x;
            const float a0 = hgrn_lb[dir * 4096 + h * 128 + x], a1 = hgrn_lb[dir * 4096 + 2048 + h * 128 + x]; const float lb = __builtin_amdgcn_rcpf(1.0f + __expf(a1 - a0));
            float R = 1.f; unsigned short raw[32], nxt[32];
#pragma unroll
            for (int i = 0; i < 32; ++i) { const int t = dir ? i : 255 - i; raw[i] = pf[(size_t)t * LDP]; }
#pragma unroll 1
            for (int tb = 0; tb < 8; ++tb) {
                if (tb < 7) {
#pragma unroll
                    for (int i = 0; i < 32; ++i) { const int t = dir ? (tb + 1) * 32 + i : 255 - ((tb + 1) * 32 + i); nxt[i] = pf[(size_t)t * LDP]; } }
#pragma unroll
                for (int i = 0; i < 32; ++i) { const int t = dir ? tb * 32 + i : 255 - (tb * 32 + i);
                    const float fraw = bf2f(raw[i]); const float f = lb + (1.f - lb) * __builtin_amdgcn_rcpf(1.f + __expf(-fraw));
                    wT[x * LDT + t] = f2bf((1.f - f) * R); R *= f; }
#pragma unroll
                for (int i = 0; i < 32; ++i) raw[i] = nxt[i];
            }
            PD[(size_t)u * 128 + x] = R;
        } else if (grp < 3) {
            const bf16_t* pv = proj + (row0 + (size_t)(grp - 1) * 128) * LDP + 12288 + h * 128 + x; bf16_t* dst = vT + x * LDT + (grp - 1) * 128;
#pragma unroll 1
            for (int tb = 0; tb < 4; ++tb) { unsigned short raw[32];
#pragma unroll
                for (int i = 0; i < 32; ++i) raw[i] = pv[(size_t)(tb * 32 + i) * LDP];
#pragma unroll
                for (int i = 0; i < 32; i += 2) *(unsigned*)(dst + tb * 32 + i) = (unsigned)raw[i] | ((unsigned)raw[i + 1] << 16); }
        }
        __syncthreads();
        pg8::f32x4 acc[8];
#pragma unroll
        for (int jb = 0; jb < 8; ++jb) acc[jb] = (pg8::f32x4){0.f, 0.f, 0.f, 0.f};
#pragma unroll
        for (int ks = 0; ks < 8; ++ks) { const pg8::bf16x8 a = *(const pg8::bf16x8*)(wT + (wid * 16 + fr) * LDT + ks * 32 + fq * 8);
#pragma unroll
            for (int jb = 0; jb < 8; ++jb) { const pg8::bf16x8 b = *(const pg8::bf16x8*)(vT + (jb * 16 + fr) * LDT + ks * 32 + fq * 8);
                acc[jb] = __builtin_amdgcn_mfma_f32_16x16x32_bf16(a, b, acc[jb], 0, 0, 0); } }
        float* st = ST + (size_t)u * 16384;
#pragma unroll
        for (int jb = 0; jb < 8; ++jb)
#pragma unroll
            for (int i = 0; i < 4; ++i) st[(wid * 16 + fq * 4 + i) * 128 + jb * 16 + fr] = acc[jb][i];
        __syncthreads();
    }
}

__device__ __forceinline__ void hgrn_out(bf16_t* proj, const float* __restrict__ hgrn_lb, const float* ST, int nseq, int L, unsigned char* lds, int bid, int nb) {
    const int tid = ltid(), wid = tid >> 6, lane = tid & 63, fr = lane & 15, fq = lane >> 4, x = tid & 127, role = tid >> 7;
    bf16_t* QD = (bf16_t*)lds; bf16_t* KD = QD + 32 * 136; bf16_t* KE = KD + 32 * 136; bf16_t* VT = KE + 128 * 40; bf16_t* SB = VT + 128 * 40; bf16_t* AM = SB + 128 * 136; float* DC = (float*)(AM + 32 * 40);
    const int NSC = L / HT, nunits = nseq * NSC * 32;
    for (int u = bid; u < nunits; u += nb) {
        const int dir = u & 1, h = (u >> 1) & 15, sc = (u >> 5) % NSC, s = (u >> 5) / NSC;
        const size_t row0 = (size_t)s * L + (size_t)sc * HT;
        const int colq = 6144 + h * 128, colf = (dir ? 10240 : 8192) + h * 128, colv = 12288 + h * 128;
        pg8::f32x4 Sacc[8];
        { const float* st = ST + (size_t)u * 16384;
#pragma unroll
          for (int jb = 0; jb < 8; ++jb)
#pragma unroll
              for (int r = 0; r < 4; ++r) Sacc[jb][r] = st[(wid * 16 + fq * 4 + r) * 128 + jb * 16 + fr]; }
        float lb = 0.f;
        if (role == 0) { const float a0 = hgrn_lb[dir * 4096 + h * 128 + x], a1 = hgrn_lb[dir * 4096 + 2048 + h * 128 + x]; lb = __builtin_amdgcn_rcpf(1.0f + __expf(a1 - a0)); }
        unsigned short ra[32], rb[32];
#define PLOAD(cc_) do { if (role == 0) { _Pragma("unroll") for (int i = 0; i < 32; ++i) { const int tt_ = (cc_) * 32 + i; const bf16_t* p_ = proj + (row0 + (dir ? 255 - tt_ : tt_)) * LDP + x; ra[i] = p_[colf]; rb[i] = p_[colq]; } } \
        else if (role == 1) { _Pragma("unroll") for (int i = 0; i < 32; ++i) { const int tt_ = (cc_) * 32 + i; ra[i] = proj[(row0 + (dir ? 255 - tt_ : tt_)) * LDP + colv + x]; } } } while (0)
        PLOAD(0);
#define SBWRITE() do { _Pragma("unroll") for (int jb = 0; jb < 8; ++jb) { u32x2 w_; w_.x = pk(Sacc[jb][0], Sacc[jb][1]); w_.y = pk(Sacc[jb][2], Sacc[jb][3]); *(u32x2*)(SB + (jb * 16 + fr) * 136 + wid * 16 + fq * 4) = w_; } } while (0)
        SBWRITE();
#pragma unroll 1
        for (int cc = 0; cc < 8; ++cc) {
            if (role == 0) { float D = 1.f; float kd[32];
#pragma unroll
                for (int i = 0; i < 32; ++i) { const float fraw = bf2f(ra[i]), qraw = bf2f(rb[i]); const float f = lb + (1.f - lb) * __builtin_amdgcn_rcpf(1.f + __expf(-fraw)); const float q = qraw * __builtin_amdgcn_rcpf(1.f + __expf(-qraw));
                    D *= f; QD[i * 136 + x] = f2bf(q * D); kd[i] = (1.f - f) * __builtin_amdgcn_rcpf(D); KD[i * 136 + x] = f2bf(kd[i]); }
                DC[x] = D;
#pragma unroll
                for (int i = 0; i < 32; i += 2) *(unsigned*)(KE + x * 40 + i) = pk(kd[i] * D, kd[i + 1] * D);
            } else if (role == 1) {
#pragma unroll
                for (int i = 0; i < 32; i += 2) *(unsigned*)(VT + x * 40 + i) = (unsigned)ra[i] | ((unsigned)ra[i + 1] << 16);
            }
            if (cc < 7) PLOAD(cc + 1);
            __syncthreads();
            if (wid < 4) { const int mb = wid >> 1, nbk = wid & 1; pg8::f32x4 acc = {0.f, 0.f, 0.f, 0.f};
#pragma unroll
                for (int ks = 0; ks < 4; ++ks) { const pg8::bf16x8 a = *(const pg8::bf16x8*)(QD + (mb * 16 + fr) * 136 + ks * 32 + fq * 8), b = *(const pg8::bf16x8*)(KD + (nbk * 16 + fr) * 136 + ks * 32 + fq * 8);
                    acc = __builtin_amdgcn_mfma_f32_16x16x32_bf16(a, b, acc, 0, 0, 0); }
#pragma unroll
                for (int r = 0; r < 4; ++r) { const int i = mb * 16 + fq * 4 + r, ip = nbk * 16 + fr; AM[i * 40 + ip] = (ip <= i) ? f2bf(acc[r]) : (unsigned short)0; } }
            __syncthreads();
            { const int mb = wid >> 2;
#pragma unroll
              for (int q2 = 0; q2 < 2; ++q2) { const int jb = (wid & 3) * 2 + q2; pg8::f32x4 acc = {0.f, 0.f, 0.f, 0.f};
                  { const pg8::bf16x8 a = *(const pg8::bf16x8*)(AM + (mb * 16 + fr) * 40 + fq * 8), b = *(const pg8::bf16x8*)(VT + (jb * 16 + fr) * 40 + fq * 8); acc = __builtin_amdgcn_mfma_f32_16x16x32_bf16(a, b, acc, 0, 0, 0); }
#pragma unroll
                  for (int ks = 0; ks < 4; ++ks) { const pg8::bf16x8 a = *(const pg8::bf16x8*)(QD + (mb * 16 + fr) * 136 + ks * 32 + fq * 8), b = *(const pg8::bf16x8*)(SB + (jb * 16 + fr) * 136 + ks * 32 + fq * 8);
                      acc = __builtin_amdgcn_mfma_f32_16x16x32_bf16(a, b, acc, 0, 0, 0); }
#pragma unroll
                  for (int r = 0; r < 4; ++r) { const int tt = cc * 32 + mb * 16 + fq * 4 + r; proj[(row0 + (dir ? 255 - tt : tt)) * LDP + colf + jb * 16 + fr] = f2bf(acc[r]); } } }
            { const pg8::f32x4 dc = *(const pg8::f32x4*)(DC + wid * 16 + fq * 4); const pg8::bf16x8 a = *(const pg8::bf16x8*)(KE + (wid * 16 + fr) * 40 + fq * 8);
#pragma unroll
              for (int jb = 0; jb < 8; ++jb) { const pg8::bf16x8 b = *(const pg8::bf16x8*)(VT + (jb * 16 + fr) * 40 + fq * 8); Sacc[jb] = Sacc[jb] * dc; Sacc[jb] = __builtin_amdgcn_mfma_f32_16x16x32_bf16(a, b, Sacc[jb], 0, 0, 0); } }
            __syncthreads();
            if (cc < 7) SBWRITE();
        }
#undef PLOAD
#undef SBWRITE
    }
}
__device__ __forceinline__ void hgrn_scan(float* ST, const float* PD, int nseq, int NSC, int bid, int nb) {
    const int nitems = nseq * 32 * 32; const int tid_ = ltid();
    for (int it = bid; it < nitems; it += nb) {
        const int eb = it & 31, hd = (it >> 5) & 31, s = it >> 10, dir = hd & 1;
        const int e = eb * 512 + tid_, k = e >> 7; float carry = 0.f;
        for (int cc = 0; cc < NSC; cc += 8) { float E[8], p[8]; size_t ui[8];
#pragma unroll
            for (int q = 0; q < 8; ++q) { const int c = dir ? NSC - 1 - (cc + q) : (cc + q); ui[q] = ((size_t)(s * NSC + c)) * 32 + hd; E[q] = ST[ui[q] * 16384 + e]; p[q] = PD[ui[q] * 128 + k]; }
#pragma unroll
            for (int q = 0; q < 8; ++q) { ST[ui[q] * 16384 + e] = carry; carry = fmaf(p[q], carry, E[q]); } }
    }
}

__device__ __forceinline__ void combine_phase(const bf16_t* OB, const bf16_t* proj, bf16_t* mix, const float* __restrict__ dl, const float* __restrict__ subln_w, const float* __restrict__ hnw, int rows, int bid, int nb) {
    const int tid_ = ltid(); const int lane = tid_ & 63, wid = tid_ >> 6;
    float a = dl[lane] * dl[128 + lane] + dl[64 + lane] * dl[192 + lane], b = dl[256 + lane] * dl[384 + lane] + dl[320 + lane] * dl[448 + lane];
#pragma unroll
    for (int o = 32; o >= 1; o >>= 1) { a += __shfl_xor(a, o); b += __shfl_xor(b, o); }
    const float lam = expf(a) - expf(b) + 0.2f;
    for (int r = bid * 8 + wid; r < rows; r += nb * 8) {
#pragma unroll
        for (int i = 0; i < 4; ++i) { const int head = i * 2 + (lane >> 5), e = (lane & 31) * 8;
            const bf16_t* o0 = OB + (size_t)r * DM + head * 512 + e; const u32x4 x0 = *(const u32x4*)o0, x1 = *(const u32x4*)(o0 + 256);
            float dv[8]; float ss = 0.f;
#pragma unroll
            for (int q = 0; q < 4; ++q) { dv[2 * q] = bflo(x0[q]) - lam * bflo(x1[q]); dv[2 * q + 1] = bfhi(x0[q]) - lam * bfhi(x1[q]); ss += dv[2 * q] * dv[2 * q] + dv[2 * q + 1] * dv[2 * q + 1]; }
#pragma unroll
            for (int o = 16; o >= 1; o >>= 1) ss += __shfl_xor(ss, o);
            const float rs = rsqrtf(ss * (1.0f / 256.0f) + EPS) * 0.8f;
            const f32x4 w0 = *(const f32x4*)(subln_w + e), w1 = *(const f32x4*)(subln_w + e + 4);
            u32x4 w; w.x = pk(dv[0] * rs * w0[0], dv[1] * rs * w0[1]); w.y = pk(dv[2] * rs * w0[2], dv[3] * rs * w0[3]); w.z = pk(dv[4] * rs * w1[0], dv[5] * rs * w1[1]); w.w = pk(dv[6] * rs * w1[2], dv[7] * rs * w1[3]);
            *(u32x4*)(mix + (size_t)r * DM + head * 256 + e) = w; }
#pragma unroll
        for (int i = 0; i < 4; ++i) { const int col = i * 512 + lane * 8, dd = col & 127;
            const bf16_t* pr = proj + (size_t)r * LDP + col; const u32x4 xf = *(const u32x4*)(pr + 8192), xb = *(const u32x4*)(pr + 10240), xg = *(const u32x4*)(pr + 14336);
            float ov[8], gv[8]; float ss = 0.f;
#pragma unroll
            for (int q = 0; q < 4; ++q) { ov[2 * q] = bflo(xf[q]) + bflo(xb[q]); ov[2 * q + 1] = bfhi(xf[q]) + bfhi(xb[q]); gv[2 * q] = bflo(xg[q]); gv[2 * q + 1] = bfhi(xg[q]); ss += ov[2 * q] * ov[2 * q] + ov[2 * q + 1] * ov[2 * q + 1]; }
#pragma unroll
            for (int o = 8; o >= 1; o >>= 1) ss += __shfl_xor(ss, o);
            const float rs = rsqrtf(ss * (1.0f / 128.0f) + EPS);
            const f32x4 w0 = *(const f32x4*)(hnw + dd), w1 = *(const f32x4*)(hnw + dd + 4);
            float y[8];
#pragma unroll
            for (int q = 0; q < 8; ++q) { const float wq = q < 4 ? w0[q & 3] : w1[q & 3]; y[q] = ov[q] * rs * wq * (gv[q] * __builtin_amdgcn_rcpf(1.f + __expf(-gv[q]))); }
            u32x4 w; w.x = pk(y[0], y[1]); w.y = pk(y[2], y[3]); w.z = pk(y[4], y[5]); w.w = pk(y[6], y[7]);
            *(u32x4*)(mix + (size_t)r * DM + 2048 + col) = w; }
    }
}

__device__ __forceinline__ void attn_phase(const bf16_t* proj, bf16_t* OB, int nseq, int L, char* lds, int bid, int nb) {
    const int nqb = L / 256, nunits = nseq * 32 * nqb;
    for (int u = bid; u < nunits; u += nb) {
        const int qb = u % nqb, r = u / nqb, vh = r & 1, c = (r >> 1) & 1, h = (r >> 2) & 7, s = r >> 5;
        const size_t row0 = (size_t)s * L;
        att::attn_dense_body<att::bf16>(proj + (row0 + (size_t)qb * 256) * LDP + h * 256 + c * 128, proj + row0 * LDP + 2048 + h * 256 + c * 128,
                                        proj + row0 * LDP + 4096 + h * 256 + vh * 128, OB + (row0 + (size_t)qb * 256) * DM + h * 512 + c * 256 + vh * 128, L, lds);
        __syncthreads();
    }
}

struct Params { const float* in[13]; float* out; unsigned char* ws; };

__global__ void __launch_bounds__(512, 2) fwd(Params p) {
    extern __shared__ __attribute__((aligned(16))) unsigned char lds[];
    const int tid = threadIdx.x, bid = blockIdx.x, nb = gridDim.x;
    if (tid < 4) ((unsigned*)(lds + LDS_BAR_OFF))[tid] = 0u;
    __syncthreads();
    XcdBarrier bar = xcd_barrier_post((unsigned*)(p.ws + WS_CTL), (volatile LAS unsigned*)(lds + LDS_BAR_OFF));
    const float* attn_norm_w = p.in[2]; const float* w_in = p.in[3]; const float* diff_lambda = p.in[4]; const float* subln_w = p.in[5];
    const float* hgrn_lb = p.in[6]; const float* hgrn_norm_w = p.in[7]; const float* w_out = p.in[8]; const float* mlp_norm_w = p.in[9];
    const float* w_up = p.in[10]; const float* w_down = p.in[11]; const float* final_norm_w = p.in[12];
    bf16_t* WIN = (bf16_t*)(p.ws + WS_WIN); bf16_t* WOUT = (bf16_t*)(p.ws + WS_WOUT); bf16_t* WUP = (bf16_t*)(p.ws + WS_WUP); bf16_t* WDN = (bf16_t*)(p.ws + WS_WDN);
    bf16_t* HB = (bf16_t*)(p.ws + WS_HB); bf16_t* PROJ = (bf16_t*)(p.ws + WS_PROJ); bf16_t* OB = (bf16_t*)(p.ws + WS_OB);
    float* ST = (float*)(p.ws + WS_ST); float* PD = (float*)(p.ws + WS_PD); float* SSQ = (float*)(p.ws + WS_CTL + 512 * 1024);
    PG8_LAS unsigned char* ldsl = (PG8_LAS unsigned char*)lds;

    for (int i = bid * 512 + tid; i < 2 * MH; i += nb * 512) SSQ[i] = 0.f;
#if PHM & 1
    transpose_cvt(w_in, WIN, DM, NPROJ, (float*)lds, bid, nb, true);
    transpose_cvt(w_out, WOUT, DM, DM, (float*)lds, bid, nb, false);
    transpose_cvt(w_up, WUP, DM, DFF, (float*)lds, bid, nb, false);
    transpose_cvt(w_down, WDN, DFF, DM, (float*)lds, bid, nb, false);
#endif

    for (int hf = 0; hf < 2; ++hf) {
        const float* x = hf ? p.in[1] : p.in[0]; const int nseq = hf ? 1 : 8, L = hf ? 16384 : 2048;
        float* outp = p.out + (size_t)hf * MH * DM;
        rmsnorm_rows<true>(x, attn_norm_w, HB, MH, bid, nb);
        xcd_barrier(bar);
#if PHM & 2
        { pg8::Gemm g{HB, WIN, MH, NPROJ, DM}; pg8::StaticOrder S; S.init(MH, NPROJ, nb, bid); EpiProjRope E{PROJ, LDP, L - 1};
          pg8::gemm_phase<EpiProjRope, pg8::StaticOrder>(ldsl, g, S, E, nullptr); }
#endif
        xcd_barrier(bar);
#if PHM & 4
        hgrn_ends(PROJ, hgrn_lb, ST, PD, nseq, L, lds, bid, nb);
#endif
        xcd_barrier(bar);
        hgrn_scan(ST, PD, nseq, L / HT, bid, nb);
#if PHM & 8
        attn_phase(PROJ, OB, nseq, L, (char*)lds, bid, nb);
#endif
        xcd_barrier(bar);
#if PHM & 16
        hgrn_out(PROJ, hgrn_lb, ST, nseq, L, lds, bid, nb);
#endif
        xcd_barrier(bar);
        combine_phase(OB, PROJ, HB, diff_lambda, subln_w, hgrn_norm_w, MH, bid, nb);
        xcd_barrier(bar);
#if PHM & 32
        { pg8::Gemm g{HB, WOUT, MH, DM, DM}; pg8::StaticOrder S; S.init(MH, DM, nb, bid); EpiResNorm E{x, outp, DM, OB, mlp_norm_w, SSQ + hf * MH};
          pg8::gemm_phase<EpiResNorm, pg8::StaticOrder>(ldsl, g, S, E, nullptr); }
#endif
        xcd_barrier(bar);
        for (int ch = 0; ch < MH / MC; ++ch) {
#if PHM & 64
            { pg8::Gemm g{OB + (size_t)ch * MC * DM, WUP, MC, DFF, DM}; pg8::StaticOrder S; S.init(MC, DFF, nb, bid); EpiB<1> E{PROJ, DFF};
              pg8::gemm_phase<EpiB<1>, pg8::StaticOrder>(ldsl, g, S, E, nullptr); }
#endif
            xcd_barrier(bar);
#if PHM & 128
            { float* oc = outp + (size_t)ch * MC * DM; pg8::Gemm g{PROJ, WDN, MC, DM, DFF}; pg8::StaticOrder S; S.init(MC, DM, nb, bid); EpiResScale E{oc, DM, SSQ + hf * MH + ch * MC};
              pg8::gemm_phase<EpiResScale, pg8::StaticOrder>(ldsl, g, S, E, nullptr); }
#endif
            xcd_barrier(bar);
        }
        rmsnorm_rows<false>(outp, final_norm_w, outp, MH, bid, nb);
    }
}
}

extern "C" void kernel_launch(void* const* d_in, const int* in_sizes, int n_in, void* d_out, int out_size, void* d_ws, size_t ws_size, hipStream_t stream) {
    static int grid = 0;
    if (grid == 0) {
        if (n_in != 13 || ws_size < mk::WS_END) { fprintf(stderr, "kernel_launch: n_in %d ws %zu (need %zu)\n", n_in, ws_size, (size_t)mk::WS_END); grid = -1; return; }
        int dev = 0, cus = 0, per_cu = 0;
        hipGetDevice(&dev); hipDeviceGetAttribute(&cus, hipDeviceAttributeMultiprocessorCount, dev);
        if (hipFuncSetAttribute((const void*)mk::fwd, hipFuncAttributeMaxDynamicSharedMemorySize, mk::LDS_BYTES) != hipSuccess) { fprintf(stderr, "kernel_launch: hipFuncSetAttribute failed\n"); grid = -1; return; }
        if (hipOccupancyMaxActiveBlocksPerMultiprocessor(&per_cu, (const void*)mk::fwd, 512, mk::LDS_BYTES) != hipSuccess || per_cu < 1) { fprintf(stderr, "kernel_launch: occupancy %d\n", per_cu); grid = -1; return; }
        (void)hipGetLastError();
        grid = cus;
    }
    if (grid < 0) return;
    hipMemsetAsync((char*)d_ws + mk::WS_CTL, 0, 65536, stream);
    mk::Params p{};
    for (int i = 0; i < 13; ++i) p.in[i] = (const float*)d_in[i];
    p.out = (float*)d_out; p.ws = (unsigned char*)d_ws;
    hipLaunchKernelGGL(mk::fwd, dim3(grid), dim3(512), mk::LDS_BYTES, stream, p);
}
```
